# Optimizing an MI355X kernel written in HIP

```python
import jax, jax.numpy as jnp
from jax import lax
import numpy as np

D_MODEL = 1024
BATCH = 8
SEQ = 4096
DEPTH = 1

HG_HEADS = 4
HG_DK = 128
HG_DV = 128
HG_QK_WIDTH = HG_HEADS * HG_DK
HG_WIDTH = HG_HEADS * HG_DV
HG_CHUNK = 64
ATT_GROUPS = ((128, 1), (512, 4), (2048, 16))
ATT_HEADS_PER_GROUP = 4
ATT_HEAD_DIM = 64
ATT_HEADS = ATT_HEADS_PER_GROUP * len(ATT_GROUPS)
ATT_WIDTH = ATT_HEADS * ATT_HEAD_DIM
ATT_OUT_WIDTH = ATT_HEADS_PER_GROUP * ATT_HEAD_DIM
IN_SIZES = (HG_QK_WIDTH, HG_QK_WIDTH, HG_WIDTH, HG_WIDTH, ATT_WIDTH, ATT_WIDTH, ATT_WIDTH, D_MODEL, D_MODEL)
IN_COLS = sum(IN_SIZES)
IN_SPLIT_IDX = tuple(int(v) for v in np.cumsum(IN_SIZES)[:-1])
N_EXPERTS = 256
TOP_K = 8
D_EXPERT = 256
D_SHARED = 256
ROUTE_SCALE = 2.5
MOE_BLOCK = 128
RMS_EPS = 1e-6

kernel_name = 'hybrid_hgrn2_dilated_attn_moe_block'


def rms_norm(x, g):
    xf = x.astype(jnp.float32)
    y = xf * lax.rsqrt(jnp.mean(xf * xf, axis=-1, keepdims=True) + RMS_EPS)
    return (y * g.astype(jnp.float32)).astype(x.dtype)


def swiglu(x, wg, wu, wd):
    return (jax.nn.silu(x @ wg) * (x @ wu)) @ wd


def hgrn2_chunked(q, f_logit, v, lb):
    B, S, H, DK = q.shape
    DV = v.shape[-1]
    C = HG_CHUNK
    NC = S // C
    f = lb + (1.0 - lb) * jax.nn.sigmoid(f_logit.astype(jnp.float32))
    log_f = jnp.log(f)
    k = 1.0 - f

    def chunks(t):
        return t.astype(jnp.float32).reshape(B, NC, C, H, t.shape[-1]).transpose(1, 0, 3, 2, 4)

    causal = jnp.tril(jnp.ones((C, C), dtype=bool))

    def step(state, inp):
        qc, kc, vc, lfc = inp
        b = jnp.cumsum(lfc, axis=2)
        o_inter = jnp.einsum('bhtk,bhkv->bhtv', qc * jnp.exp(b), state)
        diff = b[:, :, :, None, :] - b[:, :, None, :, :]
        decay = jnp.exp(jnp.where(causal[:, :, None], diff, -jnp.inf))
        scores = jnp.einsum('bhtk,bhsk,bhtsk->bhts', qc, kc, decay)
        o_intra = jnp.einsum('bhts,bhsv->bhtv', scores, vc)
        b_end = b[:, :, -1:, :]
        state = jnp.exp(b_end[:, :, 0, :])[..., None] * state + jnp.einsum('bhsk,bhsv->bhkv', kc * jnp.exp(b_end - b), vc)
        return state, o_inter + o_intra

    s0 = jnp.zeros((B, H, DK, DV), jnp.float32)
    _, o = lax.scan(step, s0, (chunks(q), chunks(k), chunks(v), chunks(log_f)))
    return o.transpose(1, 0, 3, 2, 4).reshape(B, S, H, DV)


def dilated_window_group(q, k, v, window, dilation):
    B, S, H, E = q.shape
    nk = window // dilation
    L = S // dilation
    nb = -(-L // nk)
    Lp = nb * nk

    def to_blocks(t):
        t = t.astype(jnp.float32).reshape(B, L, dilation, H, E).transpose(0, 2, 1, 3, 4)
        t = jnp.pad(t, ((0, 0), (0, 0), (0, Lp - L), (0, 0), (0, 0)))
        return t.reshape(B, dilation, nb, nk, H, E)

    def with_prev(t):
        prev = jnp.pad(t[:, :, :-1], ((0, 0), (0, 0), (1, 0), (0, 0), (0, 0), (0, 0)))
        return jnp.concatenate([prev, t], axis=3)

    qb = to_blocks(q)
    kk = with_prev(to_blocks(k))
    vv = with_prev(to_blocks(v))
    s = jnp.einsum('brnqhe,brnkhe->brnhqk', qb, kk) * (E ** -0.5)
    i = jnp.arange(nk)[None, :, None]
    j = jnp.arange(2 * nk)[None, None, :]
    n = jnp.arange(nb)[:, None, None]
    valid = (j >= i) & (j <= i + nk) & (n * nk + j - nk >= 0)
    s = jnp.where(valid[:, None], s, -jnp.inf)
    m = jnp.max(s, axis=-1, keepdims=True)
    p = jnp.exp(s - m)
    l = jnp.sum(p, axis=-1, keepdims=True)
    o = jnp.einsum('brnhqk,brnkhe->brnqhe', p, vv) / jnp.swapaxes(l, 3, 4)
    lse = jnp.swapaxes((m + jnp.log(l))[..., 0], 3, 4)
    o = o.reshape(B, dilation, Lp, H, E)[:, :, :L].transpose(0, 2, 1, 3, 4).reshape(B, S, H, E)
    lse = lse.reshape(B, dilation, Lp, H)[:, :, :L].transpose(0, 2, 1, 3).reshape(B, S, H)
    return o, lse


def dilated_attention(q, k, v):
    B, S, _, E = q.shape
    outs, lses = [], []
    for g, (window, dilation) in enumerate(ATT_GROUPS):
        hs = slice(g * ATT_HEADS_PER_GROUP, (g + 1) * ATT_HEADS_PER_GROUP)
        o, lse = dilated_window_group(q[:, :, hs], k[:, :, hs], v[:, :, hs], window, dilation)
        outs.append(o)
        lses.append(lse)
    w = jax.nn.softmax(jnp.stack(lses, axis=0), axis=0)
    y = jnp.sum(w[..., None] * jnp.stack(outs, axis=0), axis=0)
    return y.reshape(B, S, ATT_OUT_WIDTH).astype(q.dtype)


def routed_experts(h, w_router, router_bias, w_gate, w_up, w_down):
    T, D = h.shape
    scores = jax.nn.sigmoid((h @ w_router).astype(jnp.float32))
    _, idx = lax.top_k(scores + router_bias.astype(jnp.float32), TOP_K)
    sel = jnp.take_along_axis(scores, idx, axis=-1)
    gates = (sel / jnp.sum(sel, axis=-1, keepdims=True) * ROUTE_SCALE).astype(h.dtype)
    flat_e = idx.reshape(-1).astype(jnp.int32)
    flat_tok = jnp.repeat(jnp.arange(T, dtype=jnp.int32), TOP_K)
    flat_w = gates.reshape(-1)
    order = jnp.argsort(flat_e)
    e_s, tok_s, w_s = flat_e[order], flat_tok[order], flat_w[order]
    counts = jnp.bincount(flat_e, length=N_EXPERTS).astype(jnp.int32)
    starts = jnp.cumsum(counts) - counts
    padded = (counts + MOE_BLOCK - 1) // MOE_BLOCK * MOE_BLOCK
    pend = jnp.cumsum(padded)
    pstart = pend - padded
    dest = pstart[e_s] + jnp.arange(T * TOP_K, dtype=jnp.int32) - starts[e_s]
    n_blocks = -(-(T * TOP_K) // MOE_BLOCK) + N_EXPERTS
    n_slots = n_blocks * MOE_BLOCK
    slot_tok = jnp.full((n_slots,), T, jnp.int32).at[dest].set(tok_s)
    slot_w = jnp.zeros((n_slots,), h.dtype).at[dest].set(w_s)
    blk_e = jnp.minimum(jnp.searchsorted(pend, jnp.arange(n_blocks, dtype=jnp.int32) * MOE_BLOCK, side='right'), N_EXPERTS - 1)
    h_pad = jnp.concatenate([h, jnp.zeros((1, D), h.dtype)], axis=0)

    def block_step(acc, blk):
        tok, w, e = blk
        yb = swiglu(h_pad[tok], w_gate[e], w_up[e], w_down[e]) * w[:, None]
        return acc.at[tok].add(yb), None

    acc, _ = lax.scan(block_step, jnp.zeros((T + 1, D), h.dtype),
                      (slot_tok.reshape(n_blocks, MOE_BLOCK), slot_w.reshape(n_blocks, MOE_BLOCK), blk_e))
    return acc[:T]


def setup_inputs(seed: int = 0) -> dict:
    key = jax.random.key(seed)
    ks = jax.random.split(key, 24)
    D = D_MODEL

    def nrm(k, shape, scale):
        return jax.random.normal(k, shape, jnp.float32) * scale

    lb_offset = jnp.where(jnp.arange(DEPTH + 1) == 0, -2.0, 0.0).astype(jnp.float32)[:, None]
    return {
        'x': nrm(ks[0], (BATCH, SEQ, D), 1.0),
        'c': nrm(ks[1], (BATCH, D), 1.0),
        'ada_w': nrm(ks[2], (DEPTH, D, 6 * D), 0.5 * D ** -0.5),
        'ada_b': nrm(ks[3], (DEPTH, 6 * D), 0.02),
        'norm1_g': 1.0 + nrm(ks[4], (DEPTH, D), 0.02),
        'w_in': nrm(ks[5], (DEPTH, D, IN_COLS), D ** -0.5),
        'lb_logits': nrm(ks[6], (DEPTH + 1, HG_QK_WIDTH), 0.1) + lb_offset,
        'hg_norm_g': 1.0 + nrm(ks[7], (DEPTH, HG_WIDTH), 0.02),
        'w_branch_a': nrm(ks[8], (DEPTH, HG_WIDTH, D), HG_WIDTH ** -0.5),
        'w_branch_b': nrm(ks[9], (DEPTH, ATT_OUT_WIDTH, D), ATT_OUT_WIDTH ** -0.5),
        'w_out': nrm(ks[10], (DEPTH, D, D), D ** -0.5),
        'norm2_g': 1.0 + nrm(ks[11], (DEPTH, D), 0.02),
        'w_router': nrm(ks[12], (DEPTH, D, N_EXPERTS), D ** -0.5),
        'router_bias': nrm(ks[13], (DEPTH, N_EXPERTS), 0.01),
        'w_exp_gate': nrm(ks[14], (DEPTH, N_EXPERTS, D, D_EXPERT), D ** -0.5),
        'w_exp_up': nrm(ks[15], (DEPTH, N_EXPERTS, D, D_EXPERT), D ** -0.5),
        'w_exp_down': nrm(ks[16], (DEPTH, N_EXPERTS, D_EXPERT, D), D_EXPERT ** -0.5),
        'w_sh_gate': nrm(ks[17], (DEPTH, D, D_SHARED), D ** -0.5),
        'w_sh_up': nrm(ks[18], (DEPTH, D, D_SHARED), D ** -0.5),
        'w_sh_down': nrm(ks[19], (DEPTH, D_SHARED, D), D_SHARED ** -0.5),
        'final_g': 1.0 + nrm(ks[20], (D,), 0.02),
    }


def reference(x, c, ada_w, ada_b, norm1_g, w_in, lb_logits, hg_norm_g, w_branch_a, w_branch_b, w_out,
              norm2_g, w_router, router_bias, w_exp_gate, w_exp_up, w_exp_down, w_sh_gate, w_sh_up, w_sh_down,
              final_g):
    B, S, D = x.shape
    lb_table = jnp.cumsum(jax.nn.softmax(lb_logits.astype(jnp.float32), axis=0), axis=0)
    for l in range(DEPTH):
        mod = jax.nn.silu(c) @ ada_w[l] + ada_b[l]
        shift1, scale1, gate1, shift2, scale2, gate2 = jnp.split(mod[:, None, :], 6, axis=-1)

        h = rms_norm(x, norm1_g[l]) * (1.0 + scale1) + shift1
        hq, hf, hi, hg, aq, ak, av, ga, gb = jnp.split(h @ w_in[l], IN_SPLIT_IDX, axis=-1)
        o_a = hgrn2_chunked(hq.reshape(B, S, HG_HEADS, HG_DK), hf.reshape(B, S, HG_HEADS, HG_DK),
                            hi.reshape(B, S, HG_HEADS, HG_DV), lb_table[l].reshape(HG_HEADS, HG_DK))
        y_a = rms_norm(o_a.astype(x.dtype), hg_norm_g[l].reshape(HG_HEADS, HG_DV)).reshape(B, S, HG_WIDTH) * jax.nn.silu(hg)
        y_b = dilated_attention(aq.reshape(B, S, ATT_HEADS, ATT_HEAD_DIM), ak.reshape(B, S, ATT_HEADS, ATT_HEAD_DIM),
                                av.reshape(B, S, ATT_HEADS, ATT_HEAD_DIM))
        merged = jax.nn.sigmoid(ga) * (y_a @ w_branch_a[l]) + jax.nn.sigmoid(gb) * (y_b @ w_branch_b[l])
        x = x + gate1 * (merged @ w_out[l])

        h2 = (rms_norm(x, norm2_g[l]) * (1.0 + scale2) + shift2).reshape(B * S, D)
        y = routed_experts(h2, w_router[l], router_bias[l], w_exp_gate[l], w_exp_up[l], w_exp_down[l]) \
            + swiglu(h2, w_sh_gate[l], w_sh_up[l], w_sh_down[l])
        x = x + gate2 * y.reshape(B, S, D)
    return rms_norm(x, final_g)
```

```cpp
#include <hip/hip_runtime.h>
#include <cstdio>
#include <cstdint>
#ifndef DBG_MOE
#define DBG_MOE 2
#endif

#define GAS __attribute__((address_space(1)))
#define LAS __attribute__((address_space(3)))
typedef unsigned short bf16;
typedef unsigned v4u __attribute__((ext_vector_type(4)));
typedef unsigned v2u __attribute__((ext_vector_type(2)));
typedef float f32x4 __attribute__((ext_vector_type(4)));
typedef short bf16x8 __attribute__((ext_vector_type(8)));
typedef short bf16x4 __attribute__((ext_vector_type(4)));
typedef short v4i16_t __attribute__((ext_vector_type(4)));
typedef GAS unsigned gu32;

constexpr int NB = 8, SEQ = 4096, D = 1024, T = NB * SEQ;
constexpr int NIN = 6400;
constexpr int NEXP = 256, TOPK = 8, DEXP = 256;
constexpr int NSLOT = T * TOPK;
constexpr int MAXRT = NSLOT / 256 + NEXP;
constexpr int NSLOTP = MAXRT * 256;
constexpr int MAXTILES = MAXRT + T / 256;
constexpr float RMS_EPS = 1e-6f;
constexpr int NWAVES = 8;
constexpr int SH_WD = 5, SH_HMID = 2, SH_WGU = 6, SH_X = 2, SH_Y = 3, SH_G = 2, SH_U = 2, SH_M = 3, SH_YAB = 2, SH_WAB = 5, SH_Q = 2;
constexpr int SC_WD = 0x01010101 * (127 - SH_WD), SC_HMID = 0x01010101 * (127 - SH_HMID), SC_WGU = 0x01010101 * (127 - SH_WGU), SC_X = 0x01010101 * (127 - SH_X), SC_M = 0x01010101 * (127 - SH_M), SC_YAB = 0x01010101 * (127 - SH_YAB), SC_WAB = 0x01010101 * (127 - SH_WAB);

constexpr size_t MiB = 1u << 20;
constexpr size_t WS_CTL = 0, CTL_ZERO_BYTES = 1 * MiB;
constexpr size_t WS_WIN_T = 1 * MiB;
constexpr size_t WS_WA_T = 14 * MiB;
constexpr size_t WS_WB_T = 15 * MiB;
constexpr size_t WS_WO_T = 16 * MiB;
constexpr size_t WS_RS_T = 18 * MiB;
constexpr size_t WS_WSD_T = 20 * MiB;
constexpr size_t WS_PE = 21 * MiB, WS_PR = 22 * MiB, WS_PW = 23 * MiB;
constexpr size_t WS_SLOT_TOK = 24 * MiB, WS_SLOT_W = 25 * MiB, WS_TOK_SLOT = 27 * MiB;
constexpr size_t WS_LSE = 28 * MiB;
constexpr size_t WS_HISTG = 31 * MiB;
constexpr size_t WS_MOD = 30 * MiB;
constexpr size_t WS_WD = 32 * MiB;
constexpr size_t WS_QF = 160 * MiB;
constexpr size_t WS_OA = 288 * MiB;
constexpr size_t WS_OG = 320 * MiB;
constexpr size_t WS_MERGED = 288 * MiB;
constexpr size_t WS_HMID = 160 * MiB;
constexpr size_t WS_YSH = 304 * MiB;
constexpr size_t WS_WGU = 384 * MiB;
constexpr size_t WS_AQKV = 640 * MiB;
constexpr size_t WS_GAB = 784 * MiB;
constexpr size_t WS_XN = 912 * MiB;
constexpr size_t WS_YA = 640 * MiB;
constexpr size_t WS_YB = 368 * MiB;
constexpr size_t WS_H2 = 640 * MiB;
constexpr size_t WS_H2F8 = 912 * MiB;
constexpr size_t WS_X1B = 736 * MiB;
constexpr size_t WS_LOGITS = 704 * MiB;
constexpr size_t WS_YSLOT = 384 * MiB;
constexpr size_t WS_UT = 912 * MiB;
constexpr size_t WS_QTB = 976 * MiB;
constexpr size_t WS_DK = 1008 * MiB;
constexpr size_t WS_PART = 18 * MiB;
constexpr size_t WS_CB = 19 * MiB;
constexpr size_t WS_RSTD = 19 * MiB + 65536;
constexpr size_t WS_WRB = 1009 * MiB;
constexpr size_t WS_END = 1013 * MiB;
constexpr int CW_TMO = 0, CW_CODE = 1, CW_BAR = 4096, CW_GCNT = 16384, CW_ATTQ = 20480, CW_MOD = 65536;

constexpr int RING_BYTES = 131072;
constexpr int TAB_OFF = RING_BYTES;
constexpr int MISC_OFF = TAB_OFF + MAXTILES * 16;
constexpr int LDS_BYTES = MISC_OFF + 256;

#define RLX_AGENT __ATOMIC_RELAXED, __HIP_MEMORY_SCOPE_AGENT
#define LDS_WAIT() asm volatile("s_waitcnt lgkmcnt(0)" ::: "memory")
#define VM_WAIT() asm volatile("s_waitcnt vmcnt(0)" ::: "memory")
#define LBAR() do { asm volatile("s_waitcnt lgkmcnt(0)" ::: "memory"); __builtin_amdgcn_s_barrier(); asm volatile("" ::: "memory"); } while (0)
typedef float f32x2_t __attribute__((ext_vector_type(2))); typedef __bf16 bf16x2_t __attribute__((ext_vector_type(2)));
__device__ __forceinline__ unsigned cvt_pk_bf16(float lo, float hi) { f32x2_t v = {lo, hi}; bf16x2_t b = __builtin_convertvector(v, bf16x2_t); return __builtin_bit_cast(unsigned, b); }
typedef int v8i __attribute__((ext_vector_type(8))); typedef int v4i_t __attribute__((ext_vector_type(4)));
__device__ __forceinline__ unsigned cvt4_fp8(float a, float b, float c, float d) {
    a = __builtin_amdgcn_fmed3f(a, -448.f, 448.f); b = __builtin_amdgcn_fmed3f(b, -448.f, 448.f); c = __builtin_amdgcn_fmed3f(c, -448.f, 448.f); d = __builtin_amdgcn_fmed3f(d, -448.f, 448.f);
    int w = 0; w = __builtin_amdgcn_cvt_pk_fp8_f32(a, b, w, false); w = __builtin_amdgcn_cvt_pk_fp8_f32(c, d, w, true); return (unsigned)w; }
__device__ __forceinline__ v4u f8x8_to_bf16(unsigned w0, unsigned w1) {
    const f32x2_t a = __builtin_amdgcn_cvt_pk_f32_fp8((int)w0, false), b = __builtin_amdgcn_cvt_pk_f32_fp8((int)w0, true), c = __builtin_amdgcn_cvt_pk_f32_fp8((int)w1, false), d = __builtin_amdgcn_cvt_pk_f32_fp8((int)w1, true);
    v4u o; o.x = cvt_pk_bf16(a[0], a[1]); o.y = cvt_pk_bf16(b[0], b[1]); o.z = cvt_pk_bf16(c[0], c[1]); o.w = cvt_pk_bf16(d[0], d[1]); return o; }
__device__ __forceinline__ float bf2f(unsigned h) { return __uint_as_float(h << 16); }
__device__ __forceinline__ float bflo(unsigned w) { return __uint_as_float(w << 16); }
__device__ __forceinline__ float bfhi(unsigned w) { return __uint_as_float(w & 0xffff0000u); }
__device__ __forceinline__ float fsigmoid(float x) { return __builtin_amdgcn_rcpf(1.0f + __expf(-x)); }
__device__ __forceinline__ float fsilu(float x) { return x * fsigmoid(x); }
__device__ __forceinline__ float wave_sum(float v) {
#pragma unroll
    for (int o = 1; o < 64; o <<= 1) v += __shfl_xor(v, o);
    return v;
}

#define XB_TMO      128
#define XB_XCNT(j)  (256  + 64 * (j))
#define XB_XSUB(j)  (1280 + 64 * (j))
#define XB_XGEN(j)  (2304 + 64 * (j))
#define XB_TOP      3328
#define XB_TOPGEN   3392
#define XCD_BAR_WORDS 3456
#define XB_SPIN_CAP (1u << 18)
__device__ __forceinline__ unsigned xb_ld(unsigned* p)              { return __hip_atomic_load(p, __ATOMIC_RELAXED, __HIP_MEMORY_SCOPE_AGENT); }
__device__ __forceinline__ unsigned xb_add(unsigned* p, unsigned v) { return __hip_atomic_fetch_add(p, v, __ATOMIC_RELAXED, __HIP_MEMORY_SCOPE_AGENT); }
__device__ __forceinline__ unsigned xb_xcc_id() { return (unsigned)__builtin_amdgcn_s_getreg((3 << 11) | 20) & 0xFu; }
#define XB_SPIN(cond, bar) do { unsigned _sp = 0; while (cond) { __builtin_amdgcn_s_sleep(1); \
    if ((++_sp & 255u) == 0u) { if (xb_ld(&(bar)[XB_TMO])) break; if (_sp > XB_SPIN_CAP) { atomicAdd(&(bar)[XB_TMO], 1u); break; } } } } while (0)
struct XcdBarrier { unsigned* bar; unsigned x; volatile LAS unsigned* st; };
__device__ __forceinline__ XcdBarrier xcd_barrier_post(unsigned* bar, volatile LAS unsigned* st) {
    XcdBarrier b; b.bar = bar; b.x = xb_xcc_id(); b.st = st;
    if (threadIdx.x == 0) (void)xb_add(&bar[XB_XCNT(b.x)], 1u);
    return b;
}
__device__ __forceinline__ void xcd_barrier_complete(unsigned* bar, unsigned x, unsigned& nloc, unsigned& nx) {
    const unsigned G = gridDim.x * gridDim.y * gridDim.z;
    unsigned sum, cnt, mine, sp = 0u;
    for (;;) {
        sum = 0u; cnt = 0u; mine = 0u;
#pragma unroll
        for (unsigned j = 0; j < 16; ++j) { const unsigned c = xb_ld(&bar[XB_XCNT(j)]); sum += c; cnt += (c > 0u) ? 1u : 0u; mine = (j == x) ? c : mine; }
        if (sum == G) break;
        __builtin_amdgcn_s_sleep(1);
        if ((++sp & 255u) == 0u) { if (xb_ld(&bar[XB_TMO])) break; if (sp > XB_SPIN_CAP) { atomicAdd(&bar[XB_TMO], 1u); break; } }
    }
    nloc = mine > 0u ? mine : 1u; nx = cnt > 0u ? cnt : 1u;
}
__device__ __forceinline__ void xcd_barrier(const XcdBarrier& b) {
    asm volatile("s_waitcnt vmcnt(0)" ::: "memory");
    __syncthreads();
    if (threadIdx.x == 0) {
        unsigned* bar = b.bar;
        __builtin_amdgcn_s_waitcnt(0);
        unsigned nloc = b.st[0], nx = b.st[1];
        if (nloc == 0u) { xcd_barrier_complete(bar, b.x, nloc, nx); b.st[0] = nloc; b.st[1] = nx; }
        const unsigned old = xb_add(&bar[XB_XSUB(b.x)], 1u);
        const unsigned gen = old / nloc;
        if (old + 1u == (gen + 1u) * nloc) {
            __builtin_amdgcn_fence(__ATOMIC_RELEASE, "agent");
            asm volatile("s_waitcnt vmcnt(0)" ::: "memory");
            const unsigned og = xb_add(&bar[XB_TOP], 1u);
            const unsigned tg = og / nx;
            if (og + 1u == (tg + 1u) * nx) xb_add(&bar[XB_TOPGEN], 1u);
            else XB_SPIN(xb_ld(&bar[XB_TOPGEN]) == tg, bar);
            __builtin_amdgcn_fence(__ATOMIC_ACQUIRE, "agent");
            xb_add(&bar[XB_XGEN(b.x)], 1u);
            asm volatile("s_waitcnt vmcnt(0)" ::: "memory");
        } else {
            XB_SPIN(xb_ld(&bar[XB_XGEN(b.x)]) == gen, bar);
            __builtin_amdgcn_fence(__ATOMIC_ACQUIRE, "agent");
            asm volatile("s_waitcnt vmcnt(0)" ::: "memory");
        }
    }
    __syncthreads();
}

__device__ __forceinline__ void glds16s(const void* sbase, unsigned voff, unsigned lds_dst) {
    unsigned keep;
    asm volatile("s_mov_b32 %0, m0\n\ts_mov_b32 m0, %3\n\ts_nop 0\n\tglobal_load_lds_dwordx4 %1, %2\n\ts_mov_b32 m0, %0" : "=&s"(keep) : "v"(voff), "s"(sbase), "s"(lds_dst) : "memory");
}
namespace pg8 {
constexpr int BM = 256, BK = 64, HALF = 128, HTB = HALF * BK * 2, NXCD = 8, WGM = 8;
__host__ __device__ __forceinline__ int lds_byte(int r, int c) { const int st = (r >> 4) * 2 + (c >> 5), rr = r & 15, cc = c & 31, ob = rr * 64 + cc * 2; return st * 1024 + (ob ^ (((ob >> 9) & 1) << 5)); }
__host__ __device__ __forceinline__ void stage_rc(int b, int& R, int& C) { const int st = b / 1024, sb = b % 1024, swz = sb ^ (((sb >> 9) & 1) << 5); R = (st >> 1) * 16 + swz / 64; C = (st & 1) * 32 + (swz % 64) / 2; }
__host__ __device__ __forceinline__ int perm32(int rho) { const int n = rho >> 4, i = rho & 15; return 8 * (i >> 2) + 4 * n + (i & 3); }
struct Unit { int pm, pn, e, row0, rows; };

struct DenseSched {
    int nM, nN, nwg, G, c; unsigned rowbytes; int arow0; const char* Bt;
    __device__ void init(int M, int N, int Kbytes, int G_, int c_, const void* Bt_, int arow0_ = 0) { nM = M / BM; nN = N / BM; nwg = nM * nN; G = G_; c = c_; rowbytes = (unsigned)Kbytes; arow0 = arow0_; Bt = (const char*)Bt_; }
    __device__ __forceinline__ bool next(int i, Unit& u) const {
        const long L = (long)i * G + c; if (L >= nwg) return false;
        int wgid = (int)L; { const int q = nwg / NXCD, r = nwg % NXCD, xcd = wgid % NXCD, off = wgid / NXCD; wgid = (xcd < r ? xcd * (q + 1) : r * (q + 1) + (xcd - r) * q) + off; }
        const int nig = WGM * nN, gid = wgid / nig, fm = gid * WGM, gsz = (nM - fm) < WGM ? (nM - fm) : WGM;
        u.pm = fm + ((wgid % nig) % gsz); u.pn = (wgid % nig) / gsz; u.e = 0; u.row0 = u.pm * BM; u.rows = BM; return true;
    }
    __device__ __forceinline__ unsigned a_off(const Unit& u, int r) const { return (unsigned)(arow0 + u.pm * BM + r) * rowbytes; }
    __device__ __forceinline__ const char* b_base(const Unit& u) const { return Bt + (size_t)u.pn * BM * rowbytes; }
};
template <int NPN, bool GATHER>
struct RoutedSched {
    const LAS int* tab; int ntiles, G, c; unsigned rowbytes; const char* Bt; size_t estride; const int* rowlist;
    __device__ __forceinline__ bool next(int i, Unit& u) const {
        const long L = (long)i * G + c; if (L >= (long)ntiles * NPN) return false;
        const int ti = (int)(L / NPN); u.pn = (int)(L % NPN); u.pm = ti;
        u.e = __builtin_amdgcn_readfirstlane(tab[ti * 4 + 0]); u.row0 = __builtin_amdgcn_readfirstlane(tab[ti * 4 + 1]); u.rows = __builtin_amdgcn_readfirstlane(tab[ti * 4 + 2]); return true;
    }
    __device__ __forceinline__ unsigned a_off(const Unit& u, int r) const {
        const int s = u.row0 + r;
        if (GATHER) return (unsigned)rowlist[s] * rowbytes; else return (unsigned)s * rowbytes;
    }
    __device__ __forceinline__ const char* b_base(const Unit& u) const { return Bt + (size_t)u.e * estride + (size_t)u.pn * BM * rowbytes; }
};

struct RouterSched {
    int n, G, c; const char* Bt;
    __device__ __forceinline__ bool next(int i, Unit& u) const { const long L = (long)i * G + c; if (L >= n) return false; u.pm = (int)L; u.pn = 0; u.e = 0; u.row0 = u.pm * BM; u.rows = BM; return true; }
    __device__ __forceinline__ unsigned a_off(const Unit& u, int r) const { return (unsigned)(u.pm * BM + r) * 2048u; }
    __device__ __forceinline__ const char* b_base(const Unit& u) const { return Bt + (size_t)(u.pm >> 4) * (256 * 2048); }
};

template <bool ALIGN_EPI, bool FP8, class Epi, class Sched, int CM = 1>
__device__ __forceinline__ void gemm_phase(LAS unsigned char* lds, const char* Abase, const int Kbytes, const Sched& S, const Epi& E, const int scaleW = 0x7F7F7F7F, const int scaleX = 0x7F7F7F7F) {
    int tid = threadIdx.x; asm volatile("" : "+v"(tid));
    const int wid = __builtin_amdgcn_readfirstlane(tid >> 6), lane = tid & 63, wr = wid >> 2, wc = wid & 3, fr = lane & 15, fq = lane >> 4;
    const int nt = Kbytes / (BK * 2);
    unsigned voffB[2];
#pragma unroll
    for (int i = 0; i < 2; ++i) { int R, C; stage_rc(tid * 16 + i * 8192, R, C); const int Rb = (CM == 2) ? 2 * (R & ~31) + 16 * ((R & 15) >> 2) + 4 * ((R >> 4) & 1) + (R & 3) : (CM == 3) ? 2 * (R & ~31) + (R & 31) : (CM ? 2 * (R & ~31) : (R & ~31)) + perm32(R & 31); voffB[i] = (unsigned)(Rb * Kbytes + C * 2); }
    const size_t kstep = (size_t)(BK * 2);
    const size_t hstepB = (size_t)(CM == 2 ? 8 : CM ? 32 : HALF) * Kbytes;
    const unsigned ldsw = (unsigned)wid * 1024u;
    const unsigned lds0 = (unsigned)(uintptr_t)lds;
    const int aoff = lds_byte(wr * 64 + fr, fq * 8), boff = lds_byte(wc * 32 + fr, fq * 8);
#define PG8_SA(b, h) (((b) * 2 + (h)) * HTB)
#define PG8_SB(b, h) ((4 + (b) * 2 + (h)) * HTB)
#define PG8_STAGE(bufoff, gbase, voff) do { _Pragma("unroll") for (int _i = 0; _i < 2; ++_i) \
        glds16s((const void*)(gbase), (voff)[_i], lds0 + (unsigned)((bufoff) + _i * 8192) + ldsw); } while (0)
#define PG8_LD2(p) __builtin_shufflevector(*(const LAS v4i_t*)(p), *(const LAS v4i_t*)((p) + 1024), 0, 1, 2, 3, 4, 5, 6, 7)
#define PG8_LDA(dst, b, h) do { _Pragma("unroll") for (int m = 0; m < 4; ++m) dst[m] = PG8_LD2(lds + PG8_SA(b, h) + aoff + m * 2048); } while (0)
#define PG8_LDB(dst, b, h) do { _Pragma("unroll") for (int n = 0; n < 2; ++n) dst[n] = PG8_LD2(lds + PG8_SB(b, h) + boff + n * 2048); } while (0)
#define PG8_LO(v) __builtin_bit_cast(bf16x8, __builtin_shufflevector(v, v, 0, 1, 2, 3))
#define PG8_HI(v) __builtin_bit_cast(bf16x8, __builtin_shufflevector(v, v, 4, 5, 6, 7))
#define PG8_MMA(ai, bj, At, Bt) do { __builtin_amdgcn_s_setprio(1); _Pragma("unroll") for (int m = 0; m < 4; ++m) _Pragma("unroll") for (int n = 0; n < 2; ++n) { \
        if constexpr (FP8) acc[ai][bj][m][n] = __builtin_amdgcn_mfma_scale_f32_16x16x128_f8f6f4(Bt[n], At[m], acc[ai][bj][m][n], 0, 0, 0, scaleW, 0, scaleX); \
        else { acc[ai][bj][m][n] = __builtin_amdgcn_mfma_f32_16x16x32_bf16(PG8_LO(Bt[n]), PG8_LO(At[m]), acc[ai][bj][m][n], 0, 0, 0); acc[ai][bj][m][n] = __builtin_amdgcn_mfma_f32_16x16x32_bf16(PG8_HI(Bt[n]), PG8_HI(At[m]), acc[ai][bj][m][n], 0, 0, 0); } } __builtin_amdgcn_s_setprio(0); } while (0)
#define PG8_WAIT_V(n) asm volatile("s_waitcnt vmcnt(" #n ")" ::: "memory")
#define PG8_WAIT_L(n) asm volatile("s_waitcnt lgkmcnt(" #n ")" ::: "memory")
#define PG8_BAR __builtin_amdgcn_s_barrier()
#define PG8_SCHED __builtin_amdgcn_sched_barrier(0)
#define PG8_AOFF(u, o0, o1) do { int _t = tid; asm volatile("" : "+v"(_t)); _Pragma("unroll") for (int _i = 0; _i < 2; ++_i) { int _R, _C; stage_rc(_t * 16 + _i * 8192, _R, _C); \
        o0[_i] = S.a_off(u, _R) + (unsigned)_C * 2u; o1[_i] = S.a_off(u, _R + HALF) + (unsigned)_C * 2u; } } while (0)
    Unit cur, nxt; int ui = 0;
    if (!S.next(0, cur)) return;
    f32x4 acc[2][2][4][2];
#pragma unroll
    for (int a = 0; a < 2; ++a)
#pragma unroll
        for (int b = 0; b < 2; ++b)
#pragma unroll
            for (int m = 0; m < 4; ++m)
#pragma unroll
                for (int n = 0; n < 2; ++n) acc[a][b][m][n] = (f32x4){0.f, 0.f, 0.f, 0.f};
    v8i At[4], B0[2], B1[2];
    unsigned cA0[2], cA1[2];
    PG8_AOFF(cur, cA0, cA1);
    const char* cB = S.b_base(cur); const char* nB = cB;
    PG8_STAGE(PG8_SB(0, 0), cB, voffB); PG8_STAGE(PG8_SB(0, 1), cB + hstepB, voffB); PG8_STAGE(PG8_SA(0, 0), Abase, cA0); PG8_STAGE(PG8_SA(0, 1), Abase, cA1);
    if (wr == 1) PG8_BAR;
    PG8_WAIT_V(2); PG8_BAR;
    PG8_STAGE(PG8_SB(1, 0), cB + kstep, voffB); PG8_STAGE(PG8_SA(1, 0), Abase + kstep, cA0); PG8_STAGE(PG8_SB(1, 1), cB + hstepB + kstep, voffB);
    PG8_WAIT_V(6); PG8_BAR;
    for (;;) {
        const bool has_next = S.next(ui + 1, nxt);
#pragma unroll 1
        for (int t = 0; t < nt; t += 2) {
            const bool last = (t == nt - 2);
            if constexpr (Epi::MID_T > 0) { if (t == Epi::MID_T) { PG8_SCHED; E.mid(acc, cur, wr, wc, fr, fq); PG8_SCHED; } }
            if (last && has_next) nB = S.b_base(nxt);
            const char* a1 = Abase + (size_t)(t + 1) * kstep;
            const char* a2 = last ? Abase : Abase + (size_t)(t + 2) * kstep; const char* b2 = last ? nB : cB + (size_t)(t + 2) * kstep;
            const char* a3 = a2 + kstep; const char* b3 = b2 + kstep;
            PG8_LDB(B0, 0, 0); PG8_LDB(B1, 0, 1); PG8_SCHED; PG8_LDA(At, 0, 0); PG8_STAGE(PG8_SA(1, 1), a1, cA1);
            if (last && has_next) { PG8_AOFF(nxt, cA0, cA1); }
            PG8_WAIT_V(8); PG8_WAIT_L(0); PG8_BAR; PG8_MMA(0, 0, At, B0); PG8_MMA(0, 1, At, B1); PG8_BAR; PG8_SCHED;
            PG8_LDA(At, 0, 1); PG8_STAGE(PG8_SB(0, 0), b2, voffB); PG8_STAGE(PG8_SB(0, 1), b2 + hstepB, voffB); PG8_STAGE(PG8_SA(0, 0), a2, cA0);
            PG8_WAIT_V(8); PG8_WAIT_L(0); PG8_BAR; PG8_MMA(1, 0, At, B0); PG8_MMA(1, 1, At, B1); PG8_BAR; PG8_SCHED;
            PG8_LDB(B0, 1, 0); PG8_LDB(B1, 1, 1); PG8_SCHED; PG8_LDA(At, 1, 0); PG8_STAGE(PG8_SA(0, 1), a2, cA1);
            PG8_WAIT_V(8); PG8_WAIT_L(0); PG8_BAR; PG8_MMA(0, 0, At, B0); PG8_MMA(0, 1, At, B1); PG8_BAR; PG8_SCHED;
            PG8_LDA(At, 1, 1); PG8_STAGE(PG8_SB(1, 0), b3, voffB); PG8_STAGE(PG8_SB(1, 1), b3 + hstepB, voffB); PG8_STAGE(PG8_SA(1, 0), a3, cA0);
            PG8_WAIT_V(8); PG8_WAIT_L(0); PG8_BAR; PG8_MMA(1, 0, At, B0); PG8_MMA(1, 1, At, B1); PG8_BAR; PG8_SCHED;
        }
        if constexpr (ALIGN_EPI) { if (wr == 0) PG8_BAR; }
        { Unit eu = cur; int efr = fr, efq = fq; asm volatile("" : "+s"(eu.pm), "+s"(eu.pn), "+s"(eu.e), "+s"(eu.row0), "+s"(eu.rows), "+v"(efr), "+v"(efq)); E(acc, eu, wr, wc, efr, efq); }
        if (!has_next) break;
#pragma unroll
        for (int a = 0; a < 2; ++a)
#pragma unroll
            for (int b = 0; b < 2; ++b)
#pragma unroll
                for (int m = 0; m < 4; ++m)
#pragma unroll
                    for (int n = 0; n < 2; ++n) acc[a][b][m][n] = (f32x4){0.f, 0.f, 0.f, 0.f};
        cur = nxt; cB = nB; ++ui;
        if constexpr (ALIGN_EPI) { if (wr == 1) PG8_BAR; }
    }
    PG8_WAIT_V(0);
    if constexpr (!ALIGN_EPI) { if (wr == 0) PG8_BAR; }
    PG8_BAR;
#undef PG8_SA
#undef PG8_SB
#undef PG8_STAGE
#undef PG8_LDA
#undef PG8_LDB
#undef PG8_MMA
#undef PG8_LO
#undef PG8_HI
#undef PG8_LD2
#undef PG8_WAIT_V
#undef PG8_WAIT_L
#undef PG8_BAR
#undef PG8_SCHED
#undef PG8_AOFF
}

constexpr int WCS = 64, BJS = 32;
#define EPI_ROWS_BEGIN _Pragma("unroll") for (int ai = 0; ai < 2; ++ai) _Pragma("unroll") for (int m = 0; m < 4; ++m) { const int rt = ai * HALF + wr * 64 + m * 16 + fr;
#define EPI_ROWS_END }
__device__ __forceinline__ v4u pack8(const f32x4 a, const f32x4 b) { v4u w; w.x = cvt_pk_bf16(a[0], a[1]); w.y = cvt_pk_bf16(a[2], a[3]); w.z = cvt_pk_bf16(b[0], b[1]); w.w = cvt_pk_bf16(b[2], b[3]); return w; }

__device__ __forceinline__ v2u act8_fp8(const f32x4 a, const f32x4 b, const bool silu) {
    const float sc = (float)(1 << SH_G); float x[8] = {a[0], a[1], a[2], a[3], b[0], b[1], b[2], b[3]};
#pragma unroll
    for (int j = 0; j < 8; ++j) { const float sg = fsigmoid(x[j]); x[j] = (silu ? x[j] * sg : sg) * sc; }
    v2u w; w.x = cvt4_fp8(x[0], x[1], x[2], x[3]); w.y = cvt4_fp8(x[4], x[5], x[6], x[7]); return w;
}
struct EpiWin { static constexpr int MID_T = 0;
    unsigned char *QF8, *AQKV8, *GAB8, *HG8; int dry;
    __device__ __forceinline__ void operator()(const f32x4 (&acc)[2][2][4][2], const Unit& u, int wr, int wc, int fr, int fq) const {
        if (dry) return;
        if (u.pn >= 17 || u.pn == 6 || u.pn == 7) {
            const bool silu = u.pn < 8; unsigned char* base = silu ? HG8 : GAB8; const int ldc = silu ? 512 : 2048, ct = silu ? u.pn - 6 : u.pn - 17;
            const int col0 = ct * BM + wc * 64 + 16 * fq;
            EPI_ROWS_BEGIN { unsigned char* rowp = base + (size_t)(u.pm * BM + rt) * ldc + col0;
                const v2u lo = act8_fp8(acc[ai][0][m][0], acc[ai][0][m][1], silu), hi = act8_fp8(acc[ai][1][m][0], acc[ai][1][m][1], silu);
                *(v4u*)rowp = (v4u){lo.x, lo.y, hi.x, hi.y}; } EPI_ROWS_END
            return;
        }
        unsigned char* base; int ldc, ct;
        if (u.pn < 8) { base = QF8; ldc = 1536; ct = u.pn; } else { base = AQKV8; ldc = 2304; ct = u.pn - 8; }
        const int col0 = ct * BM + wc * 64 + 16 * fq; const float sq = (float)(1 << SH_Q);
        EPI_ROWS_BEGIN { unsigned char* rowp = base + (size_t)(u.pm * BM + rt) * ldc + col0;
            const f32x4 a = acc[ai][0][m][0] * sq, b = acc[ai][0][m][1] * sq, c = acc[ai][1][m][0] * sq, d = acc[ai][1][m][1] * sq;
            *(v4u*)rowp = (v4u){cvt4_fp8(a[0], a[1], a[2], a[3]), cvt4_fp8(b[0], b[1], b[2], b[3]), cvt4_fp8(c[0], c[1], c[2], c[3]), cvt4_fp8(d[0], d[1], d[2], d[3])}; } EPI_ROWS_END
    }
};
template <bool ADD> struct EpiBranch { static constexpr int MID_T = 0;
    const unsigned char* G; int goff; bf16* O;
    __device__ __forceinline__ void operator()(const f32x4 (&acc)[2][2][4][2], const Unit& u, int wr, int wc, int fr, int fq) const {
        const int col0 = u.pn * BM + wc * WCS + 8 * fq;
        EPI_ROWS_BEGIN { const size_t row = (size_t)(u.pm * BM + rt);
#pragma unroll
            for (int bj = 0; bj < 2; ++bj) {
                const v2u g = *(const v2u*)(G + row * 2048 + goff + col0 + bj * BJS); const float gs = 1.0f / (float)(1 << SH_G);
                const f32x2_t g0 = __builtin_amdgcn_cvt_pk_f32_fp8((int)g.x, false), g1 = __builtin_amdgcn_cvt_pk_f32_fp8((int)g.x, true), g2 = __builtin_amdgcn_cvt_pk_f32_fp8((int)g.y, false), g3 = __builtin_amdgcn_cvt_pk_f32_fp8((int)g.y, true);
                f32x4 a = acc[ai][bj][m][0] * (f32x4){g0[0], g0[1], g1[0], g1[1]} * gs, b = acc[ai][bj][m][1] * (f32x4){g2[0], g2[1], g3[0], g3[1]} * gs;
                bf16* op = O + row * 1024 + col0 + bj * BJS;
                if (ADD) { const v4u o = *(const v4u*)op; a[0] += bflo(o.x); a[1] += bfhi(o.x); a[2] += bflo(o.y); a[3] += bfhi(o.y); b[0] += bflo(o.z); b[1] += bfhi(o.z); b[2] += bflo(o.w); b[3] += bfhi(o.w); }
                *(v4u*)op = pack8(a, b); } } EPI_ROWS_END
    }
};
struct EpiMerge {
    static constexpr int MID_T = 4;
    const unsigned char* G; unsigned char* O;
    __device__ __forceinline__ static void dec8(const v2u g, float (&f)[8]) { const f32x2_t a = __builtin_amdgcn_cvt_pk_f32_fp8((int)g.x, false), b = __builtin_amdgcn_cvt_pk_f32_fp8((int)g.x, true), c = __builtin_amdgcn_cvt_pk_f32_fp8((int)g.y, false), d = __builtin_amdgcn_cvt_pk_f32_fp8((int)g.y, true);
        f[0] = a[0]; f[1] = a[1]; f[2] = b[0]; f[3] = b[1]; f[4] = c[0]; f[5] = c[1]; f[6] = d[0]; f[7] = d[1]; }
    __device__ __forceinline__ void mid(f32x4 (&acc)[2][2][4][2], const Unit& u, int wr, int wc, int fr, int fq) const {
        const int col0 = u.pn * BM + wc * 64 + 16 * fq;
        EPI_ROWS_BEGIN { const size_t row = (size_t)(u.pm * BM + rt);
            const v4u ga = *(const v4u*)(G + row * 2048 + col0), gb = *(const v4u*)(G + row * 2048 + 1024 + col0);
#pragma unroll
            for (int bj = 0; bj < 2; ++bj) { float sa[8], sb[8]; dec8(bj ? (v2u){ga.z, ga.w} : (v2u){ga.x, ga.y}, sa); dec8(bj ? (v2u){gb.z, gb.w} : (v2u){gb.x, gb.y}, sb);
#pragma unroll
                for (int j = 0; j < 4; ++j) { acc[ai][bj][m][0][j] *= sa[j] * __builtin_amdgcn_rcpf(fmaxf(sb[j], 0.001953125f)); acc[ai][bj][m][1][j] *= sa[4 + j] * __builtin_amdgcn_rcpf(fmaxf(sb[4 + j], 0.001953125f)); } } } EPI_ROWS_END
    }
    __device__ __forceinline__ void operator()(const f32x4 (&acc)[2][2][4][2], const Unit& u, int wr, int wc, int fr, int fq) const {
        const int col0 = u.pn * BM + wc * 64 + 16 * fq;
        EPI_ROWS_BEGIN { const size_t row = (size_t)(u.pm * BM + rt);
            const v4u gb = *(const v4u*)(G + row * 2048 + 1024 + col0); unsigned ow[4];
#pragma unroll
            for (int bj = 0; bj < 2; ++bj) { float sb[8]; dec8(bj ? (v2u){gb.z, gb.w} : (v2u){gb.x, gb.y}, sb); const float gs = 1.0f / (float)(1 << SH_G);
                f32x4 a = acc[ai][bj][m][0], b = acc[ai][bj][m][1];
#pragma unroll
                for (int j = 0; j < 4; ++j) { a[j] *= fmaxf(sb[j], 0.001953125f) * (gs * (float)(1 << SH_M)); b[j] *= fmaxf(sb[4 + j], 0.001953125f) * (gs * (float)(1 << SH_M)); }
                ow[2 * bj] = cvt4_fp8(a[0], a[1], a[2], a[3]); ow[2 * bj + 1] = cvt4_fp8(b[0], b[1], b[2], b[3]); }
            *(v4u*)(O + row * 1024 + col0) = (v4u){ow[0], ow[1], ow[2], ow[3]}; } EPI_ROWS_END
    }
};
struct EpiOut { static constexpr int MID_T = 0;
    const float* x; bf16* x1; const float* mod;
    __device__ __forceinline__ void operator()(const f32x4 (&acc)[2][2][4][2], const Unit& u, int wr, int wc, int fr, int fq) const {
        const int col0 = u.pn * BM + wc * WCS + 8 * fq; const int b = u.pm >> 4;
        f32x4 gt[2][2];
#pragma unroll
        for (int bj = 0; bj < 2; ++bj)
#pragma unroll
            for (int n = 0; n < 2; ++n) { const int c = 2048 + col0 + bj * BJS + 4 * n; gt[bj][n] = *(const f32x4*)(mod + b * 6144 + c); }
        EPI_ROWS_BEGIN { const size_t off = (size_t)(u.pm * BM + rt) * 1024 + col0;
#pragma unroll
            for (int bj = 0; bj < 2; ++bj) { const size_t o2 = off + bj * BJS;
                *(v4u*)(x1 + o2) = pack8(*(const f32x4*)(x + o2) + gt[bj][0] * acc[ai][bj][m][0], *(const f32x4*)(x + o2 + 4) + gt[bj][1] * acc[ai][bj][m][1]); } } EPI_ROWS_END
    }
};
__device__ __forceinline__ v4u swiglu8(const f32x4 g0, const f32x4 g1, const f32x4 u0, const f32x4 u1) {
    f32x4 a, b;
#pragma unroll
    for (int j = 0; j < 4; ++j) { a[j] = fsilu(g0[j]) * u0[j]; b[j] = fsilu(g1[j]) * u1[j]; }
    return pack8(a, b);
}
__device__ __forceinline__ v2u swiglu8_fp8(const f32x4 g0, const f32x4 g1, const f32x4 u0, const f32x4 u1) {
    const float sc = (float)(1 << SH_HMID); float a[4], b[4];
#pragma unroll
    for (int j = 0; j < 4; ++j) { a[j] = fsilu(g0[j]) * u0[j] * sc; b[j] = fsilu(g1[j]) * u1[j] * sc; }
    v2u w; w.x = cvt4_fp8(a[0], a[1], a[2], a[3]); w.y = cvt4_fp8(b[0], b[1], b[2], b[3]); return w;
}
struct EpiRS { static constexpr int MID_T = 0;
    float* logits; unsigned char* hsh;
    __device__ __forceinline__ void operator()(const f32x4 (&acc)[2][2][4][2], const Unit& u, int wr, int wc, int fr, int fq) const {
        if (u.pn == 0) {
            EPI_ROWS_BEGIN { float* rowp = logits + (size_t)(u.pm * BM + rt) * 256 + wc * WCS + 8 * fq;
#pragma unroll
                for (int bj = 0; bj < 2; ++bj)
#pragma unroll
                    for (int n = 0; n < 2; ++n) *(f32x4*)(rowp + bj * BJS + 4 * n) = acc[ai][bj][m][n]; } EPI_ROWS_END
        } else {
            const int hc = (u.pn - 1) * HALF + wc * WCS + 8 * fq;
            EPI_ROWS_BEGIN { *(v2u*)(hsh + (size_t)(u.pm * BM + rt) * 256 + hc) = swiglu8_fp8(acc[ai][0][m][0], acc[ai][0][m][1], acc[ai][1][m][0], acc[ai][1][m][1]); } EPI_ROWS_END
        }
    }
};
struct EpiRL { static constexpr int MID_T = 0;
    float* logits;
    __device__ __forceinline__ void operator()(const f32x4 (&acc)[2][2][4][2], const Unit& u, int wr, int wc, int fr, int fq) const {
        EPI_ROWS_BEGIN { float* rowp = logits + (size_t)(u.pm * BM + rt) * 256 + wc * 64 + 4 * fq;
#pragma unroll
            for (int bj = 0; bj < 2; ++bj)
#pragma unroll
                for (int n = 0; n < 2; ++n) *(f32x4*)(rowp + bj * 32 + 16 * n) = acc[ai][bj][m][n]; } EPI_ROWS_END
    }
};
struct EpiGU { static constexpr int MID_T = 0;
    unsigned char* hmid;
    __device__ __forceinline__ void operator()(const f32x4 (&acc)[2][2][4][2], const Unit& u, int wr, int wc, int fr, int fq) const {
        const int hc = u.pn * HALF + wc * 32 + 8 * fq;
        EPI_ROWS_BEGIN { if (rt < u.rows) *(v2u*)(hmid + (size_t)(u.row0 + rt) * 256 + hc) = swiglu8_fp8(acc[ai][0][m][0], acc[ai][0][m][1], acc[ai][1][m][0], acc[ai][1][m][1]); } EPI_ROWS_END
    }
};
struct EpiSD { static constexpr int MID_T = 0;
    bf16* ysh;
    __device__ __forceinline__ void operator()(const f32x4 (&acc)[2][2][4][2], const Unit& u, int wr, int wc, int fr, int fq) const {
        const int col0 = u.pn * BM + wc * WCS + 8 * fq;
        EPI_ROWS_BEGIN { bf16* rowp = ysh + (size_t)(u.pm * BM + rt) * 1024 + col0;
#pragma unroll
            for (int bj = 0; bj < 2; ++bj) *(v4u*)(rowp + bj * BJS) = pack8(acc[ai][bj][m][0], acc[ai][bj][m][1]); } EPI_ROWS_END
    }
};
struct EpiRD { static constexpr int MID_T = 0;
    unsigned char* yslot; const float* slot_w;
    __device__ __forceinline__ void operator()(const f32x4 (&acc)[2][2][4][2], const Unit& u, int wr, int wc, int fr, int fq) const {
        const int col0 = u.pn * BM + wc * 64 + 16 * fq;
        EPI_ROWS_BEGIN { if (rt < u.rows) { const float w = (float)(1 << SH_Y); unsigned char* rowp = yslot + (size_t)(u.row0 + rt) * 1024 + col0;
            const f32x4 a = acc[ai][0][m][0] * w, b = acc[ai][0][m][1] * w, c = acc[ai][1][m][0] * w, d = acc[ai][1][m][1] * w;
            *(v4u*)rowp = (v4u){cvt4_fp8(a[0], a[1], a[2], a[3]), cvt4_fp8(b[0], b[1], b[2], b[3]), cvt4_fp8(c[0], c[1], c[2], c[3]), cvt4_fp8(d[0], d[1], d[2], d[3])}; } } EPI_ROWS_END
    }
};
}

struct Args { const float* in[21]; float* out; unsigned char* ws; int ph_lo, ph_hi; };
struct Frame {
    LAS unsigned char* lds; volatile LAS unsigned* MISC; gu32* ctl;
    int tid, lane, wave, vcu, G, gw, NGW;
};

__device__ __forceinline__ void transpose_item(const float* W, int ldn, bf16* WT, int ldk, int k0, int n0, int drow0, LAS float* scr, int lane) {
#pragma unroll 8
    for (int i = 0; i < 32; ++i) { const int kk = 2 * i + (lane >> 5); scr[kk * 33 + (lane & 31)] = W[(size_t)(k0 + kk) * ldn + n0 + (lane & 31)]; }
    LDS_WAIT(); asm volatile("" ::: "memory");
    const int c = lane & 7;
#pragma unroll
    for (int j = 0; j < 4; ++j) { const int n = (lane >> 3) + 8 * j; const LAS float* s = scr + (8 * c) * 33 + n;
        v4u o; o.x = cvt_pk_bf16(s[0 * 33], s[1 * 33]); o.y = cvt_pk_bf16(s[2 * 33], s[3 * 33]); o.z = cvt_pk_bf16(s[4 * 33], s[5 * 33]); o.w = cvt_pk_bf16(s[6 * 33], s[7 * 33]);
        *(GAS v4u*)(WT + (size_t)(drow0 + n) * ldk + k0 + 8 * c) = o; }
    LDS_WAIT(); asm volatile("" ::: "memory");
}
struct ConvDesc { const float* W; unsigned char* WT; int ldn, ldk, k0, n0, drow0; float scale; };
__device__ __forceinline__ void ti_load(const ConvDesc& d, int lane, f32x4 (&r)[16]) {
#pragma unroll
    for (int i = 0; i < 16; ++i) r[i] = *(const f32x4*)(d.W + (size_t)(d.k0 + 8 * i + (lane >> 3)) * d.ldn + d.n0 + (lane & 7) * 4);
}
#ifndef TR8_MAP
#define TR8_MAP 0
#endif
typedef int v2i_t __attribute__((ext_vector_type(2)));
__device__ __forceinline__ void ti_store(const ConvDesc& d, const f32x4 (&r)[16], LAS float* scr, int lane) {
    LAS unsigned char* Tl = (LAS unsigned char*)scr; const float sc = d.scale;
#pragma unroll
    for (int i = 0; i < 16; ++i) *(LAS unsigned*)(Tl + (8 * i + (lane >> 3)) * 32 + (lane & 7) * 4) = cvt4_fp8(r[i][0] * sc, r[i][1] * sc, r[i][2] * sc, r[i][3] * sc);
    LDS_WAIT(); asm volatile("" ::: "memory");
    const int g = lane >> 4, l = lane & 15, nh = g & 1, ch = g >> 1, n = 16 * nh + l;
    const int rr = TR8_MAP ? (l & 7) : (l >> 1), cc = TR8_MAP ? (l >> 3) : (l & 1);
    LAS unsigned char* T2 = Tl + 4096;
#pragma unroll
    for (int j = 0; j < 4; ++j) { const int c = 4 * ch + j;
        const v2i_t lo = __builtin_amdgcn_ds_read_tr8_b64_v2i32((LAS v2i_t*)(Tl + (16 * c + rr) * 32 + 16 * nh + 8 * cc));
        const v2i_t hi = __builtin_amdgcn_ds_read_tr8_b64_v2i32((LAS v2i_t*)(Tl + (16 * c + 8 + rr) * 32 + 16 * nh + 8 * cc));
        *(LAS v4u*)(T2 + n * 144 + 16 * c) = (v4u){(unsigned)lo.x, (unsigned)lo.y, (unsigned)hi.x, (unsigned)hi.y}; }
    LDS_WAIT(); asm volatile("" ::: "memory");
#pragma unroll
    for (int j = 0; j < 4; ++j) { const int n2 = (lane >> 3) + 8 * j, c2 = lane & 7;
        *(GAS v4u*)(d.WT + (size_t)(d.drow0 + n2) * d.ldk + d.k0 + 16 * c2) = *(const LAS v4u*)(T2 + n2 * 144 + 16 * c2); }
    LDS_WAIT(); asm volatile("" ::: "memory");
}
__device__ __forceinline__ ConvDesc conv_desc_fp8(const float* W, int K, int N, unsigned char* WT, int mode, int rowbase, int item, float scale) {
    const int nblk = N / 32, kb = item / nblk, nb = item % nblk, k0 = 128 * kb, n0 = 32 * nb;
    int drow0 = rowbase + n0;
    if (mode) drow0 = rowbase + (n0 >> 5) * 64 + (mode - 1) * 32;
    return ConvDesc{W, WT, N, K, k0, n0, drow0, scale};
}
__device__ __forceinline__ void conv_item(const float* W, int K, int N, bf16* WT, int mode, int rowbase, int item, LAS float* scr, int lane) {
    const int nblk = N / 32, kb = item / nblk, nb = item % nblk, k0 = 64 * kb, n0 = 32 * nb;
    int drow0 = rowbase + n0;
    if (mode) drow0 = rowbase + (n0 >> 7) * 256 + (mode - 1) * 128 + (n0 & 127);
    transpose_item(W, N, WT, K, k0, n0, drow0, scr, lane);
}

__global__ void __launch_bounds__(NWAVES * 64, 2) mk_fwd(Args args) {
    extern __shared__ __attribute__((aligned(16))) unsigned char lds_raw[];
    Frame F;
    F.lds = (LAS unsigned char*)lds_raw;
    F.MISC = (volatile LAS unsigned*)(F.lds + MISC_OFF);
    F.tid = threadIdx.x; F.lane = F.tid & 63; F.wave = __builtin_amdgcn_readfirstlane(F.tid >> 6);
    F.G = gridDim.x; { const int bx = blockIdx.x; F.vcu = (F.G % 8 == 0) ? (bx % 8) * (F.G / 8) + bx / 8 : bx; }
    F.gw = F.vcu * NWAVES + F.wave; F.NGW = F.G * NWAVES;
    unsigned char* ws = args.ws;
    F.ctl = (gu32*)(ws + WS_CTL);
    const int tid = F.tid, lane = F.lane, wave = F.wave;
    LAS unsigned char* lds = F.lds;

#define X_IN (args.in[0])
#define cvec (args.in[1])
#define ada_w (args.in[2])
#define ada_b (args.in[3])
#define norm1_g (args.in[4])
#define w_in (args.in[5])
#define lb_logits (args.in[6])
#define hg_norm_g (args.in[7])
#define w_branch_a (args.in[8])
#define w_branch_b (args.in[9])
#define w_out (args.in[10])
#define norm2_g (args.in[11])
#define w_router (args.in[12])
#define router_bias (args.in[13])
#define w_exp_gate (args.in[14])
#define w_exp_up (args.in[15])
#define w_exp_down (args.in[16])
#define w_sh_gate (args.in[17])
#define w_sh_up (args.in[18])
#define w_sh_down (args.in[19])
#define final_g (args.in[20])
#define out (args.out)
#define WIN_T ((bf16*)(ws + WS_WIN_T))
#define WA_T ((bf16*)(ws + WS_WA_T))
#define WB_T ((bf16*)(ws + WS_WB_T))
#define WO_T ((bf16*)(ws + WS_WO_T))
#define RS_T ((bf16*)(ws + WS_RS_T))
#define WSD_T ((bf16*)(ws + WS_WSD_T))
#define WD ((bf16*)(ws + WS_WD))
#define WGU ((bf16*)(ws + WS_WGU))
#define PE ((int*)(ws + WS_PE))
#define PR ((int*)(ws + WS_PR))
#define PW ((float*)(ws + WS_PW))
#define SLOT_TOK ((int*)(ws + WS_SLOT_TOK))
#define SLOT_W ((float*)(ws + WS_SLOT_W))
#define TOK_SLOT ((int*)(ws + WS_TOK_SLOT))
#define LSE ((float*)(ws + WS_LSE))
#define QF ((bf16*)(ws + WS_QF))
#define OA ((bf16*)(ws + WS_OA))
#define OG ((bf16*)(ws + WS_OG))
#define MERGED ((bf16*)(ws + WS_MERGED))
#define HMID ((bf16*)(ws + WS_HMID))
#define YSH (((unsigned char*)(ws + WS_YSLOT)) + (size_t)NSLOTP * 1024)
#define AQKV ((bf16*)(ws + WS_AQKV))
#define GAB ((bf16*)(ws + WS_GAB))
#define XN ((bf16*)(ws + WS_XN))
#define YA ((bf16*)(ws + WS_YA))
#define YB ((bf16*)(ws + WS_YB))
#define H2 ((bf16*)(ws + WS_H2))
#define LOGITS ((float*)(ws + WS_LOGITS))
#define YSLOT ((bf16*)(ws + WS_YSLOT))
#define MOD ((float*)(ws + WS_MOD))
#define HISTG ((unsigned*)(ws + WS_HISTG))
#define ATTQ (((unsigned*)(ws + WS_CTL)) + CW_ATTQ)
    for (int u = tid; u < 64; u += NWAVES * 64) ((LAS unsigned*)(lds + MISC_OFF))[u] = 0u;
    __syncthreads();
    XcdBarrier bar = xcd_barrier_post((unsigned*)(F.ctl + CW_BAR), F.MISC + 8);
    const int lo = args.ph_lo, hi = args.ph_hi;
#ifndef PHMASK
#define PHMASK 0x3fff
#endif
#define IN(k) (((PHMASK >> (k)) & 1) && lo <= (k) && (k) < hi)
#define SEAM(k) do { if (IN(k) && IN((k) + 1)) xcd_barrier(bar); } while (0)
#ifndef ALIGN_P2
#define ALIGN_P2 true
#endif
#ifndef ALIGN_P12
#define ALIGN_P12 true
#endif
#ifndef ALIGN_DEFAULT
#define ALIGN_DEFAULT true
#endif
#ifndef REPMASK
#define REPMASK 0
#endif
#ifndef CONV2_ITEMS
#define CONV2_ITEMS 42000
#endif
#ifndef DBG_H1_ST
#define DBG_H1_ST 1
#endif
#ifndef DBG_ATT_NOLOAD
#define DBG_ATT_NOLOAD 0
#endif
#ifndef TKI
#define TKI 8
#endif
#ifndef CONV11_ITEMS
#define CONV11_ITEMS 7000
#endif
#ifndef CONV11_MINWG
#define CONV11_MINWG 16
#endif
#ifndef P2_GEMM_WGS
#define P2_GEMM_WGS 178
#endif
#define REPS(k) (((REPMASK >> (k)) & 1) ? 2 : 1)
#define REP_BEGIN(k) _Pragma("unroll") for (int rep = 0; rep < REPS(k); ++rep) {
#define REP_END(k) if (rep + 1 < REPS(k)) xcd_barrier(bar); }

        constexpr int I_IN = 8 * 200, I_A = 4 * 32, I_B = 2 * 32, I_O = 8 * 32, I_SD = 2 * 32, I_E = 8 * 8, I_ED = 2 * 32;
        constexpr int NSMALL = I_IN + I_A + I_B + I_O + I_SD;
        constexpr int NITEMS = NSMALL + 2 * (NEXP + 1) * I_E + NEXP * I_ED;
    constexpr int NCONV2 = CONV2_ITEMS;
    const int NGB = (F.G == 256 && NCONV2 > 0) ? P2_GEMM_WGS : F.G;
    constexpr int NCONV11 = CONV11_ITEMS;
    static_assert(NITEMS - NCONV2 - NCONV11 >= I_IN, "the input-projection weights must be converted in P0");
    const int nitems0 = (NGB < F.G) ? NITEMS - NCONV2 - NCONV11 : NITEMS;
    auto conv_desc = [&](int it) __attribute__((always_inline)) -> ConvDesc {
            int r = it;
            if (r < I_IN) return conv_desc_fp8(w_in, 1024, NIN, (unsigned char*)WIN_T, 0, 0, r, (float)(1 << SH_WGU)); r -= I_IN;
            if (r < I_A) { const int kb = r / 32, nb = r % 32; return ConvDesc{w_branch_a, (unsigned char*)WA_T, 1024, 768, 128 * kb, 32 * nb, 32 * nb, (float)(1 << SH_WAB)}; } r -= I_A;
            if (r < I_B) { const int kb = r / 32, nb = r % 32; return ConvDesc{w_branch_b, (unsigned char*)WA_T + 512, 1024, 768, 128 * kb, 32 * nb, 32 * nb, (float)(1 << SH_WAB)}; } r -= I_B;
            if (r < I_O) return conv_desc_fp8(w_out, 1024, 1024, (unsigned char*)WO_T, 0, 0, r, (float)(1 << SH_WGU)); r -= I_O;
            if (r < I_SD) return conv_desc_fp8(w_sh_down, 256, 1024, (unsigned char*)WD, 0, NEXP * 1024, r, (float)(1 << SH_WD)); r -= I_SD;
            if (r < 2 * (NEXP + 1) * I_E) { const int seg = r / ((NEXP + 1) * I_E), rr = r % ((NEXP + 1) * I_E), e = rr / I_E, ii = rr % I_E;
                const float* src = (seg == 0) ? (e < NEXP ? w_exp_gate + (size_t)e * 1024 * 256 : w_sh_gate) : (e < NEXP ? w_exp_up + (size_t)e * 1024 * 256 : w_sh_up);
                return conv_desc_fp8(src, 1024, 256, (unsigned char*)WGU, seg + 1, e * 512, ii, (float)(1 << SH_WGU)); }
            r -= 2 * (NEXP + 1) * I_E; const int e = r / I_ED, ii = r % I_ED;
            return conv_desc_fp8(w_exp_down + (size_t)e * 256 * 1024, 256, 1024, (unsigned char*)WD, 0, e * 1024, ii, (float)(1 << SH_WD));
    };
    auto conv_run = [&](int first, int end, int stride, LAS float* scr) __attribute__((always_inline)) {
        int it = first; if (it >= end) return;
        ConvDesc d = conv_desc(it); f32x4 r[16]; ti_load(d, lane, r);
        for (;;) {
            const int nx = it + stride; const bool more = nx < end;
            ConvDesc dn = d; f32x4 rn[16];
            if (more) { dn = conv_desc(nx); ti_load(dn, lane, rn); }
            ti_store(d, r, scr, lane);
            if (!more) break;
            d = dn; it = nx;
#pragma unroll
            for (int i = 0; i < 16; ++i) r[i] = rn[i];
        }
    };

    if (IN(0)) { REP_BEGIN(0)
        {
            LAS float* sc = (LAS float*)lds; LAS float* red = (LAS float*)(lds + 32768);
            for (int i = tid; i < NB * D; i += NWAVES * 64) sc[i] = fsilu(cvec[i]);
            __syncthreads();
            _Pragma("unroll") for (int sr = 0; sr < (((REPMASK >> 19) & 1) ? 2 : 1); ++sr)
            for (int cbk = blockIdx.x; cbk < 256; cbk += F.G) {
                const int j0 = cbk * 24, kg = tid >> 3, cc = tid & 7;
                float a8[8][3];
#pragma unroll
                for (int b = 0; b < 8; ++b) { a8[b][0] = 0.f; a8[b][1] = 0.f; a8[b][2] = 0.f; }
                for (int r = 0; r < 16; ++r) { const int i = kg * 16 + r; const float* wp = ada_w + (size_t)i * 6144 + j0 + 3 * cc; const float w0 = wp[0], w1 = wp[1], w2 = wp[2];
#pragma unroll
                    for (int b = 0; b < 8; ++b) { const float sv = sc[b * 1024 + i]; a8[b][0] += sv * w0; a8[b][1] += sv * w1; a8[b][2] += sv * w2; } }
#pragma unroll
                for (int b = 0; b < 8; ++b) { red[(kg * 8 + b) * 24 + 3 * cc + 0] = a8[b][0]; red[(kg * 8 + b) * 24 + 3 * cc + 1] = a8[b][1]; red[(kg * 8 + b) * 24 + 3 * cc + 2] = a8[b][2]; }
                __syncthreads();
                if (tid < 192) { const int b = tid / 24, col = tid % 24; float sum = ada_b[j0 + col];
                    for (int g = 0; g < 64; ++g) sum += red[(g * 8 + b) * 24 + col];
                    MOD[b * 6144 + j0 + col] = sum; }
                __syncthreads();
            }
        }
        LAS float* scr = (LAS float*)(lds + wave * 16384);
        conv_run(F.gw, nitems0, F.NGW, scr);
    REP_END(0) }
    SEAM(0);

    if (IN(1)) { REP_BEGIN(1)
        for (int m0 = F.gw * 16; m0 < T; m0 += F.NGW * 16) {
            const int b = m0 >> 12;
            f32x4 mul[4], add[4];
#pragma unroll
            for (int j = 0; j < 4; ++j) { const int c = 4 * lane + 256 * j;
                const f32x4 s1 = *(const f32x4*)(MOD + b * 6144 + 1024 + c);
                mul[j] = *(const f32x4*)(norm1_g + c) * (s1 + 1.0f);
                add[j] = *(const f32x4*)(MOD + b * 6144 + c); }
            for (int m = m0; m < m0 + 16; ++m) {
                const GAS f32x4* xr = (const GAS f32x4*)(X_IN + (size_t)m * D) + lane;
                f32x4 v[4]; float s = 0.f;
#pragma unroll
                for (int j = 0; j < 4; ++j) { v[j] = xr[64 * j]; s += (v[j].x * v[j].x + v[j].y * v[j].y) + (v[j].z * v[j].z + v[j].w * v[j].w); }
                const float rstd = 1.0f / sqrtf(wave_sum(s) * (1.f / D) + RMS_EPS);
                GAS unsigned* o4 = (GAS unsigned*)((unsigned char*)XN + (size_t)m * D) + lane;
#pragma unroll
                for (int j = 0; j < 4; ++j) { const f32x4 y = v[j] * rstd * mul[j] + add[j]; const float sx = (float)(1 << SH_X); o4[64 * j] = cvt4_fp8(y.x * sx, y.y * sx, y.z * sx, y.w * sx); }
            }
        }
        for (int it = blockIdx.x; it < 256; it += F.G) {
            const int b = it >> 5, e = tid & 255, dh = tid >> 8, d0 = 32 * (it & 31) + 16 * dh;
            float wv[16];
#pragma unroll
            for (int j = 0; j < 16; ++j) wv[j] = w_router[(size_t)(d0 + j) * 256 + e];
            float part = 0.f; unsigned pk[8];
#pragma unroll
            for (int j = 0; j < 16; j += 2) {
                const float a0 = norm2_g[d0 + j] * (1.0f + MOD[b * 6144 + 4096 + d0 + j]), a1 = norm2_g[d0 + j + 1] * (1.0f + MOD[b * 6144 + 4096 + d0 + j + 1]);
                part += MOD[b * 6144 + 3072 + d0 + j] * wv[j]; part += MOD[b * 6144 + 3072 + d0 + j + 1] * wv[j + 1];
                pk[j >> 1] = cvt_pk_bf16(wv[j] * a0, wv[j + 1] * a1); }
            GAS v4u* wp = (GAS v4u*)((bf16*)(ws + WS_WRB) + ((size_t)(b * 256 + e) * 1024 + d0));
            v4u o0, o1; o0.x = pk[0]; o0.y = pk[1]; o0.z = pk[2]; o0.w = pk[3]; o1.x = pk[4]; o1.y = pk[5]; o1.z = pk[6]; o1.w = pk[7]; wp[0] = o0; wp[1] = o1;
            ((float*)(ws + WS_PART))[(size_t)(b * 64 + (it & 31) * 2 + dh) * 256 + e] = part;
        }
    REP_END(1) }
    SEAM(1);

    if (IN(2)) { REP_BEGIN(2)
        if ((int)blockIdx.x < NGB) {
            pg8::DenseSched S; S.init(T, NIN, 1024, NGB, (int)blockIdx.x, WIN_T);
            pg8::EpiWin E{(unsigned char*)QF, (unsigned char*)AQKV, (unsigned char*)GAB, (unsigned char*)GAB + (size_t)T * 2048, 0};
            pg8::gemm_phase<ALIGN_P2, true, pg8::EpiWin, pg8::DenseSched, 2>(lds, (const char*)XN, 1024, S, E, SC_WGU, SC_X);
        } else {
            LAS float* scr2 = (LAS float*)(lds + wave * 16384);
            conv_run(nitems0 + ((int)blockIdx.x - NGB) * NWAVES + wave, NITEMS - NCONV11, (F.G - NGB) * NWAVES, scr2);
        }
    REP_END(2) }
    SEAM(2);

    if (IN(3)) { REP_BEGIN(3)
        const int fr = lane & 15, fq = lane >> 4;
        bf16* QTB = (bf16*)(ws + WS_QTB); unsigned char* UT = (unsigned char*)(ws + WS_UT); float* DKB = (float*)(ws + WS_DK);
        {
            constexpr int NH1 = NB * 4 * 64, NATT = NB * 3 * 4 * 32;
            {
                const int kq = tid & 31, rg = tid >> 5, vrow = tid >> 3, v16 = (tid & 7) * 16;
                unsigned rq[4], rf[4]; v4u rv0;
                const unsigned char* QF8 = (const unsigned char*)QF;
#define H1_LOAD(w) do { const int b_ = (w) >> 8, h_ = ((w) >> 6) & 3, c_ = (w) & 63; const size_t r0_ = (size_t)(b_ * SEQ + c_ * 64); \
                _Pragma("unroll") for (int rr = 0; rr < 4; ++rr) { const size_t ro = (r0_ + rg * 4 + rr) * 1536 + h_ * 128 + 4 * kq; rq[rr] = *(const unsigned*)(QF8 + ro); rf[rr] = *(const unsigned*)(QF8 + ro + 512); } \
                rv0 = *(const v4u*)(QF8 + (r0_ + vrow) * 1536 + 1024 + h_ * 128 + v16); } while (0)
                if ((int)blockIdx.x < NH1) { H1_LOAD((int)blockIdx.x); }
                _Pragma("unroll") for (int sr = 0; sr < (((REPMASK >> 16) & 1) ? 2 : 1); ++sr) { if (sr) { H1_LOAD((int)blockIdx.x); }
                int hprev = -1; float lbv[4] = {0.f, 0.f, 0.f, 0.f};
                for (int wi = blockIdx.x, j1 = 0; wi < NH1; wi += F.G, ++j1) {
                    const int b = wi >> 8, h = (wi >> 6) & 3, c = wi & 63;
                    constexpr int QT_S = 272, KH_S = 144, VR_S = 288;
                    LAS unsigned char* Qt = lds;
                    LAS unsigned char* Kt = lds + 17408;
                    LAS unsigned char* Kh = lds + 34816;
                    LAS unsigned char* Vr = lds + 53248;
                    LAS unsigned char* Asc = lds + 71680;
                    LAS float* btot = (LAS float*)(lds + 80896);
                    if (h != hprev) { hprev = h;
                        const f32x4 l0 = *(const f32x4*)(lb_logits + h * 128 + 4 * kq), l1 = *(const f32x4*)(lb_logits + 512 + h * 128 + 4 * kq);
#pragma unroll
                        for (int ch = 0; ch < 4; ++ch) lbv[ch] = 1.0f / (1.0f + __expf(l1[ch] - l0[ch])); }
                    const size_t row0 = (size_t)(b * SEQ + c * 64);
                    const float rq_ = 1.0f / (float)(1 << SH_Q);
                    LBAR();
                    for (int i = tid; i < 9216 / 4; i += NWAVES * 64) ((LAS unsigned*)Asc)[i] = 0u;
                    float kk[4][4], bl[4][4]; float run[4] = {0.f, 0.f, 0.f, 0.f};
#pragma unroll
                    for (int rr = 0; rr < 4; ++rr) { const f32x2_t lo = __builtin_amdgcn_cvt_pk_f32_fp8((int)rf[rr], false), hi = __builtin_amdgcn_cvt_pk_f32_fp8((int)rf[rr], true); const float fv[4] = {lo[0], lo[1], hi[0], hi[1]};
#pragma unroll
                        for (int ch = 0; ch < 4; ++ch) { const float sg = fsigmoid(fv[ch] * rq_); const float f = lbv[ch] + (1.0f - lbv[ch]) * sg; run[ch] += __logf(f); bl[rr][ch] = run[ch]; kk[rr][ch] = (1.0f - lbv[ch]) * (1.0f - sg); } }
                    *(LAS f32x4*)(btot + rg * 128 + 4 * kq) = (f32x4){run[0], run[1], run[2], run[3]};
                    {   const unsigned vw[4] = {rv0.x, rv0.y, rv0.z, rv0.w}; unsigned w8[8];
#pragma unroll
                        for (int j = 0; j < 4; ++j) { const f32x2_t lo = __builtin_amdgcn_cvt_pk_f32_fp8((int)vw[j], false), hi = __builtin_amdgcn_cvt_pk_f32_fp8((int)vw[j], true); w8[2 * j] = cvt_pk_bf16(lo[0] * rq_, lo[1] * rq_); w8[2 * j + 1] = cvt_pk_bf16(hi[0] * rq_, hi[1] * rq_); }
                        *(LAS v4u*)(Vr + vrow * VR_S + v16 * 2) = (v4u){w8[0], w8[1], w8[2], w8[3]}; *(LAS v4u*)(Vr + vrow * VR_S + v16 * 2 + 16) = (v4u){w8[4], w8[5], w8[6], w8[7]}; }
                    LBAR();
                    float pre[4] = {0.f, 0.f, 0.f, 0.f}, bend[4] = {0.f, 0.f, 0.f, 0.f};
#pragma unroll
                    for (int g = 0; g < 16; ++g) { const f32x4 tg = *(const LAS f32x4*)(btot + g * 128 + 4 * kq);
#pragma unroll
                        for (int ch = 0; ch < 4; ++ch) { if (g < rg) pre[ch] += tg[ch]; bend[ch] += tg[ch]; } }
#pragma unroll
                    for (int rr = 0; rr < 4; ++rr) { const f32x2_t lo = __builtin_amdgcn_cvt_pk_f32_fp8((int)rq[rr], false), hi = __builtin_amdgcn_cvt_pk_f32_fp8((int)rq[rr], true); const float qf4[4] = {lo[0], lo[1], hi[0], hi[1]};
                        float qv[4], kv[4], kh[4];
#pragma unroll
                        for (int ch = 0; ch < 4; ++ch) { const float bb = pre[ch] + bl[rr][ch]; qv[ch] = qf4[ch] * rq_ * __expf(bb); kv[ch] = kk[rr][ch] * __expf(fminf(-bb, 80.f)); kh[ch] = kk[rr][ch] * __expf(bend[ch] - bb); }
                        *(LAS v2u*)(Qt + (rg * 4 + rr) * QT_S + kq * 8) = (v2u){cvt_pk_bf16(qv[0], qv[1]), cvt_pk_bf16(qv[2], qv[3])};
                        *(LAS v2u*)(Kt + (rg * 4 + rr) * QT_S + kq * 8) = (v2u){cvt_pk_bf16(kv[0], kv[1]), cvt_pk_bf16(kv[2], kv[3])};
                        *(LAS v2u*)(Kh + (rg * 4 + rr) * VR_S + kq * 8) = (v2u){cvt_pk_bf16(kh[0], kh[1]), cvt_pk_bf16(kh[2], kh[3])}; }
                    if (rg == 0) *(f32x4*)(DKB + (size_t)wi * 128 + 4 * kq) = (f32x4){__expf(bend[0]), __expf(bend[1]), __expf(bend[2]), __expf(bend[3])};
                    { const int wn = wi + (int)F.G; if (wn < NH1) { H1_LOAD(wn); } }
                    LBAR();
                    for (int idx = wave; idx < 10; idx += 8) {
                        const int ti = idx < 1 ? 0 : idx < 3 ? 1 : idx < 6 ? 2 : 3; const int si = idx - (ti * (ti + 1)) / 2;
                        f32x4 a4 = (f32x4){0.f, 0.f, 0.f, 0.f};
#pragma unroll
                        for (int ks = 0; ks < 4; ++ks) { const bf16x8 af = *(const LAS bf16x8*)(Qt + (16 * ti + fr) * QT_S + (32 * ks + 8 * fq) * 2); const bf16x8 bfr = *(const LAS bf16x8*)(Kt + (16 * si + fr) * QT_S + (32 * ks + 8 * fq) * 2);
                            a4 = __builtin_amdgcn_mfma_f32_16x16x32_bf16(af, bfr, a4, 0, 0, 0); }
#pragma unroll
                        for (int i = 0; i < 4; ++i) { const int tt = 16 * ti + 4 * fq + i, ss = 16 * si + fr; const float v = (ss <= tt) ? a4[i] : 0.f;
                            *(LAS unsigned short*)(Asc + tt * KH_S + ss * 2) = (unsigned short)(cvt_pk_bf16(v, 0.f) & 0xffff); }
                    }
#pragma unroll
                    for (int j = 0; j < 2; ++j) { const int p = tid + 512 * j, prow = p >> 4, c16 = p & 15; if (DBG_H1_ST || sr) *(v4u*)(QTB + (row0 + prow) * 512 + h * 128 + c16 * 8) = *(const LAS v4u*)(Qt + prow * QT_S + c16 * 16); }
                    bf16x8 vf[2];
#pragma unroll
                    for (int ks = 0; ks < 2; ++ks) {
                        const v2u a0 = __builtin_bit_cast(v2u, __builtin_amdgcn_ds_read_tr16_b64_v4i16((LAS v4i16_t*)(Vr + (32 * ks + 8 * fq + (fr >> 2)) * VR_S + (16 * wave + 4 * (fr & 3)) * 2)));
                        const v2u a1 = __builtin_bit_cast(v2u, __builtin_amdgcn_ds_read_tr16_b64_v4i16((LAS v4i16_t*)(Vr + (32 * ks + 8 * fq + 4 + (fr >> 2)) * VR_S + (16 * wave + 4 * (fr & 3)) * 2)));
                        vf[ks] = __builtin_bit_cast(bf16x8, (v4u){a0.x, a0.y, a1.x, a1.y}); }
                    {   unsigned uw[8];
#pragma unroll
                        for (int kt = 0; kt < 8; ++kt) { f32x4 u4 = (f32x4){0.f, 0.f, 0.f, 0.f};
#pragma unroll
                            for (int ks = 0; ks < 2; ++ks) {
                                const v2u a0 = __builtin_bit_cast(v2u, __builtin_amdgcn_ds_read_tr16_b64_v4i16((LAS v4i16_t*)(Kh + (32 * ks + 8 * fq + (fr >> 2)) * VR_S + (32 * (fr & 3) + 4 * kt) * 2)));
                                const v2u a1 = __builtin_bit_cast(v2u, __builtin_amdgcn_ds_read_tr16_b64_v4i16((LAS v4i16_t*)(Kh + (32 * ks + 8 * fq + 4 + (fr >> 2)) * VR_S + (32 * (fr & 3) + 4 * kt) * 2)));
                                u4 = __builtin_amdgcn_mfma_f32_16x16x32_bf16(__builtin_bit_cast(bf16x8, (v4u){a0.x, a0.y, a1.x, a1.y}), vf[ks], u4, 0, 0, 0); }
                            const float su = (float)(1 << SH_U); uw[kt] = cvt4_fp8(u4[0] * su, u4[1] * su, u4[2] * su, u4[3] * su); }
                        unsigned char* up = UT + ((size_t)wi * 128 + 16 * wave + fr) * 128 + 32 * fq;
                        if (DBG_H1_ST || sr) { *(v4u*)up = (v4u){uw[0], uw[1], uw[2], uw[3]}; *(v4u*)(up + 16) = (v4u){uw[4], uw[5], uw[6], uw[7]}; } }
                    LBAR();
                    {   const int tt = wave & 3, vh = wave >> 2; bf16x8 af[2]; unsigned ow[8];
#pragma unroll
                        for (int ks = 0; ks < 2; ++ks) af[ks] = *(const LAS bf16x8*)(Asc + (16 * tt + fr) * KH_S + (32 * ks + 8 * fq) * 2);
#pragma unroll
                        for (int vt = 0; vt < 4; ++vt) { f32x4 o4 = (f32x4){0.f, 0.f, 0.f, 0.f};
#pragma unroll
                            for (int ks = 0; ks < 2; ++ks) {
                                const v2u a0 = __builtin_bit_cast(v2u, __builtin_amdgcn_ds_read_tr16_b64_v4i16((LAS v4i16_t*)(Vr + (32 * ks + 8 * fq + (fr >> 2)) * VR_S + (64 * vh + 16 * (fr & 3) + 4 * vt) * 2)));
                                const v2u a1 = __builtin_bit_cast(v2u, __builtin_amdgcn_ds_read_tr16_b64_v4i16((LAS v4i16_t*)(Vr + (32 * ks + 8 * fq + 4 + (fr >> 2)) * VR_S + (64 * vh + 16 * (fr & 3) + 4 * vt) * 2)));
                                o4 = __builtin_amdgcn_mfma_f32_16x16x32_bf16(__builtin_bit_cast(bf16x8, (v4u){a0.x, a0.y, a1.x, a1.y}), af[ks], o4, 0, 0, 0); }
                            ow[2 * vt] = cvt_pk_bf16(o4[0], o4[1]); ow[2 * vt + 1] = cvt_pk_bf16(o4[2], o4[3]); }
                        bf16* op = OA + (row0 + 16 * tt + fr) * 512 + h * 128 + 64 * vh + 16 * fq;
                        if (DBG_H1_ST || sr) { *(v4u*)op = (v4u){ow[0], ow[1], ow[2], ow[3]}; *(v4u*)(op + 8) = (v4u){ow[4], ow[5], ow[6], ow[7]}; } }
                } }
#undef H1_LOAD
            }
            {
                constexpr int K_S = 144, VT_S = 528;
                LAS unsigned char* Kl = lds;
                LAS unsigned char* Vt = lds + 36864;
                v4u kx[2], vx[2]; v2u qn[2];
#define ATT_DECODE(un) const int rn = (un) & 31, hh = ((un) >> 5) & 3, g = ((un) >> 7) % 3, b = (un) / 384; \
                const int dl = g == 0 ? 0 : g == 1 ? 2 : 4, d = 1 << dl, nbk = 32 >> dl, r = rn / nbk, n = rn % nbk; \
                const unsigned char* base = (const unsigned char*)AQKV + (size_t)(b * SEQ) * 2304 + (g * 4 + hh) * 64; const int qi = 16 * wave + fr; const int tq = (n * 128 + qi) * d + r;
#define ATT_LOAD(un) do { ATT_DECODE(un)       \
                _Pragma("unroll") for (int j = 0; j < 2; ++j) { const int p = tid + 512 * j, key = p >> 2, c16 = p & 3; const int l = (n - 1) * 128 + key; \
                    kx[j] = (v4u){0u, 0u, 0u, 0u}; vx[j] = kx[j]; \
                    if (l >= 0) { const unsigned char* rowp = base + (size_t)(l * d + r) * 2304 + c16 * 16; kx[j] = *(const v4u*)(rowp + 768); vx[j] = *(const v4u*)(rowp + 1536); } } \
                _Pragma("unroll") for (int ks = 0; ks < 2; ++ks) qn[ks] = *(const v2u*)(base + (size_t)tq * 2304 + 32 * ks + 8 * fq); } while (0)
                if (F.vcu < NATT) { ATT_LOAD(F.vcu); }
                _Pragma("unroll") for (int sr = 0; sr < (((REPMASK >> 17) & 1) ? 2 : 1); ++sr) { if (sr) { ATT_LOAD(F.vcu); }
                for (int un = F.vcu; un < NATT; un += F.G) {
                    ATT_DECODE(un)
                    LBAR();
#pragma unroll
                    for (int j = 0; j < 2; ++j) { const int p = tid + 512 * j, key = p >> 2, c16 = p & 3;
                        *(LAS v4u*)(Kl + key * K_S + c16 * 32) = f8x8_to_bf16(kx[j].x, kx[j].y); *(LAS v4u*)(Kl + key * K_S + c16 * 32 + 16) = f8x8_to_bf16(kx[j].z, kx[j].w);
                        *(LAS v4u*)(Vt + key * K_S + c16 * 32) = f8x8_to_bf16(vx[j].x, vx[j].y); *(LAS v4u*)(Vt + key * K_S + c16 * 32 + 16) = f8x8_to_bf16(vx[j].z, vx[j].w); }
                    bf16x8 qf[2]; qf[0] = __builtin_bit_cast(bf16x8, f8x8_to_bf16(qn[0].x, qn[0].y)); qf[1] = __builtin_bit_cast(bf16x8, f8x8_to_bf16(qn[1].x, qn[1].y));
                    if (un + (int)F.G < NATT && !(DBG_ATT_NOLOAD && sr)) { ATT_LOAD(un + (int)F.G); }
                    LBAR();
                    float p[10][4]; float mx = -INFINITY;
#pragma unroll
                    for (int jt = 0; jt < 10; ++jt) { const int kt = (wave + jt) < 15 ? (wave + jt) : 15; f32x4 s4 = (f32x4){0.f, 0.f, 0.f, 0.f};
#pragma unroll
                        for (int ks = 0; ks < 2; ++ks) { const bf16x8 af = *(const LAS bf16x8*)(Kl + (16 * kt + fr) * K_S + (32 * ks + 8 * fq) * 2); s4 = __builtin_amdgcn_mfma_f32_16x16x32_bf16(af, qf[ks], s4, 0, 0, 0); }
#pragma unroll
                        for (int i = 0; i < 4; ++i) { const int kj = 16 * (wave + jt) + 4 * fq + i; const bool ok = (kj >= qi) && (kj <= qi + 128) && (n > 0 || kj >= 128);
                            const float sv = ok ? s4[i] * (0.125f / (float)(1 << (2 * SH_Q))) : -INFINITY; p[jt][i] = sv; mx = fmaxf(mx, sv); } }
                    mx = fmaxf(mx, __shfl_xor(mx, 16)); mx = fmaxf(mx, __shfl_xor(mx, 32));
                    float ls = 0.f;
#pragma unroll
                    for (int jt = 0; jt < 10; ++jt)
#pragma unroll
                        for (int i = 0; i < 4; ++i) { const float e = __expf(p[jt][i] - mx); p[jt][i] = e; ls += e; }
                    ls += __shfl_xor(ls, 16); ls += __shfl_xor(ls, 32);
                    f32x4 o4[4];
#pragma unroll
                    for (int dt = 0; dt < 4; ++dt) o4[dt] = (f32x4){0.f, 0.f, 0.f, 0.f};
#pragma unroll
                    for (int pp = 0; pp < 5; ++pp) { const int k0 = (wave + 2 * pp) < 15 ? (wave + 2 * pp) : 15, k1 = (wave + 2 * pp + 1) < 15 ? (wave + 2 * pp + 1) : 15;
                        v4u pb; pb.x = cvt_pk_bf16(p[2 * pp][0], p[2 * pp][1]); pb.y = cvt_pk_bf16(p[2 * pp][2], p[2 * pp][3]); pb.z = cvt_pk_bf16(p[2 * pp + 1][0], p[2 * pp + 1][1]); pb.w = cvt_pk_bf16(p[2 * pp + 1][2], p[2 * pp + 1][3]);
                        const bf16x8 pf = __builtin_bit_cast(bf16x8, pb);
#pragma unroll
                        for (int dt = 0; dt < 4; ++dt) {
                            const v2u a0 = __builtin_bit_cast(v2u, __builtin_amdgcn_ds_read_tr16_b64_v4i16((LAS v4i16_t*)(Vt + (16 * k0 + 4 * fq + (fr >> 2)) * K_S + (16 * (fr & 3) + 4 * dt) * 2)));
                            const v2u a1 = __builtin_bit_cast(v2u, __builtin_amdgcn_ds_read_tr16_b64_v4i16((LAS v4i16_t*)(Vt + (16 * k1 + 4 * fq + (fr >> 2)) * K_S + (16 * (fr & 3) + 4 * dt) * 2)));
                            const v4u av = (v4u){a0.x, a0.y, a1.x, a1.y};
                            o4[dt] = __builtin_amdgcn_mfma_f32_16x16x32_bf16(__builtin_bit_cast(bf16x8, av), pf, o4[dt], 0, 0, 0); } }
                    const float inv = 1.0f / (ls * (float)(1 << SH_Q)); const size_t trow = (size_t)(b * SEQ + tq);
                    bf16* og = OG + ((size_t)g * T + trow) * 256 + hh * 64 + 16 * fq;
                    { unsigned ow[8];
#pragma unroll
                      for (int dt = 0; dt < 4; ++dt) { ow[2 * dt] = cvt_pk_bf16(o4[dt][0] * inv, o4[dt][1] * inv); ow[2 * dt + 1] = cvt_pk_bf16(o4[dt][2] * inv, o4[dt][3] * inv); }
                      *(v4u*)og = (v4u){ow[0], ow[1], ow[2], ow[3]}; *(v4u*)(og + 8) = (v4u){ow[4], ow[5], ow[6], ow[7]}; }
                    if (fq == 0) LSE[((size_t)(g * 4 + hh) * NB + b) * SEQ + r * (SEQ >> dl) + n * 128 + qi] = mx + __logf(ls);
                } }
#undef ATT_LOAD
#undef ATT_DECODE
            }
        }
        xcd_barrier(bar);
        for (int vb = blockIdx.x; vb < 256; vb += F.G) {
            const int bh = vb >> 3, eg = (vb & 7) * 512 + tid, v = eg >> 5, kq = eg & 31;
            LAS float* Dl = (LAS float*)lds;
            __syncthreads();
            for (int i = tid; i < 64 * 128; i += NWAVES * 64) Dl[i] = DKB[(size_t)bh * 64 * 128 + i];
            unsigned char* up = UT + ((size_t)bh * 64 * 128 + v) * 128 + kq * 4;
            __syncthreads();
            float S0 = 0.f, S1 = 0.f, S2 = 0.f, S3 = 0.f; const float su = (float)(1 << SH_U), ru = 1.0f / su;
            for (int c0 = 0; c0 < 64; c0 += 32) {
                unsigned u[32];
                { const unsigned char* lp = up + (size_t)c0 * 128 * 128;
#pragma unroll
                  for (int c = 0; c < 32; ++c) { u[c] = *(const unsigned*)lp; lp += 128 * 128; asm volatile("" : "+v"(lp)); } }
                unsigned char* sp = up + (size_t)c0 * 128 * 128;
#pragma unroll
                for (int c = 0; c < 32; ++c) { const f32x4 d = *(const LAS f32x4*)(Dl + (c0 + c) * 128 + kq * 4);
                    *(unsigned*)sp = cvt4_fp8(S0 * su, S1 * su, S2 * su, S3 * su); sp += 128 * 128; asm volatile("" : "+v"(sp));
                    const f32x2_t ua = __builtin_amdgcn_cvt_pk_f32_fp8((int)u[c], false), ub = __builtin_amdgcn_cvt_pk_f32_fp8((int)u[c], true);
                    S0 = d[0] * S0 + ua[0] * ru; S1 = d[1] * S1 + ua[1] * ru; S2 = d[2] * S2 + ub[0] * ru; S3 = d[3] * S3 + ub[1] * ru; }
            }
        }
        for (int m0 = F.gw * 16; m0 < T; m0 += F.NGW * 16)
            for (int m = m0; m < m0 + 16; ++m) {
                const int hh = lane >> 4;
                const int bb = m >> 12, tt = m & 4095;
                const float l0 = LSE[((size_t)(0 + hh) * NB + bb) * SEQ + tt], l1 = LSE[((size_t)(4 + hh) * NB + bb) * SEQ + (tt & 3) * 1024 + (tt >> 2)], l2 = LSE[((size_t)(8 + hh) * NB + bb) * SEQ + (tt & 15) * 256 + (tt >> 4)];
                const float mxl = fmaxf(l0, fmaxf(l1, l2)); const float e0 = __expf(l0 - mxl), e1 = __expf(l1 - mxl), e2 = __expf(l2 - mxl); const float inv = 1.0f / (e0 + e1 + e2);
                const v2u a0 = *(const v2u*)(OG + ((size_t)0 * T + m) * 256 + 4 * lane), a1 = *(const v2u*)(OG + ((size_t)1 * T + m) * 256 + 4 * lane), a2 = *(const v2u*)(OG + ((size_t)2 * T + m) * 256 + 4 * lane);
                const float w0 = e0 * inv, w1 = e1 * inv, w2 = e2 * inv;
                const float sy = (float)(1 << SH_YAB);
                *(unsigned*)((unsigned char*)YA + (size_t)m * 768 + 512 + 4 * lane) = cvt4_fp8(sy * (w0 * bflo(a0.x) + w1 * bflo(a1.x) + w2 * bflo(a2.x)), sy * (w0 * bfhi(a0.x) + w1 * bfhi(a1.x) + w2 * bfhi(a2.x)),
                                                                                                     sy * (w0 * bflo(a0.y) + w1 * bflo(a1.y) + w2 * bflo(a2.y)), sy * (w0 * bfhi(a0.y) + w1 * bfhi(a1.y) + w2 * bfhi(a2.y)));
            }
        xcd_barrier(bar);
        {
            LAS float* Ot = (LAS float*)lds;
            const int t = tid >> 3, seg = (tid & 7) * 16;
            v2u sfN[4]; bf16x8 afN[4][4]; v4u oiN0, oiN1, hzN;
#define P3C_LOAD(un_) do { const int b_ = (un_) >> 8, h_ = ((un_) >> 6) & 3, c_ = (un_) & 63; const size_t r0_ = (size_t)(b_ * SEQ + c_ * 64); \
                _Pragma("unroll") for (int ks = 0; ks < 4; ++ks) sfN[ks] = *(const v2u*)(UT + ((size_t)(un_) * 128 + 16 * wave + fr) * 128 + 32 * ks + 8 * fq); \
                _Pragma("unroll") for (int tt = 0; tt < 4; ++tt) _Pragma("unroll") for (int ks = 0; ks < 4; ++ks) afN[tt][ks] = *(const bf16x8*)(QTB + (r0_ + 16 * tt + fr) * 512 + h_ * 128 + 32 * ks + 8 * fq); \
                oiN0 = *(const v4u*)(OA + (r0_ + t) * 512 + h_ * 128 + seg); oiN1 = *(const v4u*)(OA + (r0_ + t) * 512 + h_ * 128 + seg + 8); \
                hzN = *(const v4u*)((const unsigned char*)GAB + (size_t)T * 2048 + (r0_ + t) * 512 + h_ * 128 + seg); } while (0)
            if (F.vcu < NB * 4 * 64) { P3C_LOAD(F.vcu); }
            int hprev3 = -1; f32x4 ggv[4];
#pragma unroll
            for (int j = 0; j < 4; ++j) ggv[j] = (f32x4){0.f, 0.f, 0.f, 0.f};
            for (int unit = F.vcu; unit < NB * 4 * 64; unit += F.G) {
                const int b = unit >> 8, h = (unit >> 6) & 3, c = unit & 63; const size_t row0 = (size_t)(b * SEQ + c * 64);
                if (h != hprev3) { hprev3 = h;
#pragma unroll
                    for (int j = 0; j < 4; ++j) ggv[j] = *(const f32x4*)(hg_norm_g + h * 128 + seg + 4 * j); }
                bf16x8 sf[4], af[4][4]; f32x4 o4[4];
#pragma unroll
                for (int ks = 0; ks < 4; ++ks) { const f32x2_t s0 = __builtin_amdgcn_cvt_pk_f32_fp8((int)sfN[ks].x, false), s1 = __builtin_amdgcn_cvt_pk_f32_fp8((int)sfN[ks].x, true), s2 = __builtin_amdgcn_cvt_pk_f32_fp8((int)sfN[ks].y, false), s3 = __builtin_amdgcn_cvt_pk_f32_fp8((int)sfN[ks].y, true);
                    const float ru = 1.0f / (float)(1 << SH_U); v4u sw; sw.x = cvt_pk_bf16(s0[0] * ru, s0[1] * ru); sw.y = cvt_pk_bf16(s1[0] * ru, s1[1] * ru); sw.z = cvt_pk_bf16(s2[0] * ru, s2[1] * ru); sw.w = cvt_pk_bf16(s3[0] * ru, s3[1] * ru);
                    sf[ks] = __builtin_bit_cast(bf16x8, sw);
#pragma unroll
                    for (int tt = 0; tt < 4; ++tt) af[tt][ks] = afN[tt][ks]; }
                const v4u oi0 = oiN0, oi1 = oiN1, hz = hzN;
                if (unit + (int)F.G < NB * 4 * 64) { P3C_LOAD(unit + (int)F.G); }
#pragma unroll
                for (int tt = 0; tt < 4; ++tt) { o4[tt] = (f32x4){0.f, 0.f, 0.f, 0.f};
#pragma unroll
                    for (int ks = 0; ks < 4; ++ks) o4[tt] = __builtin_amdgcn_mfma_f32_16x16x32_bf16(af[tt][ks], sf[ks], o4[tt], 0, 0, 0); }
                LBAR();
#pragma unroll
                for (int tt = 0; tt < 4; ++tt)
#pragma unroll
                    for (int i = 0; i < 4; ++i) Ot[(16 * tt + 4 * fq + i) * 132 + 16 * wave + fr] = o4[tt][i];
                LBAR();
                float o[16];
                { const unsigned ow[8] = {oi0.x, oi0.y, oi0.z, oi0.w, oi1.x, oi1.y, oi1.z, oi1.w};
#pragma unroll
                  for (int j = 0; j < 4; ++j) { const f32x4 q4 = *(const LAS f32x4*)(Ot + t * 132 + seg + 4 * j); o[4 * j] = q4[0] + bflo(ow[2 * j]); o[4 * j + 1] = q4[1] + bfhi(ow[2 * j]); o[4 * j + 2] = q4[2] + bflo(ow[2 * j + 1]); o[4 * j + 3] = q4[3] + bfhi(ow[2 * j + 1]); } }
                float ss = 0.f;
#pragma unroll
                for (int j = 0; j < 16; ++j) ss += o[j] * o[j];
                ss += __shfl_xor(ss, 1); ss += __shfl_xor(ss, 2); ss += __shfl_xor(ss, 4);
                const float rstd = 1.0f / sqrtf(ss * (1.f / 128.f) + RMS_EPS);
                const unsigned hw[4] = {hz.x, hz.y, hz.z, hz.w}; const float rs = rstd * (1.0f / (float)(1 << SH_G));
                unsigned yw[4]; const float rsy = rs * (float)(1 << SH_YAB);
#pragma unroll
                for (int j = 0; j < 4; ++j) { const f32x2_t s0 = __builtin_amdgcn_cvt_pk_f32_fp8((int)hw[j], false), s1 = __builtin_amdgcn_cvt_pk_f32_fp8((int)hw[j], true); const f32x4 gg = ggv[j];
                    yw[j] = cvt4_fp8(o[4 * j] * rsy * gg[0] * s0[0], o[4 * j + 1] * rsy * gg[1] * s0[1], o[4 * j + 2] * rsy * gg[2] * s1[0], o[4 * j + 3] * rsy * gg[3] * s1[1]); }
                *(v4u*)((unsigned char*)YA + (row0 + t) * 768 + h * 128 + seg) = (v4u){yw[0], yw[1], yw[2], yw[3]};
            }
#undef P3C_LOAD
        }
    REP_END(3) }

    SEAM(4);

    if (IN(5)) { REP_BEGIN(5)
        { pg8::DenseSched S; S.init(T, 1024, 768, F.G, (int)blockIdx.x, WA_T); pg8::EpiMerge E{(const unsigned char*)GAB, (unsigned char*)MERGED}; pg8::gemm_phase<ALIGN_DEFAULT, true, pg8::EpiMerge, pg8::DenseSched, 2>(lds, (const char*)YA, 768, S, E, SC_WAB, SC_YAB); }
    REP_END(5) }
    SEAM(5);

    if (IN(6)) { REP_BEGIN(6)
        pg8::DenseSched S; S.init(T, 1024, 1024, F.G, (int)blockIdx.x, WO_T); pg8::EpiOut E{X_IN, (bf16*)(ws + WS_X1B), MOD};
        pg8::gemm_phase<ALIGN_DEFAULT, true>(lds, (const char*)MERGED, 1024, S, E, SC_WGU, SC_M);
    REP_END(6) }
    SEAM(6);

    if (IN(7)) { REP_BEGIN(7)
        const int NRB = (F.G >= 256) ? 128 : F.G / 2;
        if ((int)blockIdx.x < NRB) {
            pg8::RouterSched S{T / 256, NRB, (int)blockIdx.x, (const char*)(ws + WS_WRB)}; pg8::EpiRL E{LOGITS};
            pg8::gemm_phase<ALIGN_DEFAULT, false, pg8::EpiRL, pg8::RouterSched, 3>(lds, (const char*)(ws + WS_X1B), 2048, S, E);
        } else {
            const int rb = (int)blockIdx.x - NRB, nrow = F.G - NRB;
            for (int b = rb; b < NB; b += nrow) if (tid < 256) { float sum = 0.f;
                for (int p0 = 0; p0 < 64; p0 += 16) { float v[16];
#pragma unroll
                    for (int j = 0; j < 16; ++j) v[j] = ((const float*)(ws + WS_PART))[(size_t)(b * 64 + p0 + j) * 256 + tid];
#pragma unroll
                    for (int j = 0; j < 16; ++j) sum += v[j]; }
                ((float*)(ws + WS_CB))[b * 256 + tid] = sum; }
            for (int m0 = (rb * NWAVES + wave) * 16; m0 < T; m0 += nrow * NWAVES * 16) {
                const int b = m0 >> 12;
                f32x4 mul[4], add[4];
#pragma unroll
                for (int j = 0; j < 4; ++j) { const int c = 4 * lane + 256 * j;
                    const f32x4 s2 = *(const f32x4*)(MOD + b * 6144 + 4096 + c);
                    mul[j] = *(const f32x4*)(norm2_g + c) * (s2 + 1.0f);
                    add[j] = *(const f32x4*)(MOD + b * 6144 + 3072 + c); }
                for (int m = m0; m < m0 + 16; ++m) {
                    const GAS v2u* xr = (const GAS v2u*)((const bf16*)(ws + WS_X1B) + (size_t)m * D) + lane;
                    f32x4 v[4]; float s = 0.f;
#pragma unroll
                    for (int j = 0; j < 4; ++j) { const v2u xw = xr[64 * j]; v[j] = (f32x4){bflo(xw.x), bfhi(xw.x), bflo(xw.y), bfhi(xw.y)}; s += (v[j].x * v[j].x + v[j].y * v[j].y) + (v[j].z * v[j].z + v[j].w * v[j].w); }
                    const float rstd = 1.0f / sqrtf(wave_sum(s) * (1.f / D) + RMS_EPS);
                    if (lane == 0) ((float*)(ws + WS_RSTD))[m] = rstd;
                    GAS unsigned* o4 = (GAS unsigned*)((unsigned char*)(ws + WS_H2F8) + (size_t)m * D) + lane;
#pragma unroll
                    for (int j = 0; j < 4; ++j) { const f32x4 y = v[j] * rstd * mul[j] + add[j]; const float sx = (float)(1 << SH_X); o4[64 * j] = cvt4_fp8(y.x * sx, y.y * sx, y.z * sx, y.w * sx); }
                }
            }
        }
    REP_END(7) }
    SEAM(7);

    if (IN(9)) { REP_BEGIN(9)
        LAS unsigned* whist = (LAS unsigned*)lds;
        LAS unsigned* wbase = whist + 2048;
        LAS int* pe_l = (LAS int*)(lds + 16384); LAS int* pr_l = pe_l + 1024; LAS float* pw_l = (LAS float*)(pr_l + 1024);
        for (int cid = F.vcu; cid < T / 128; cid += F.G) {
            const int m0w = cid * 128;
            __syncthreads();
            for (int i = tid; i < 2048; i += NWAVES * 64) whist[i] = 0u;
            __syncthreads();
            float cb4[4], rb4[4];
#pragma unroll
            for (int i = 0; i < 4; ++i) { cb4[i] = ((const float*)(ws + WS_CB))[(cid >> 5) * 256 + lane + 64 * i]; rb4[i] = router_bias[lane + 64 * i]; }
            for (int jg = 0; jg < 16 / TKI; ++jg) {
                float sc[TKI][4]; unsigned key[TKI][4];
#pragma unroll
                for (int tt = 0; tt < TKI; ++tt) { const int t = m0w + wave * 16 + jg * TKI + tt; const float rs = ((const float*)(ws + WS_RSTD))[t];
#pragma unroll
                    for (int i = 0; i < 4; ++i) { sc[tt][i] = fsigmoid(rs * LOGITS[(size_t)t * 256 + lane + 64 * i] + cb4[i]); const float sl = fmaxf(sc[tt][i] + rb4[i], 0.f);
                        key[tt][i] = (__float_as_uint(sl) & 0xFFFFFF00u) | (unsigned)(255 - (lane + 64 * i)); } }
                float myw[TKI], ssum[TKI]; int mye[TKI];
#pragma unroll
                for (int tt = 0; tt < TKI; ++tt) { myw[tt] = 0.f; ssum[tt] = 0.f; mye[tt] = 0; }
                for (int k = 0; k < 8; ++k) {
#pragma unroll
                    for (int tt = 0; tt < TKI; ++tt) {
                        unsigned bk = max(max(key[tt][0], key[tt][1]), max(key[tt][2], key[tt][3]));
                        bk = max(bk, (unsigned)__builtin_amdgcn_update_dpp(0, (int)bk, 0xB1, 0xF, 0xF, false));
                        bk = max(bk, (unsigned)__builtin_amdgcn_update_dpp(0, (int)bk, 0x4E, 0xF, 0xF, false));
                        bk = max(bk, (unsigned)__builtin_amdgcn_update_dpp(0, (int)bk, 0x141, 0xF, 0xF, false));
                        bk = max(bk, (unsigned)__builtin_amdgcn_update_dpp(0, (int)bk, 0x140, 0xF, 0xF, false));
                        bk = max(bk, (unsigned)__builtin_amdgcn_update_dpp(0, (int)bk, 0x142, 0xA, 0xF, false));
                        bk = max(bk, (unsigned)__builtin_amdgcn_update_dpp(0, (int)bk, 0x143, 0xC, 0xF, false));
                        bk = (unsigned)__builtin_amdgcn_readlane((int)bk, 63);
                        const int idx = 255 - (int)(bk & 0xFFu), own = idx & 63, ii = idx >> 6;
                        float sv = ii == 0 ? sc[tt][0] : ii == 1 ? sc[tt][1] : ii == 2 ? sc[tt][2] : sc[tt][3];
                        sv = __int_as_float(__builtin_amdgcn_readlane(__float_as_int(sv), own));
#pragma unroll
                        for (int i = 0; i < 4; ++i) if (lane == own && ii == i) key[tt][i] = 0u;
                        ssum[tt] += sv;
                        if (lane == k) { mye[tt] = idx; myw[tt] = sv; }
                    }
                }
#pragma unroll
                for (int tt = 0; tt < TKI; ++tt) {
                    const float w = myw[tt] / ssum[tt] * 2.5f; const int j = jg * TKI + tt;
                    if (lane < 8) { LAS unsigned* hp = whist + wave * 256 + mye[tt]; const unsigned lr = *hp; *hp = lr + 1u;
                        const int ix = (wave * 16 + j) * 8 + lane; pe_l[ix] = mye[tt]; pr_l[ix] = (int)lr; pw_l[ix] = w; }
                    LDS_WAIT();
                }
            }
            __syncthreads();
            if (tid < 256) { unsigned run = 0u;
#pragma unroll
                for (int w = 0; w < 8; ++w) { wbase[w * 256 + tid] = run; run += whist[w * 256 + tid]; }
                HISTG[cid * 256 + tid] = run; }
            __syncthreads();
            for (int i = tid; i < 1024; i += NWAVES * 64) { const int e = pe_l[i]; const size_t gi = (size_t)m0w * 8 + i; PE[gi] = e; PR[gi] = pr_l[i] + (int)wbase[(i >> 7) * 256 + e]; PW[gi] = pw_l[i]; }
        }
    REP_END(9) }
    SEAM(9);

    if (IN(10) || IN(11) || IN(12)) {
        LAS int* tab = (LAS int*)(lds + TAB_OFF);
        LAS int* est = (LAS int*)lds; LAS int* tst = est + 256; LAS int* cntl = tst + 256; LAS int* ntl = cntl + 256; LAS int* cbl = ntl + 64;
        REP_BEGIN(10)
        for (int cid = F.vcu; cid < T / 128; cid += F.G) {
            __syncthreads();
            {
                const int e = tid & 255, hf = tid >> 8; int tot = 0, cb = 0;
                for (int c0 = hf * 128; c0 < hf * 128 + 128; c0 += 16) { int v[16];
#pragma unroll
                    for (int j = 0; j < 16; ++j) v[j] = (int)HISTG[(c0 + j) * 256 + e];
#pragma unroll
                    for (int j = 0; j < 16; ++j) { tot += v[j]; cb += (c0 + j < cid) ? v[j] : 0; } }
                if (hf) { cntl[e] = tot; cbl[e] = cb; }
                __syncthreads();
                if (!hf) { cntl[e] += tot; cbl[e] += cb; }
            }
            __syncthreads();
            if (wave == 0) {
                int c4[4], loc = 0, locT = 0;
#pragma unroll
                for (int i = 0; i < 4; ++i) { c4[i] = cntl[4 * lane + i]; loc += c4[i]; locT += (c4[i] + 255) >> 8; }
                int inc = loc, incT = locT;
#pragma unroll
                for (int o = 1; o < 64; o <<= 1) { const int a = __shfl_up(inc, o), bt = __shfl_up(incT, o); if (lane >= o) { inc += a; incT += bt; } }
                int ex = inc - loc, exT = incT - locT;
#pragma unroll
                for (int i = 0; i < 4; ++i) { est[4 * lane + i] = exT * 256; tst[4 * lane + i] = exT; ex += c4[i]; exT += (c4[i] + 255) >> 8; }
                if (lane == 63) ntl[0] = incT;
            }
            __syncthreads();
            if (tid < 256) { const int cn = cntl[tid], t0 = tst[tid], e0 = est[tid]; for (int j = 0; j * 256 < cn; ++j) { const int rem = cn - j * 256; tab[(t0 + j) * 4 + 0] = tid; tab[(t0 + j) * 4 + 1] = e0 + j * 256; tab[(t0 + j) * 4 + 2] = rem < 256 ? rem : 256; tab[(t0 + j) * 4 + 3] = 0; } }
            if (tid < T / 256) { const int ti = ntl[0] + tid; tab[ti * 4 + 0] = NEXP; tab[ti * 4 + 1] = NSLOTP + 256 * tid; tab[ti * 4 + 2] = 256; tab[ti * 4 + 3] = 0; }
            if (tid == 0) { F.MISC[16] = (unsigned)ntl[0]; F.MISC[17] = (unsigned)(ntl[0] + T / 256); }
            __syncthreads();
            if (IN(10)) {
                for (int i = cid * 128 + tid; i < cid * 128 + 128; i += NWAVES * 64) SLOT_TOK[NSLOTP + i] = i;
                for (int e = blockIdx.x; e < NEXP; e += F.G) { const int cn = cntl[e], e0 = est[e], pend = e0 + (((cn + 255) >> 8) << 8); for (int i = e0 + cn + tid; i < pend; i += NWAVES * 64) __hip_atomic_store(SLOT_TOK + i, 0, RLX_AGENT); }
                for (int i = tid; i < 1024; i += NWAVES * 64) { const size_t gi = (size_t)cid * 1024 + i; const int e = PE[gi]; const int slot = est[e] + cbl[e] + PR[gi]; __hip_atomic_store(SLOT_TOK + slot, (int)(gi >> 3), RLX_AGENT); TOK_SLOT[gi] = slot; }
            }
        }
        REP_END(10)
        __syncthreads();
    }
    SEAM(10);

    if (IN(11)) { REP_BEGIN(11)
        int Gp = F.G, c11 = F.vcu, cid = -1;
        if (NGB < F.G && NCONV11 > 0) {
            const int units = (int)F.MISC[17] * 2, gmax = F.G - CONV11_MINWG, R = (units + gmax - 1) / gmax; Gp = (units + R - 1) / R;
            const int x = (int)blockIdx.x & 7, j = (int)blockIdx.x >> 3, qb = Gp >> 3, qr = Gp & 7, qx = qb + (x < qr ? 1 : 0), mn = x < qr ? x : qr;
            if (j < qx) c11 = x * qb + mn + j; else cid = x * (32 - qb) - mn + (j - qx);
        }
        Gp = __builtin_amdgcn_readfirstlane(Gp); c11 = __builtin_amdgcn_readfirstlane(c11); cid = __builtin_amdgcn_readfirstlane(cid);
        if (cid < 0) { pg8::RoutedSched<2, true> S{(const LAS int*)(lds + TAB_OFF), (int)F.MISC[17], Gp, c11, 1024u, (const char*)WGU, (size_t)512 * 1024, SLOT_TOK};
          pg8::EpiGU E{(unsigned char*)HMID}; pg8::gemm_phase<ALIGN_DEFAULT, true>(lds, (const char*)(ws + WS_H2F8), 1024, S, E, SC_WGU, SC_X); }
        else conv_run(NITEMS - NCONV11 + cid * NWAVES + wave, NITEMS, (F.G - Gp) * NWAVES, (LAS float*)(lds + wave * 16384));
    REP_END(11) }
    SEAM(11);

    if (IN(12)) { REP_BEGIN(12)
        { pg8::RoutedSched<4, false> S{(const LAS int*)(lds + TAB_OFF), (int)F.MISC[17], F.G, F.vcu, 256u, (const char*)WD, (size_t)1024 * 256, nullptr};
          pg8::EpiRD E{(unsigned char*)YSLOT, SLOT_W}; pg8::gemm_phase<ALIGN_P12, true, pg8::EpiRD, pg8::RoutedSched<4, false>, 2>(lds, (const char*)HMID, 256, S, E, SC_WD, SC_HMID); }

    REP_END(12) }
    SEAM(12);

    if (IN(13)) { REP_BEGIN(13)
        float* dst13 = (rep + 1 < REPS(13)) ? (float*)(ws + WS_QF) : out;
        for (int m0 = F.gw * 16; m0 < T; m0 += F.NGW * 16) {
            const int b = m0 >> 12;
            f32x4 g2[4], fg[4];
#pragma unroll
            for (int j = 0; j < 4; ++j) { const int c = 256 * j + 4 * lane; g2[j] = *(const f32x4*)(MOD + b * 6144 + 5120 + c) * (1.0f / (float)(1 << SH_Y)); fg[j] = *(const f32x4*)(final_g + c); }
            for (int m = m0; m < m0 + 16; ++m) {
                unsigned yr[9][4];
#pragma unroll
                for (int j = 0; j < 4; ++j) yr[0][j] = *(const unsigned*)(YSH + (size_t)m * 1024 + 256 * j + 4 * lane);
#pragma unroll
                for (int k = 0; k < 8; ++k) { const int slot = TOK_SLOT[m * 8 + k]; const unsigned char* sp = (const unsigned char*)YSLOT + (size_t)slot * 1024 + 4 * lane;
#pragma unroll
                    for (int j = 0; j < 4; ++j) yr[k + 1][j] = *(const unsigned*)(sp + 256 * j); }
                f32x4 v[4];
#pragma unroll
                for (int j = 0; j < 4; ++j) { const v2u xw = *(const v2u*)((const bf16*)(ws + WS_X1B) + (size_t)m * D + 256 * j + 4 * lane); v[j] = (f32x4){bflo(xw.x), bfhi(xw.x), bflo(xw.y), bfhi(xw.y)}; }
                f32x4 a[4];
#pragma unroll
                for (int j = 0; j < 4; ++j) a[j] = (f32x4){0.f, 0.f, 0.f, 0.f};
#pragma unroll
                for (int k = (DBG_MOE >= 1 ? 0 : 9); k < (DBG_MOE >= 2 ? 9 : 1); ++k) {
                    const float wk = k == 0 ? 1.0f : PW[m * 8 + (k > 0 ? k - 1 : 0)];
#pragma unroll
                    for (int j = 0; j < 4; ++j) { const f32x2_t lo = __builtin_amdgcn_cvt_pk_f32_fp8((int)yr[k][j], false), hi = __builtin_amdgcn_cvt_pk_f32_fp8((int)yr[k][j], true); a[j] += (f32x4){lo[0], lo[1], hi[0], hi[1]} * wk; } }
                float s = 0.f;
#pragma unroll
                for (int j = 0; j < 4; ++j) { v[j] = v[j] + g2[j] * a[j]; s += (v[j].x * v[j].x + v[j].y * v[j].y) + (v[j].z * v[j].z + v[j].w * v[j].w); }
                const float rstd = 1.0f / sqrtf(wave_sum(s) * (1.f / D) + RMS_EPS);
                GAS f32x4* dr = (GAS f32x4*)(dst13 + (size_t)m * D + 4 * lane);
#pragma unroll
                for (int j = 0; j < 4; ++j) dr[64 * j] = v[j] * rstd * fg[j];
            }
        }
    REP_END(13) }
#if defined(DBG_DUMP)
    {
        xcd_barrier(bar);
        const bf16* SRC = DBG_DUMP_SRC; const int ld = DBG_DUMP_LD, off = DBG_DUMP_OFF;
        for (int m = F.gw; m < T; m += F.NGW) {
#pragma unroll
            for (int j = 0; j < 4; ++j) { const int c = 4 * lane + 256 * j; const int cc = c % DBG_DUMP_W; const v2u y = *(const v2u*)(SRC + (size_t)m * ld + off + cc); *(f32x4*)(out + (size_t)m * 1024 + c) = (f32x4){bflo(y.x), bfhi(y.x), bflo(y.y), bfhi(y.y)}; }
        }
    }
#endif
#undef IN
#undef SEAM
}

#undef X_IN
#undef cvec
#undef ada_w
#undef ada_b
#undef norm1_g
#undef w_in
#undef lb_logits
#undef hg_norm_g
#undef w_branch_a
#undef w_branch_b
#undef w_out
#undef norm2_g
#undef w_router
#undef router_bias
#undef w_exp_gate
#undef w_exp_up
#undef w_exp_down
#undef w_sh_gate
#undef w_sh_up
#undef w_sh_down
#undef final_g
#undef out
#undef WIN_T
#undef WA_T
#undef WB_T
#undef WO_T
#undef RS_T
#undef WSD_T
#undef WD
#undef WGU
#undef PE
#undef PR
#undef PW
#undef SLOT_TOK
#undef SLOT_W
#undef TOK_SLOT
#undef LSE
#undef QF
#undef OA
#undef OG
#undef MERGED
#undef HMID
#undef YSH
#undef AQKV
#undef GAB
#undef XN
#undef YA
#undef YB
#undef H2
#undef LOGITS
#undef YSLOT
#undef MOD
#undef HISTG
#undef ATTQ
#ifndef DBG_MOE
#define DBG_MOE 2
#endif
#ifndef MK_CUTS
#define MK_CUTS 1
#endif
extern "C" void kernel_launch(void* const* d_in, const int* in_sizes, int n_in, void* d_out, int out_size, void* d_ws, size_t ws_size, hipStream_t stream) {
    static int grid = 0;
    if (grid == 0) {
        if (n_in != 21 || out_size != T * D || ws_size < WS_END) { fprintf(stderr, "kernel_launch: unexpected shapes (n_in %d out %d ws %zu)\n", n_in, out_size, ws_size); grid = -1; return; }
        int dev = 0, cus = 0, per_cu = 0;
        if (hipGetDevice(&dev) != hipSuccess || hipDeviceGetAttribute(&cus, hipDeviceAttributeMultiprocessorCount, dev) != hipSuccess) { grid = -1; return; }
        if (hipFuncSetAttribute((const void*)mk_fwd, hipFuncAttributeMaxDynamicSharedMemorySize, LDS_BYTES) != hipSuccess) { fprintf(stderr, "kernel_launch: hipFuncSetAttribute failed\n"); grid = -1; return; }
        if (hipOccupancyMaxActiveBlocksPerMultiprocessor(&per_cu, (const void*)mk_fwd, NWAVES * 64, LDS_BYTES) != hipSuccess || per_cu < 1) fprintf(stderr, "kernel_launch: occupancy query reports %d\n", per_cu);
        (void)hipGetLastError();
        grid = cus;
    }
    if (grid < 0) return;
    if (hipMemsetAsync((char*)d_ws + WS_CTL, 0, CTL_ZERO_BYTES, stream) != hipSuccess) return;
    Args a{};
    for (int i = 0; i < 21; ++i) a.in[i] = (const float*)d_in[i];
    a.out = (float*)d_out; a.ws = (unsigned char*)d_ws;
#if MK_CUTS == 1
    a.ph_lo = 0; a.ph_hi = 14;
    hipLaunchKernelGGL(mk_fwd, dim3(grid), dim3(NWAVES * 64), LDS_BYTES, stream, a);
#else
    for (int p = 0; p < 14; ++p) { a.ph_lo = p; a.ph_hi = p + 1; hipLaunchKernelGGL(mk_fwd, dim3(grid), dim3(NWAVES * 64), LDS_BYTES, stream, a); }
#endif
}
```

```cpp
#include <hip/hip_runtime.h>
#include <cstdio>
#include <cstdint>
#ifndef DBG_MOE
#define DBG_MOE 2
#endif

#define GAS __attribute__((address_space(1)))
#define LAS __attribute__((address_space(3)))
typedef unsigned short bf16;
typedef unsigned v4u __attribute__((ext_vector_type(4)));
typedef unsigned v2u __attribute__((ext_vector_type(2)));
typedef float f32x4 __attribute__((ext_vector_type(4)));
typedef short bf16x8 __attribute__((ext_vector_type(8)));
typedef short bf16x4 __attribute__((ext_vector_type(4)));
typedef short v4i16_t __attribute__((ext_vector_type(4)));
typedef GAS unsigned gu32;

constexpr int NB = 8, SEQ = 4096, D = 1024, T = NB * SEQ;
constexpr int NIN = 6400;
constexpr int NEXP = 256, TOPK = 8, DEXP = 256;
constexpr int NSLOT = T * TOPK;
constexpr int MAXRT = NSLOT / 256 + NEXP;
constexpr int NSLOTP = MAXRT * 256;
constexpr int MAXTILES = MAXRT + T / 256;
constexpr float RMS_EPS = 1e-6f;
constexpr int NWAVES = 8;
constexpr int SH_WD = 5, SH_HMID = 2, SH_WGU = 6, SH_X = 2, SH_Y = 3, SH_G = 2, SH_U = 2, SH_M = 3, SH_YAB = 2, SH_WAB = 5, SH_Q = 2;
constexpr int SC_WD = 0x01010101 * (127 - SH_WD), SC_HMID = 0x01010101 * (127 - SH_HMID), SC_WGU = 0x01010101 * (127 - SH_WGU), SC_X = 0x01010101 * (127 - SH_X), SC_M = 0x01010101 * (127 - SH_M), SC_YAB = 0x01010101 * (127 - SH_YAB), SC_WAB = 0x01010101 * (127 - SH_WAB);

constexpr size_t MiB = 1u << 20;
constexpr size_t WS_CTL = 0, CTL_ZERO_BYTES = 1 * MiB;
constexpr size_t WS_WIN_T = 1 * MiB;
constexpr size_t WS_WA_T = 14 * MiB;
constexpr size_t WS_WB_T = 15 * MiB;
constexpr size_t WS_WO_T = 16 * MiB;
constexpr size_t WS_RS_T = 18 * MiB;
constexpr size_t WS_WSD_T = 20 * MiB;
constexpr size_t WS_PE = 21 * MiB, WS_PR = 22 * MiB, WS_PW = 23 * MiB;
constexpr size_t WS_SLOT_TOK = 24 * MiB, WS_SLOT_W = 25 * MiB, WS_TOK_SLOT = 27 * MiB;
constexpr size_t WS_LSE = 28 * MiB;
constexpr size_t WS_HISTG = 31 * MiB;
constexpr size_t WS_MOD = 30 * MiB;
constexpr size_t WS_WD = 32 * MiB;
constexpr size_t WS_QF = 160 * MiB;
constexpr size_t WS_OA = 288 * MiB;
constexpr size_t WS_OG = 320 * MiB;
constexpr size_t WS_MERGED = 288 * MiB;
constexpr size_t WS_HMID = 160 * MiB;
constexpr size_t WS_YSH = 304 * MiB;
constexpr size_t WS_WGU = 384 * MiB;
constexpr size_t WS_AQKV = 640 * MiB;
constexpr size_t WS_GAB = 784 * MiB;
constexpr size_t WS_XN = 912 * MiB;
constexpr size_t WS_YA = 640 * MiB;
constexpr size_t WS_YB = 368 * MiB;
constexpr size_t WS_H2 = 640 * MiB;
constexpr size_t WS_H2F8 = 912 * MiB;
constexpr size_t WS_X1B = 736 * MiB;
constexpr size_t WS_LOGITS = 704 * MiB;
constexpr size_t WS_YSLOT = 384 * MiB;
constexpr size_t WS_UT = 912 * MiB;
constexpr size_t WS_QTB = 976 * MiB;
constexpr size_t WS_DK = 1008 * MiB;
constexpr size_t WS_PART = 18 * MiB;
constexpr size_t WS_CB = 19 * MiB;
constexpr size_t WS_RSTD = 19 * MiB + 65536;
constexpr size_t WS_WRB = 1009 * MiB;
constexpr size_t WS_END = 1013 * MiB;
constexpr int CW_TMO = 0, CW_CODE = 1, CW_BAR = 4096, CW_GCNT = 16384, CW_ATTQ = 20480, CW_MOD = 65536;

constexpr int RING_BYTES = 131072;
constexpr int TAB_OFF = RING_BYTES;
constexpr int MISC_OFF = TAB_OFF + MAXTILES * 16;
constexpr int LDS_BYTES = MISC_OFF + 256;

#define RLX_AGENT __ATOMIC_RELAXED, __HIP_MEMORY_SCOPE_AGENT
#define LDS_WAIT() asm volatile("s_waitcnt lgkmcnt(0)" ::: "memory")
#define VM_WAIT() asm volatile("s_waitcnt vmcnt(0)" ::: "memory")
#define LBAR() do { asm volatile("s_waitcnt lgkmcnt(0)" ::: "memory"); __builtin_amdgcn_s_barrier(); asm volatile("" ::: "memory"); } while (0)
typedef float f32x2_t __attribute__((ext_vector_type(2))); typedef __bf16 bf16x2_t __attribute__((ext_vector_type(2)));
__device__ __forceinline__ unsigned cvt_pk_bf16(float lo, float hi) { f32x2_t v = {lo, hi}; bf16x2_t b = __builtin_convertvector(v, bf16x2_t); return __builtin_bit_cast(unsigned, b); }
typedef int v8i __attribute__((ext_vector_type(8))); typedef int v4i_t __attribute__((ext_vector_type(4)));
__device__ __forceinline__ unsigned cvt4_fp8(float a, float b, float c, float d) {
    a = __builtin_amdgcn_fmed3f(a, -448.f, 448.f); b = __builtin_amdgcn_fmed3f(b, -448.f, 448.f); c = __builtin_amdgcn_fmed3f(c, -448.f, 448.f); d = __builtin_amdgcn_fmed3f(d, -448.f, 448.f);
    int w = 0; w = __builtin_amdgcn_cvt_pk_fp8_f32(a, b, w, false); w = __builtin_amdgcn_cvt_pk_fp8_f32(c, d, w, true); return (unsigned)w; }
__device__ __forceinline__ v4u f8x8_to_bf16(unsigned w0, unsigned w1) {
    const f32x2_t a = __builtin_amdgcn_cvt_pk_f32_fp8((int)w0, false), b = __builtin_amdgcn_cvt_pk_f32_fp8((int)w0, true), c = __builtin_amdgcn_cvt_pk_f32_fp8((int)w1, false), d = __builtin_amdgcn_cvt_pk_f32_fp8((int)w1, true);
    v4u o; o.x = cvt_pk_bf16(a[0], a[1]); o.y = cvt_pk_bf16(b[0], b[1]); o.z = cvt_pk_bf16(c[0], c[1]); o.w = cvt_pk_bf16(d[0], d[1]); return o; }
__device__ __forceinline__ float bf2f(unsigned h) { return __uint_as_float(h << 16); }
__device__ __forceinline__ float bflo(unsigned w) { return __uint_as_float(w << 16); }
__device__ __forceinline__ float bfhi(unsigned w) { return __uint_as_float(w & 0xffff0000u); }
__device__ __forceinline__ float fsigmoid(float x) { return __builtin_amdgcn_rcpf(1.0f + __expf(-x)); }
__device__ __forceinline__ float fsilu(float x) { return x * fsigmoid(x); }
__device__ __forceinline__ float wave_sum(float v) {
#pragma unroll
    for (int o = 1; o < 64; o <<= 1) v += __shfl_xor(v, o);
    return v;
}

#define XB_TMO      128
#define XB_XCNT(j)  (256  + 64 * (j))
#define XB_XSUB(j)  (1280 + 64 * (j))
#define XB_XGEN(j)  (2304 + 64 * (j))
#define XB_TOP      3328
#define XB_TOPGEN   3392
#define XCD_BAR_WORDS 3456
#define XB_SPIN_CAP (1u << 18)
__device__ __forceinline__ unsigned xb_ld(unsigned* p)              { return __hip_atomic_load(p, __ATOMIC_RELAXED, __HIP_MEMORY_SCOPE_AGENT); }
__device__ __forceinline__ unsigned xb_add(unsigned* p, unsigned v) { return __hip_atomic_fetch_add(p, v, __ATOMIC_RELAXED, __HIP_MEMORY_SCOPE_AGENT); }
__device__ __forceinline__ unsigned xb_xcc_id() { return (unsigned)__builtin_amdgcn_s_getreg((3 << 11) | 20) & 0xFu; }
#define XB_SPIN(cond, bar) do { unsigned _sp = 0; while (cond) { __builtin_amdgcn_s_sleep(1); \
    if ((++_sp & 255u) == 0u) { if (xb_ld(&(bar)[XB_TMO])) break; if (_sp > XB_SPIN_CAP) { atomicAdd(&(bar)[XB_TMO], 1u); break; } } } } while (0)
struct XcdBarrier { unsigned* bar; unsigned x; volatile LAS unsigned* st; };
__device__ __forceinline__ XcdBarrier xcd_barrier_post(unsigned* bar, volatile LAS unsigned* st) {
    XcdBarrier b; b.bar = bar; b.x = xb_xcc_id(); b.st = st;
    if (threadIdx.x == 0) (void)xb_add(&bar[XB_XCNT(b.x)], 1u);
    return b;
}
__device__ __forceinline__ void xcd_barrier_complete(unsigned* bar, unsigned x, unsigned& nloc, unsigned& nx) {
    const unsigned G = gridDim.x * gridDim.y * gridDim.z;
    unsigned sum, cnt, mine, sp = 0u;
    for (;;) {
        sum = 0u; cnt = 0u; mine = 0u;
#pragma unroll
        for (unsigned j = 0; j < 16; ++j) { const unsigned c = xb_ld(&bar[XB_XCNT(j)]); sum += c; cnt += (c > 0u) ? 1u : 0u; mine = (j == x) ? c : mine; }
        if (sum == G) break;
        __builtin_amdgcn_s_sleep(1);
        if ((++sp & 255u) == 0u) { if (xb_ld(&bar[XB_TMO])) break; if (sp > XB_SPIN_CAP) { atomicAdd(&bar[XB_TMO], 1u); break; } }
    }
    nloc = mine > 0u ? mine : 1u; nx = cnt > 0u ? cnt : 1u;
}
__device__ __forceinline__ void xcd_barrier(const XcdBarrier& b) {
    asm volatile("s_waitcnt vmcnt(0)" ::: "memory");
    __syncthreads();
    if (threadIdx.x == 0) {
        unsigned* bar = b.bar;
        __builtin_amdgcn_s_waitcnt(0);
        unsigned nloc = b.st[0], nx = b.st[1];
        if (nloc == 0u) { xcd_barrier_complete(bar, b.x, nloc, nx); b.st[0] = nloc; b.st[1] = nx; }
        const unsigned old = xb_add(&bar[XB_XSUB(b.x)], 1u);
        const unsigned gen = old / nloc;
        if (old + 1u == (gen + 1u) * nloc) {
            __builtin_amdgcn_fence(__ATOMIC_RELEASE, "agent");
            asm volatile("s_waitcnt vmcnt(0)" ::: "memory");
            const unsigned og = xb_add(&bar[XB_TOP], 1u);
            const unsigned tg = og / nx;
            if (og + 1u == (tg + 1u) * nx) xb_add(&bar[XB_TOPGEN], 1u);
            else XB_SPIN(xb_ld(&bar[XB_TOPGEN]) == tg, bar);
            __builtin_amdgcn_fence(__ATOMIC_ACQUIRE, "agent");
            xb_add(&bar[XB_XGEN(b.x)], 1u);
            asm volatile("s_waitcnt vmcnt(0)" ::: "memory");
        } else {
            XB_SPIN(xb_ld(&bar[XB_XGEN(b.x)]) == gen, bar);
            __builtin_amdgcn_fence(__ATOMIC_ACQUIRE, "agent");
            asm volatile("s_waitcnt vmcnt(0)" ::: "memory");
        }
    }
    __syncthreads();
}

__device__ __forceinline__ void glds16s(const void* sbase, unsigned voff, unsigned lds_dst) {
    unsigned keep;
    asm volatile("s_mov_b32 %0, m0\n\ts_mov_b32 m0, %3\n\ts_nop 0\n\tglobal_load_lds_dwordx4 %1, %2\n\ts_mov_b32 m0, %0" : "=&s"(keep) : "v"(voff), "s"(sbase), "s"(lds_dst) : "memory");
}
namespace pg8 {
constexpr int BM = 256, BK = 64, HALF = 128, HTB = HALF * BK * 2, NXCD = 8, WGM = 8;
__host__ __device__ __forceinline__ int lds_byte(int r, int c) { const int st = (r >> 4) * 2 + (c >> 5), rr = r & 15, cc = c & 31, ob = rr * 64 + cc * 2; return st * 1024 + (ob ^ (((ob >> 9) & 1) << 5)); }
__host__ __device__ __forceinline__ void stage_rc(int b, int& R, int& C) { const int st = b / 1024, sb = b % 1024, swz = sb ^ (((sb >> 9) & 1) << 5); R = (st >> 1) * 16 + swz / 64; C = (st & 1) * 32 + (swz % 64) / 2; }
__host__ __device__ __forceinline__ int perm32(int rho) { const int n = rho >> 4, i = rho & 15; return 8 * (i >> 2) + 4 * n + (i & 3); }
struct Unit { int pm, pn, e, row0, rows; };

struct DenseSched {
    int nM, nN, nwg, G, c; unsigned rowbytes; int arow0; const char* Bt;
    __device__ void init(int M, int N, int Kbytes, int G_, int c_, const void* Bt_, int arow0_ = 0) { nM = M / BM; nN = N / BM; nwg = nM * nN; G = G_; c = c_; rowbytes = (unsigned)Kbytes; arow0 = arow0_; Bt = (const char*)Bt_; }
    __device__ __forceinline__ bool next(int i, Unit& u) const {
        const long L = (long)i * G + c; if (L >= nwg) return false;
        int wgid = (int)L; { const int q = nwg / NXCD, r = nwg % NXCD, xcd = wgid % NXCD, off = wgid / NXCD; wgid = (xcd < r ? xcd * (q + 1) : r * (q + 1) + (xcd - r) * q) + off; }
        const int nig = WGM * nN, gid = wgid / nig, fm = gid * WGM, gsz = (nM - fm) < WGM ? (nM - fm) : WGM;
        u.pm = fm + ((wgid % nig) % gsz); u.pn = (wgid % nig) / gsz; u.e = 0; u.row0 = u.pm * BM; u.rows = BM; return true;
    }
    __device__ __forceinline__ unsigned a_off(const Unit& u, int r) const { return (unsigned)(arow0 + u.pm * BM + r) * rowbytes; }
    __device__ __forceinline__ const char* b_base(const Unit& u) const { return Bt + (size_t)u.pn * BM * rowbytes; }
};
template <int NPN, bool GATHER>
struct RoutedSched {
    const LAS int* tab; int ntiles, G, c; unsigned rowbytes; const char* Bt; size_t estride; const int* rowlist;
    __device__ __forceinline__ bool next(int i, Unit& u) const {
        const long L = (long)i * G + c; if (L >= (long)ntiles * NPN) return false;
        const int ti = (int)(L / NPN); u.pn = (int)(L % NPN); u.pm = ti;
        u.e = __builtin_amdgcn_readfirstlane(tab[ti * 4 + 0]); u.row0 = __builtin_amdgcn_readfirstlane(tab[ti * 4 + 1]); u.rows = __builtin_amdgcn_readfirstlane(tab[ti * 4 + 2]); return true;
    }
    __device__ __forceinline__ unsigned a_off(const Unit& u, int r) const {
        const int s = u.row0 + r;
        if (GATHER) return (unsigned)rowlist[s] * rowbytes; else return (unsigned)s * rowbytes;
    }
    __device__ __forceinline__ const char* b_base(const Unit& u) const { return Bt + (size_t)u.e * estride + (size_t)u.pn * BM * rowbytes; }
};

struct RouterSched {
    int n, G, c; const char* Bt;
    __device__ __forceinline__ bool next(int i, Unit& u) const { const long L = (long)i * G + c; if (L >= n) return false; u.pm = (int)L; u.pn = 0; u.e = 0; u.row0 = u.pm * BM; u.rows = BM; return true; }
    __device__ __forceinline__ unsigned a_off(const Unit& u, int r) const { return (unsigned)(u.pm * BM + r) * 2048u; }
    __device__ __forceinline__ const char* b_base(const Unit& u) const { return Bt + (size_t)(u.pm >> 4) * (256 * 2048); }
};

template <bool ALIGN_EPI, bool FP8, class Epi, class Sched, int CM = 1>
__device__ __forceinline__ void gemm_phase(LAS unsigned char* lds, const char* Abase, const int Kbytes, const Sched& S, const Epi& E, const int scaleW = 0x7F7F7F7F, const int scaleX = 0x7F7F7F7F) {
    int tid = threadIdx.x; asm volatile("" : "+v"(tid));
    const int wid = __builtin_amdgcn_readfirstlane(tid >> 6), lane = tid & 63, wr = wid >> 2, wc = wid & 3, fr = lane & 15, fq = lane >> 4;
    const int nt = Kbytes / (BK * 2);
    unsigned voffB[2];
#pragma unroll
    for (int i = 0; i < 2; ++i) { int R, C; stage_rc(tid * 16 + i * 8192, R, C); const int Rb = (CM == 2) ? 2 * (R & ~31) + 16 * ((R & 15) >> 2) + 4 * ((R >> 4) & 1) + (R & 3) : (CM ? 2 * (R & ~31) : (R & ~31)) + perm32(R & 31); voffB[i] = (unsigned)(Rb * Kbytes + C * 2); }
    const size_t kstep = (size_t)(BK * 2);
    const size_t hstepB = (size_t)(CM == 2 ? 8 : CM ? 32 : HALF) * Kbytes;
    const unsigned ldsw = (unsigned)wid * 1024u;
    const unsigned lds0 = (unsigned)(uintptr_t)lds;
    const int aoff = lds_byte(wr * 64 + fr, fq * 8), boff = lds_byte(wc * 32 + fr, fq * 8);
#define PG8_SA(b, h) (((b) * 2 + (h)) * HTB)
#define PG8_SB(b, h) ((4 + (b) * 2 + (h)) * HTB)
#define PG8_STAGE(bufoff, gbase, voff) do { _Pragma("unroll") for (int _i = 0; _i < 2; ++_i) \
        glds16s((const void*)(gbase), (voff)[_i], lds0 + (unsigned)((bufoff) + _i * 8192) + ldsw); } while (0)
#define PG8_LD2(p) __builtin_shufflevector(*(const LAS v4i_t*)(p), *(const LAS v4i_t*)((p) + 1024), 0, 1, 2, 3, 4, 5, 6, 7)
#define PG8_LDA(dst, b, h) do { _Pragma("unroll") for (int m = 0; m < 4; ++m) dst[m] = PG8_LD2(lds + PG8_SA(b, h) + aoff + m * 2048); } while (0)
#define PG8_LDB(dst, b, h) do { _Pragma("unroll") for (int n = 0; n < 2; ++n) dst[n] = PG8_LD2(lds + PG8_SB(b, h) + boff + n * 2048); } while (0)
#define PG8_LO(v) __builtin_bit_cast(bf16x8, __builtin_shufflevector(v, v, 0, 1, 2, 3))
#define PG8_HI(v) __builtin_bit_cast(bf16x8, __builtin_shufflevector(v, v, 4, 5, 6, 7))
#define PG8_MMA(ai, bj, At, Bt) do { __builtin_amdgcn_s_setprio(1); _Pragma("unroll") for (int m = 0; m < 4; ++m) _Pragma("unroll") for (int n = 0; n < 2; ++n) { \
        if constexpr (FP8) acc[ai][bj][m][n] = __builtin_amdgcn_mfma_scale_f32_16x16x128_f8f6f4(Bt[n], At[m], acc[ai][bj][m][n], 0, 0, 0, scaleW, 0, scaleX); \
        else { acc[ai][bj][m][n] = __builtin_amdgcn_mfma_f32_16x16x32_bf16(PG8_LO(Bt[n]), PG8_LO(At[m]), acc[ai][bj][m][n], 0, 0, 0); acc[ai][bj][m][n] = __builtin_amdgcn_mfma_f32_16x16x32_bf16(PG8_HI(Bt[n]), PG8_HI(At[m]), acc[ai][bj][m][n], 0, 0, 0); } } __builtin_amdgcn_s_setprio(0); } while (0)
#define PG8_WAIT_V(n) asm volatile("s_waitcnt vmcnt(" #n ")" ::: "memory")
#define PG8_WAIT_L(n) asm volatile("s_waitcnt lgkmcnt(" #n ")" ::: "memory")
#define PG8_BAR __builtin_amdgcn_s_barrier()
#define PG8_SCHED __builtin_amdgcn_sched_barrier(0)
#define PG8_AOFF(u, o0, o1) do { int _t = tid; asm volatile("" : "+v"(_t)); _Pragma("unroll") for (int _i = 0; _i < 2; ++_i) { int _R, _C; stage_rc(_t * 16 + _i * 8192, _R, _C); \
        o0[_i] = S.a_off(u, _R) + (unsigned)_C * 2u; o1[_i] = S.a_off(u, _R + HALF) + (unsigned)_C * 2u; } } while (0)
    Unit cur, nxt; int ui = 0;
    if (!S.next(0, cur)) return;
    f32x4 acc[2][2][4][2];
#pragma unroll
    for (int a = 0; a < 2; ++a)
#pragma unroll
        for (int b = 0; b < 2; ++b)
#pragma unroll
            for (int m = 0; m < 4; ++m)
#pragma unroll
                for (int n = 0; n < 2; ++n) acc[a][b][m][n] = (f32x4){0.f, 0.f, 0.f, 0.f};
    v8i At[4], B0[2], B1[2];
    unsigned cA0[2], cA1[2];
    PG8_AOFF(cur, cA0, cA1);
    const char* cB = S.b_base(cur); const char* nB = cB;
    PG8_STAGE(PG8_SB(0, 0), cB, voffB); PG8_STAGE(PG8_SB(0, 1), cB + hstepB, voffB); PG8_STAGE(PG8_SA(0, 0), Abase, cA0); PG8_STAGE(PG8_SA(0, 1), Abase, cA1);
    if (wr == 1) PG8_BAR;
    PG8_WAIT_V(2); PG8_BAR;
    PG8_STAGE(PG8_SB(1, 0), cB + kstep, voffB); PG8_STAGE(PG8_SA(1, 0), Abase + kstep, cA0); PG8_STAGE(PG8_SB(1, 1), cB + hstepB + kstep, voffB);
    PG8_WAIT_V(6); PG8_BAR;
    for (;;) {
        const bool has_next = S.next(ui + 1, nxt);
#pragma unroll 1
        for (int t = 0; t < nt; t += 2) {
            const bool last = (t == nt - 2);
            if constexpr (Epi::MID_T > 0) { if (t == Epi::MID_T) { PG8_SCHED; E.mid(acc, cur, wr, wc, fr, fq); PG8_SCHED; } }
            if (last && has_next) nB = S.b_base(nxt);
            const char* a1 = Abase + (size_t)(t + 1) * kstep;
            const char* a2 = last ? Abase : Abase + (size_t)(t + 2) * kstep; const char* b2 = last ? nB : cB + (size_t)(t + 2) * kstep;
            const char* a3 = a2 + kstep; const char* b3 = b2 + kstep;
            PG8_LDB(B0, 0, 0); PG8_LDB(B1, 0, 1); PG8_SCHED; PG8_LDA(At, 0, 0); PG8_STAGE(PG8_SA(1, 1), a1, cA1);
            if (last && has_next) { PG8_AOFF(nxt, cA0, cA1); }
            PG8_WAIT_V(8); PG8_WAIT_L(0); PG8_BAR; PG8_MMA(0, 0, At, B0); PG8_MMA(0, 1, At, B1); PG8_BAR; PG8_SCHED;
            PG8_LDA(At, 0, 1); PG8_STAGE(PG8_SB(0, 0), b2, voffB); PG8_STAGE(PG8_SB(0, 1), b2 + hstepB, voffB); PG8_STAGE(PG8_SA(0, 0), a2, cA0);
            PG8_WAIT_V(8); PG8_WAIT_L(0); PG8_BAR; PG8_MMA(1, 0, At, B0); PG8_MMA(1, 1, At, B1); PG8_BAR; PG8_SCHED;
            PG8_LDB(B0, 1, 0); PG8_LDB(B1, 1, 1); PG8_SCHED; PG8_LDA(At, 1, 0); PG8_STAGE(PG8_SA(0, 1), a2, cA1);
            PG8_WAIT_V(8); PG8_WAIT_L(0); PG8_BAR; PG8_MMA(0, 0, At, B0); PG8_MMA(0, 1, At, B1); PG8_BAR; PG8_SCHED;
            PG8_LDA(At, 1, 1); PG8_STAGE(PG8_SB(1, 0), b3, voffB); PG8_STAGE(PG8_SB(1, 1), b3 + hstepB, voffB); PG8_STAGE(PG8_SA(1, 0), a3, cA0);
            PG8_WAIT_V(8); PG8_WAIT_L(0); PG8_BAR; PG8_MMA(1, 0, At, B0); PG8_MMA(1, 1, At, B1); PG8_BAR; PG8_SCHED;
        }
        if constexpr (ALIGN_EPI) { if (wr == 0) PG8_BAR; }
        { Unit eu = cur; int efr = fr, efq = fq; asm volatile("" : "+s"(eu.pm), "+s"(eu.pn), "+s"(eu.e), "+s"(eu.row0), "+s"(eu.rows), "+v"(efr), "+v"(efq)); E(acc, eu, wr, wc, efr, efq); }
        if (!has_next) break;
#pragma unroll
        for (int a = 0; a < 2; ++a)
#pragma unroll
            for (int b = 0; b < 2; ++b)
#pragma unroll
                for (int m = 0; m < 4; ++m)
#pragma unroll
                    for (int n = 0; n < 2; ++n) acc[a][b][m][n] = (f32x4){0.f, 0.f, 0.f, 0.f};
        cur = nxt; cB = nB; ++ui;
        if constexpr (ALIGN_EPI) { if (wr == 1) PG8_BAR; }
    }
    PG8_WAIT_V(0);
    if constexpr (!ALIGN_EPI) { if (wr == 0) PG8_BAR; }
    PG8_BAR;
#undef PG8_SA
#undef PG8_SB
#undef PG8_STAGE
#undef PG8_LDA
#undef PG8_LDB
#undef PG8_MMA
#undef PG8_LO
#undef PG8_HI
#undef PG8_LD2
#undef PG8_WAIT_V
#undef PG8_WAIT_L
#undef PG8_BAR
#undef PG8_SCHED
#undef PG8_AOFF
}

constexpr int WCS = 64, BJS = 32;
#define EPI_ROWS_BEGIN _Pragma("unroll") for (int ai = 0; ai < 2; ++ai) _Pragma("unroll") for (int m = 0; m < 4; ++m) { const int rt = ai * HALF + wr * 64 + m * 16 + fr;
#define EPI_ROWS_END }
__device__ __forceinline__ v4u pack8(const f32x4 a, const f32x4 b) { v4u w; w.x = cvt_pk_bf16(a[0], a[1]); w.y = cvt_pk_bf16(a[2], a[3]); w.z = cvt_pk_bf16(b[0], b[1]); w.w = cvt_pk_bf16(b[2], b[3]); return w; }

__device__ __forceinline__ v2u act8_fp8(const f32x4 a, const f32x4 b, const bool silu) {
    const float sc = (float)(1 << SH_G); float x[8] = {a[0], a[1], a[2], a[3], b[0], b[1], b[2], b[3]};
#pragma unroll
    for (int j = 0; j < 8; ++j) { const float sg = fsigmoid(x[j]); x[j] = (silu ? x[j] * sg : sg) * sc; }
    v2u w; w.x = cvt4_fp8(x[0], x[1], x[2], x[3]); w.y = cvt4_fp8(x[4], x[5], x[6], x[7]); return w;
}
struct EpiWin { static constexpr int MID_T = 0;
    unsigned char *QF8, *AQKV8, *GAB8, *HG8; int dry;
    __device__ __forceinline__ void operator()(const f32x4 (&acc)[2][2][4][2], const Unit& u, int wr, int wc, int fr, int fq) const {
        if (dry) return;
        if (u.pn >= 17 || u.pn == 6 || u.pn == 7) {
            const bool silu = u.pn < 8; unsigned char* base = silu ? HG8 : GAB8; const int ldc = silu ? 512 : 2048, ct = silu ? u.pn - 6 : u.pn - 17;
            const int col0 = ct * BM + wc * 64 + 16 * fq;
            EPI_ROWS_BEGIN { unsigned char* rowp = base + (size_t)(u.pm * BM + rt) * ldc + col0;
                const v2u lo = act8_fp8(acc[ai][0][m][0], acc[ai][0][m][1], silu), hi = act8_fp8(acc[ai][1][m][0], acc[ai][1][m][1], silu);
                *(v4u*)rowp = (v4u){lo.x, lo.y, hi.x, hi.y}; } EPI_ROWS_END
            return;
        }
        unsigned char* base; int ldc, ct;
        if (u.pn < 8) { base = QF8; ldc = 1536; ct = u.pn; } else { base = AQKV8; ldc = 2304; ct = u.pn - 8; }
        const int col0 = ct * BM + wc * 64 + 16 * fq; const float sq = (float)(1 << SH_Q);
        EPI_ROWS_BEGIN { unsigned char* rowp = base + (size_t)(u.pm * BM + rt) * ldc + col0;
            const f32x4 a = acc[ai][0][m][0] * sq, b = acc[ai][0][m][1] * sq, c = acc[ai][1][m][0] * sq, d = acc[ai][1][m][1] * sq;
            *(v4u*)rowp = (v4u){cvt4_fp8(a[0], a[1], a[2], a[3]), cvt4_fp8(b[0], b[1], b[2], b[3]), cvt4_fp8(c[0], c[1], c[2], c[3]), cvt4_fp8(d[0], d[1], d[2], d[3])}; } EPI_ROWS_END
    }
};
template <bool ADD> struct EpiBranch { static constexpr int MID_T = 0;
    const unsigned char* G; int goff; bf16* O;
    __device__ __forceinline__ void operator()(const f32x4 (&acc)[2][2][4][2], const Unit& u, int wr, int wc, int fr, int fq) const {
        const int col0 = u.pn * BM + wc * WCS + 8 * fq;
        EPI_ROWS_BEGIN { const size_t row = (size_t)(u.pm * BM + rt);
#pragma unroll
            for (int bj = 0; bj < 2; ++bj) {
                const v2u g = *(const v2u*)(G + row * 2048 + goff + col0 + bj * BJS); const float gs = 1.0f / (float)(1 << SH_G);
                const f32x2_t g0 = __builtin_amdgcn_cvt_pk_f32_fp8((int)g.x, false), g1 = __builtin_amdgcn_cvt_pk_f32_fp8((int)g.x, true), g2 = __builtin_amdgcn_cvt_pk_f32_fp8((int)g.y, false), g3 = __builtin_amdgcn_cvt_pk_f32_fp8((int)g.y, true);
                f32x4 a = acc[ai][bj][m][0] * (f32x4){g0[0], g0[1], g1[0], g1[1]} * gs, b = acc[ai][bj][m][1] * (f32x4){g2[0], g2[1], g3[0], g3[1]} * gs;
                bf16* op = O + row * 1024 + col0 + bj * BJS;
                if (ADD) { const v4u o = *(const v4u*)op; a[0] += bflo(o.x); a[1] += bfhi(o.x); a[2] += bflo(o.y); a[3] += bfhi(o.y); b[0] += bflo(o.z); b[1] += bfhi(o.z); b[2] += bflo(o.w); b[3] += bfhi(o.w); }
                *(v4u*)op = pack8(a, b); } } EPI_ROWS_END
    }
};
struct EpiMerge {
    static constexpr int MID_T = 4;
    const unsigned char* G; unsigned char* O;
    __device__ __forceinline__ static void dec8(const v2u g, float (&f)[8]) { const f32x2_t a = __builtin_amdgcn_cvt_pk_f32_fp8((int)g.x, false), b = __builtin_amdgcn_cvt_pk_f32_fp8((int)g.x, true), c = __builtin_amdgcn_cvt_pk_f32_fp8((int)g.y, false), d = __builtin_amdgcn_cvt_pk_f32_fp8((int)g.y, true);
        f[0] = a[0]; f[1] = a[1]; f[2] = b[0]; f[3] = b[1]; f[4] = c[0]; f[5] = c[1]; f[6] = d[0]; f[7] = d[1]; }
    __device__ __forceinline__ void mid(f32x4 (&acc)[2][2][4][2], const Unit& u, int wr, int wc, int fr, int fq) const {
        const int col0 = u.pn * BM + wc * 64 + 16 * fq;
        EPI_ROWS_BEGIN { const size_t row = (size_t)(u.pm * BM + rt);
            const v4u ga = *(const v4u*)(G + row * 2048 + col0), gb = *(const v4u*)(G + row * 2048 + 1024 + col0);
#pragma unroll
            for (int bj = 0; bj < 2; ++bj) { float sa[8], sb[8]; dec8(bj ? (v2u){ga.z, ga.w} : (v2u){ga.x, ga.y}, sa); dec8(bj ? (v2u){gb.z, gb.w} : (v2u){gb.x, gb.y}, sb);
#pragma unroll
                for (int j = 0; j < 4; ++j) { acc[ai][bj][m][0][j] *= sa[j] * __builtin_amdgcn_rcpf(fmaxf(sb[j], 0.001953125f)); acc[ai][bj][m][1][j] *= sa[4 + j] * __builtin_amdgcn_rcpf(fmaxf(sb[4 + j], 0.001953125f)); } } } EPI_ROWS_END
    }
    __device__ __forceinline__ void operator()(const f32x4 (&acc)[2][2][4][2], const Unit& u, int wr, int wc, int fr, int fq) const {
        const int col0 = u.pn * BM + wc * 64 + 16 * fq;
        EPI_ROWS_BEGIN { const size_t row = (size_t)(u.pm * BM + rt);
            const v4u gb = *(const v4u*)(G + row * 2048 + 1024 + col0); unsigned ow[4];
#pragma unroll
            for (int bj = 0; bj < 2; ++bj) { float sb[8]; dec8(bj ? (v2u){gb.z, gb.w} : (v2u){gb.x, gb.y}, sb); const float gs = 1.0f / (float)(1 << SH_G);
                f32x4 a = acc[ai][bj][m][0], b = acc[ai][bj][m][1];
#pragma unroll
                for (int j = 0; j < 4; ++j) { a[j] *= fmaxf(sb[j], 0.001953125f) * (gs * (float)(1 << SH_M)); b[j] *= fmaxf(sb[4 + j], 0.001953125f) * (gs * (float)(1 << SH_M)); }
                ow[2 * bj] = cvt4_fp8(a[0], a[1], a[2], a[3]); ow[2 * bj + 1] = cvt4_fp8(b[0], b[1], b[2], b[3]); }
            *(v4u*)(O + row * 1024 + col0) = (v4u){ow[0], ow[1], ow[2], ow[3]}; } EPI_ROWS_END
    }
};
struct EpiOut { static constexpr int MID_T = 0;
    const float* x; bf16* x1; const float* mod;
    __device__ __forceinline__ void operator()(const f32x4 (&acc)[2][2][4][2], const Unit& u, int wr, int wc, int fr, int fq) const {
        const int col0 = u.pn * BM + wc * WCS + 8 * fq; const int b = u.pm >> 4;
        f32x4 gt[2][2];
#pragma unroll
        for (int bj = 0; bj < 2; ++bj)
#pragma unroll
            for (int n = 0; n < 2; ++n) { const int c = 2048 + col0 + bj * BJS + 4 * n; gt[bj][n] = *(const f32x4*)(mod + b * 6144 + c); }
        EPI_ROWS_BEGIN { const size_t off = (size_t)(u.pm * BM + rt) * 1024 + col0;
#pragma unroll
            for (int bj = 0; bj < 2; ++bj) { const size_t o2 = off + bj * BJS;
                *(v4u*)(x1 + o2) = pack8(*(const f32x4*)(x + o2) + gt[bj][0] * acc[ai][bj][m][0], *(const f32x4*)(x + o2 + 4) + gt[bj][1] * acc[ai][bj][m][1]); } } EPI_ROWS_END
    }
};
__device__ __forceinline__ v4u swiglu8(const f32x4 g0, const f32x4 g1, const f32x4 u0, const f32x4 u1) {
    f32x4 a, b;
#pragma unroll
    for (int j = 0; j < 4; ++j) { a[j] = fsilu(g0[j]) * u0[j]; b[j] = fsilu(g1[j]) * u1[j]; }
    return pack8(a, b);
}
__device__ __forceinline__ v2u swiglu8_fp8(const f32x4 g0, const f32x4 g1, const f32x4 u0, const f32x4 u1) {
    const float sc = (float)(1 << SH_HMID); float a[4], b[4];
#pragma unroll
    for (int j = 0; j < 4; ++j) { a[j] = fsilu(g0[j]) * u0[j] * sc; b[j] = fsilu(g1[j]) * u1[j] * sc; }
    v2u w; w.x = cvt4_fp8(a[0], a[1], a[2], a[3]); w.y = cvt4_fp8(b[0], b[1], b[2], b[3]); return w;
}
struct EpiRS { static constexpr int MID_T = 0;
    float* logits; unsigned char* hsh;
    __device__ __forceinline__ void operator()(const f32x4 (&acc)[2][2][4][2], const Unit& u, int wr, int wc, int fr, int fq) const {
        if (u.pn == 0) {
            EPI_ROWS_BEGIN { float* rowp = logits + (size_t)(u.pm * BM + rt) * 256 + wc * WCS + 8 * fq;
#pragma unroll
                for (int bj = 0; bj < 2; ++bj)
#pragma unroll
                    for (int n = 0; n < 2; ++n) *(f32x4*)(rowp + bj * BJS + 4 * n) = acc[ai][bj][m][n]; } EPI_ROWS_END
        } else {
            const int hc = (u.pn - 1) * HALF + wc * WCS + 8 * fq;
            EPI_ROWS_BEGIN { *(v2u*)(hsh + (size_t)(u.pm * BM + rt) * 256 + hc) = swiglu8_fp8(acc[ai][0][m][0], acc[ai][0][m][1], acc[ai][1][m][0], acc[ai][1][m][1]); } EPI_ROWS_END
        }
    }
};
struct EpiRL { static constexpr int MID_T = 0;
    float* logits;
    __device__ __forceinline__ void operator()(const f32x4 (&acc)[2][2][4][2], const Unit& u, int wr, int wc, int fr, int fq) const {
        EPI_ROWS_BEGIN { float* rowp = logits + (size_t)(u.pm * BM + rt) * 256 + wc * WCS + 8 * fq;
#pragma unroll
            for (int bj = 0; bj < 2; ++bj)
#pragma unroll
                for (int n = 0; n < 2; ++n) *(f32x4*)(rowp + bj * BJS + 4 * n) = acc[ai][bj][m][n]; } EPI_ROWS_END
    }
};
struct EpiGU { static constexpr int MID_T = 0;
    unsigned char* hmid;
    __device__ __forceinline__ void operator()(const f32x4 (&acc)[2][2][4][2], const Unit& u, int wr, int wc, int fr, int fq) const {
        const int hc = u.pn * HALF + wc * 32 + 8 * fq;
        EPI_ROWS_BEGIN { if (rt < u.rows) *(v2u*)(hmid + (size_t)(u.row0 + rt) * 256 + hc) = swiglu8_fp8(acc[ai][0][m][0], acc[ai][0][m][1], acc[ai][1][m][0], acc[ai][1][m][1]); } EPI_ROWS_END
    }
};
struct EpiSD { static constexpr int MID_T = 0;
    bf16* ysh;
    __device__ __forceinline__ void operator()(const f32x4 (&acc)[2][2][4][2], const Unit& u, int wr, int wc, int fr, int fq) const {
        const int col0 = u.pn * BM + wc * WCS + 8 * fq;
        EPI_ROWS_BEGIN { bf16* rowp = ysh + (size_t)(u.pm * BM + rt) * 1024 + col0;
#pragma unroll
            for (int bj = 0; bj < 2; ++bj) *(v4u*)(rowp + bj * BJS) = pack8(acc[ai][bj][m][0], acc[ai][bj][m][1]); } EPI_ROWS_END
    }
};
struct EpiRD { static constexpr int MID_T = 0;
    unsigned char* yslot; const float* slot_w;
    __device__ __forceinline__ void operator()(const f32x4 (&acc)[2][2][4][2], const Unit& u, int wr, int wc, int fr, int fq) const {
        const int col0 = u.pn * BM + wc * 64 + 16 * fq;
        EPI_ROWS_BEGIN { if (rt < u.rows) { const float w = (float)(1 << SH_Y); unsigned char* rowp = yslot + (size_t)(u.row0 + rt) * 1024 + col0;
            const f32x4 a = acc[ai][0][m][0] * w, b = acc[ai][0][m][1] * w, c = acc[ai][1][m][0] * w, d = acc[ai][1][m][1] * w;
            *(v4u*)rowp = (v4u){cvt4_fp8(a[0], a[1], a[2], a[3]), cvt4_fp8(b[0], b[1], b[2], b[3]), cvt4_fp8(c[0], c[1], c[2], c[3]), cvt4_fp8(d[0], d[1], d[2], d[3])}; } } EPI_ROWS_END
    }
};
}

struct Args { const float* in[21]; float* out; unsigned char* ws; int ph_lo, ph_hi; };
struct Frame {
    LAS unsigned char* lds; volatile LAS unsigned* MISC; gu32* ctl;
    int tid, lane, wave, vcu, G, gw, NGW;
};

__device__ __forceinline__ void transpose_item(const float* W, int ldn, bf16* WT, int ldk, int k0, int n0, int drow0, LAS float* scr, int lane) {
#pragma unroll 8
    for (int i = 0; i < 32; ++i) { const int kk = 2 * i + (lane >> 5); scr[kk * 33 + (lane & 31)] = W[(size_t)(k0 + kk) * ldn + n0 + (lane & 31)]; }
    LDS_WAIT(); asm volatile("" ::: "memory");
    const int c = lane & 7;
#pragma unroll
    for (int j = 0; j < 4; ++j) { const int n = (lane >> 3) + 8 * j; const LAS float* s = scr + (8 * c) * 33 + n;
        v4u o; o.x = cvt_pk_bf16(s[0 * 33], s[1 * 33]); o.y = cvt_pk_bf16(s[2 * 33], s[3 * 33]); o.z = cvt_pk_bf16(s[4 * 33], s[5 * 33]); o.w = cvt_pk_bf16(s[6 * 33], s[7 * 33]);
        *(GAS v4u*)(WT + (size_t)(drow0 + n) * ldk + k0 + 8 * c) = o; }
    LDS_WAIT(); asm volatile("" ::: "memory");
}
struct ConvDesc { const float* W; unsigned char* WT; int ldn, ldk, k0, n0, drow0; float scale; };
__device__ __forceinline__ void ti_load(const ConvDesc& d, int lane, f32x4 (&r)[16]) {
#pragma unroll
    for (int i = 0; i < 16; ++i) r[i] = *(const f32x4*)(d.W + (size_t)(d.k0 + 8 * i + (lane >> 3)) * d.ldn + d.n0 + (lane & 7) * 4);
}
#ifndef TR8_MAP
#define TR8_MAP 0
#endif
typedef int v2i_t __attribute__((ext_vector_type(2)));
__device__ __forceinline__ void ti_store(const ConvDesc& d, const f32x4 (&r)[16], LAS float* scr, int lane) {
    LAS unsigned char* Tl = (LAS unsigned char*)scr; const float sc = d.scale;
#pragma unroll
    for (int i = 0; i < 16; ++i) *(LAS unsigned*)(Tl + (8 * i + (lane >> 3)) * 32 + (lane & 7) * 4) = cvt4_fp8(r[i][0] * sc, r[i][1] * sc, r[i][2] * sc, r[i][3] * sc);
    LDS_WAIT(); asm volatile("" ::: "memory");
    const int g = lane >> 4, l = lane & 15, nh = g & 1, ch = g >> 1, n = 16 * nh + l;
    const int rr = TR8_MAP ? (l & 7) : (l >> 1), cc = TR8_MAP ? (l >> 3) : (l & 1);
    LAS unsigned char* T2 = Tl + 4096;
#pragma unroll
    for (int j = 0; j < 4; ++j) { const int c = 4 * ch + j;
        const v2i_t lo = __builtin_amdgcn_ds_read_tr8_b64_v2i32((LAS v2i_t*)(Tl + (16 * c + rr) * 32 + 16 * nh + 8 * cc));
        const v2i_t hi = __builtin_amdgcn_ds_read_tr8_b64_v2i32((LAS v2i_t*)(Tl + (16 * c + 8 + rr) * 32 + 16 * nh + 8 * cc));
        *(LAS v4u*)(T2 + n * 144 + 16 * c) = (v4u){(unsigned)lo.x, (unsigned)lo.y, (unsigned)hi.x, (unsigned)hi.y}; }
    LDS_WAIT(); asm volatile("" ::: "memory");
#pragma unroll
    for (int j = 0; j < 4; ++j) { const int n2 = (lane >> 3) + 8 * j, c2 = lane & 7;
        *(GAS v4u*)(d.WT + (size_t)(d.drow0 + n2) * d.ldk + d.k0 + 16 * c2) = *(const LAS v4u*)(T2 + n2 * 144 + 16 * c2); }
    LDS_WAIT(); asm volatile("" ::: "memory");
}
__device__ __forceinline__ ConvDesc conv_desc_fp8(const float* W, int K, int N, unsigned char* WT, int mode, int rowbase, int item, float scale) {
    const int nblk = N / 32, kb = item / nblk, nb = item % nblk, k0 = 128 * kb, n0 = 32 * nb;
    int drow0 = rowbase + n0;
    if (mode) drow0 = rowbase + (n0 >> 5) * 64 + (mode - 1) * 32;
    return ConvDesc{W, WT, N, K, k0, n0, drow0, scale};
}
__device__ __forceinline__ void conv_item(const float* W, int K, int N, bf16* WT, int mode, int rowbase, int item, LAS float* scr, int lane) {
    const int nblk = N / 32, kb = item / nblk, nb = item % nblk, k0 = 64 * kb, n0 = 32 * nb;
    int drow0 = rowbase + n0;
    if (mode) drow0 = rowbase + (n0 >> 7) * 256 + (mode - 1) * 128 + (n0 & 127);
    transpose_item(W, N, WT, K, k0, n0, drow0, scr, lane);
}

__global__ void __launch_bounds__(NWAVES * 64, 2) mk_fwd(Args args) {
    extern __shared__ __attribute__((aligned(16))) unsigned char lds_raw[];
    Frame F;
    F.lds = (LAS unsigned char*)lds_raw;
    F.MISC = (volatile LAS unsigned*)(F.lds + MISC_OFF);
    F.tid = threadIdx.x; F.lane = F.tid & 63; F.wave = __builtin_amdgcn_readfirstlane(F.tid >> 6);
    F.G = gridDim.x; { const int bx = blockIdx.x; F.vcu = (F.G % 8 == 0) ? (bx % 8) * (F.G / 8) + bx / 8 : bx; }
    F.gw = F.vcu * NWAVES + F.wave; F.NGW = F.G * NWAVES;
    unsigned char* ws = args.ws;
    F.ctl = (gu32*)(ws + WS_CTL);
    const int tid = F.tid, lane = F.lane, wave = F.wave;
    LAS unsigned char* lds = F.lds;

#define X_IN (args.in[0])
#define cvec (args.in[1])
#define ada_w (args.in[2])
#define ada_b (args.in[3])
#define norm1_g (args.in[4])
#define w_in (args.in[5])
#define lb_logits (args.in[6])
#define hg_norm_g (args.in[7])
#define w_branch_a (args.in[8])
#define w_branch_b (args.in[9])
#define w_out (args.in[10])
#define norm2_g (args.in[11])
#define w_router (args.in[12])
#define router_bias (args.in[13])
#define w_exp_gate (args.in[14])
#define w_exp_up (args.in[15])
#define w_exp_down (args.in[16])
#define w_sh_gate (args.in[17])
#define w_sh_up (args.in[18])
#define w_sh_down (args.in[19])
#define final_g (args.in[20])
#define out (args.out)
#define WIN_T ((bf16*)(ws + WS_WIN_T))
#define WA_T ((bf16*)(ws + WS_WA_T))
#define WB_T ((bf16*)(ws + WS_WB_T))
#define WO_T ((bf16*)(ws + WS_WO_T))
#define RS_T ((bf16*)(ws + WS_RS_T))
#define WSD_T ((bf16*)(ws + WS_WSD_T))
#define WD ((bf16*)(ws + WS_WD))
#define WGU ((bf16*)(ws + WS_WGU))
#define PE ((int*)(ws + WS_PE))
#define PR ((int*)(ws + WS_PR))
#define PW ((float*)(ws + WS_PW))
#define SLOT_TOK ((int*)(ws + WS_SLOT_TOK))
#define SLOT_W ((float*)(ws + WS_SLOT_W))
#define TOK_SLOT ((int*)(ws + WS_TOK_SLOT))
#define LSE ((float*)(ws + WS_LSE))
#define QF ((bf16*)(ws + WS_QF))
#define OA ((bf16*)(ws + WS_OA))
#define OG ((bf16*)(ws + WS_OG))
#define MERGED ((bf16*)(ws + WS_MERGED))
#define HMID ((bf16*)(ws + WS_HMID))
#define YSH (((unsigned char*)(ws + WS_YSLOT)) + (size_t)NSLOTP * 1024)
#define AQKV ((bf16*)(ws + WS_AQKV))
#define GAB ((bf16*)(ws + WS_GAB))
#define XN ((bf16*)(ws + WS_XN))
#define YA ((bf16*)(ws + WS_YA))
#define YB ((bf16*)(ws + WS_YB))
#define H2 ((bf16*)(ws + WS_H2))
#define LOGITS ((float*)(ws + WS_LOGITS))
#define YSLOT ((bf16*)(ws + WS_YSLOT))
#define MOD ((float*)(ws + WS_MOD))
#define HISTG ((unsigned*)(ws + WS_HISTG))
#define ATTQ (((unsigned*)(ws + WS_CTL)) + CW_ATTQ)
    for (int u = tid; u < 64; u += NWAVES * 64) ((LAS unsigned*)(lds + MISC_OFF))[u] = 0u;
    __syncthreads();
    XcdBarrier bar = xcd_barrier_post((unsigned*)(F.ctl + CW_BAR), F.MISC + 8);
    const int lo = args.ph_lo, hi = args.ph_hi;
#ifndef PHMASK
#define PHMASK 0x3fff
#endif
#define IN(k) (((PHMASK >> (k)) & 1) && lo <= (k) && (k) < hi)
#define SEAM(k) do { if (IN(k) && IN((k) + 1)) xcd_barrier(bar); } while (0)
#ifndef ALIGN_P2
#define ALIGN_P2 true
#endif
#ifndef ALIGN_P12
#define ALIGN_P12 true
#endif
#ifndef ALIGN_DEFAULT
#define ALIGN_DEFAULT true
#endif
#ifndef REPMASK
#define REPMASK 0
#endif
#ifndef CONV2_ITEMS
#define CONV2_ITEMS 42000
#endif
#ifndef DBG_H1_ST
#define DBG_H1_ST 1
#endif
#ifndef DBG_ATT_NOLOAD
#define DBG_ATT_NOLOAD 0
#endif
#ifndef TKI
#define TKI 8
#endif
#ifndef CONV11_ITEMS
#define CONV11_ITEMS 0
#endif
#ifndef CONV11_MINWG
#define CONV11_MINWG 16
#endif
#ifndef P2_GEMM_WGS
#define P2_GEMM_WGS 178
#endif
#define REPS(k) (((REPMASK >> (k)) & 1) ? 2 : 1)
#define REP_BEGIN(k) _Pragma("unroll") for (int rep = 0; rep < REPS(k); ++rep) {
#define REP_END(k) if (rep + 1 < REPS(k)) xcd_barrier(bar); }

        constexpr int I_IN = 8 * 200, I_A = 4 * 32, I_B = 2 * 32, I_O = 8 * 32, I_SD = 2 * 32, I_E = 8 * 8, I_ED = 2 * 32;
        constexpr int NSMALL = I_IN + I_A + I_B + I_O + I_SD;
        constexpr int NITEMS = NSMALL + 2 * (NEXP + 1) * I_E + NEXP * I_ED;
    constexpr int NCONV2 = CONV2_ITEMS;
    const int NGB = (F.G == 256 && NCONV2 > 0) ? P2_GEMM_WGS : F.G;
    constexpr int NCONV11 = CONV11_ITEMS;
    static_assert(NITEMS - NCONV2 - NCONV11 >= I_IN, "the input-projection weights must be converted in P0");
    const int nitems0 = (NGB < F.G) ? NITEMS - NCONV2 - NCONV11 : NITEMS;
    auto conv_desc = [&](int it) __attribute__((always_inline)) -> ConvDesc {
            int r = it;
            if (r < I_IN) return conv_desc_fp8(w_in, 1024, NIN, (unsigned char*)WIN_T, 0, 0, r, (float)(1 << SH_WGU)); r -= I_IN;
            if (r < I_A) { const int kb = r / 32, nb = r % 32; return ConvDesc{w_branch_a, (unsigned char*)WA_T, 1024, 768, 128 * kb, 32 * nb, 32 * nb, (float)(1 << SH_WAB)}; } r -= I_A;
            if (r < I_B) { const int kb = r / 32, nb = r % 32; return ConvDesc{w_branch_b, (unsigned char*)WA_T + 512, 1024, 768, 128 * kb, 32 * nb, 32 * nb, (float)(1 << SH_WAB)}; } r -= I_B;
            if (r < I_O) return conv_desc_fp8(w_out, 1024, 1024, (unsigned char*)WO_T, 0, 0, r, (float)(1 << SH_WGU)); r -= I_O;
            if (r < I_SD) return conv_desc_fp8(w_sh_down, 256, 1024, (unsigned char*)WD, 0, NEXP * 1024, r, (float)(1 << SH_WD)); r -= I_SD;
            if (r < 2 * (NEXP + 1) * I_E) { const int seg = r / ((NEXP + 1) * I_E), rr = r % ((NEXP + 1) * I_E), e = rr / I_E, ii = rr % I_E;
                const float* src = (seg == 0) ? (e < NEXP ? w_exp_gate + (size_t)e * 1024 * 256 : w_sh_gate) : (e < NEXP ? w_exp_up + (size_t)e * 1024 * 256 : w_sh_up);
                return conv_desc_fp8(src, 1024, 256, (unsigned char*)WGU, seg + 1, e * 512, ii, (float)(1 << SH_WGU)); }
            r -= 2 * (NEXP + 1) * I_E; const int e = r / I_ED, ii = r % I_ED;
            return conv_desc_fp8(w_exp_down + (size_t)e * 256 * 1024, 256, 1024, (unsigned char*)WD, 0, e * 1024, ii, (float)(1 << SH_WD));
    };
    auto conv_run = [&](int first, int end, int stride, LAS float* scr) __attribute__((always_inline)) {
        int it = first; if (it >= end) return;
        ConvDesc d = conv_desc(it); f32x4 r[16]; ti_load(d, lane, r);
        for (;;) {
            const int nx = it + stride; const bool more = nx < end;
            ConvDesc dn = d; f32x4 rn[16];
            if (more) { dn = conv_desc(nx); ti_load(dn, lane, rn); }
            ti_store(d, r, scr, lane);
            if (!more) break;
            d = dn; it = nx;
#pragma unroll
            for (int i = 0; i < 16; ++i) r[i] = rn[i];
        }
    };

    if (IN(0)) { REP_BEGIN(0)
        {
            LAS float* sc = (LAS float*)lds; LAS float* red = (LAS float*)(lds + 32768);
            for (int i = tid; i < NB * D; i += NWAVES * 64) sc[i] = fsilu(cvec[i]);
            __syncthreads();
            _Pragma("unroll") for (int sr = 0; sr < (((REPMASK >> 19) & 1) ? 2 : 1); ++sr)
            for (int cbk = blockIdx.x; cbk < 256; cbk += F.G) {
                const int j0 = cbk * 24, kg = tid >> 3, cc = tid & 7;
                float a8[8][3];
#pragma unroll
                for (int b = 0; b < 8; ++b) { a8[b][0] = 0.f; a8[b][1] = 0.f; a8[b][2] = 0.f; }
                for (int r = 0; r < 16; ++r) { const int i = kg * 16 + r; const float* wp = ada_w + (size_t)i * 6144 + j0 + 3 * cc; const float w0 = wp[0], w1 = wp[1], w2 = wp[2];
#pragma unroll
                    for (int b = 0; b < 8; ++b) { const float sv = sc[b * 1024 + i]; a8[b][0] += sv * w0; a8[b][1] += sv * w1; a8[b][2] += sv * w2; } }
#pragma unroll
                for (int b = 0; b < 8; ++b) { red[(kg * 8 + b) * 24 + 3 * cc + 0] = a8[b][0]; red[(kg * 8 + b) * 24 + 3 * cc + 1] = a8[b][1]; red[(kg * 8 + b) * 24 + 3 * cc + 2] = a8[b][2]; }
                __syncthreads();
                if (tid < 192) { const int b = tid / 24, col = tid % 24; float sum = ada_b[j0 + col];
                    for (int g = 0; g < 64; ++g) sum += red[(g * 8 + b) * 24 + col];
                    MOD[b * 6144 + j0 + col] = sum; }
                __syncthreads();
            }
        }
        LAS float* scr = (LAS float*)(lds + wave * 16384);
        conv_run(F.gw, nitems0, F.NGW, scr);
    REP_END(0) }
    SEAM(0);

    if (IN(1)) { REP_BEGIN(1)
        for (int m0 = F.gw * 16; m0 < T; m0 += F.NGW * 16) {
            const int b = m0 >> 12;
            f32x4 mul[4], add[4];
#pragma unroll
            for (int j = 0; j < 4; ++j) { const int c = 4 * lane + 256 * j;
                const f32x4 s1 = *(const f32x4*)(MOD + b * 6144 + 1024 + c);
                mul[j] = *(const f32x4*)(norm1_g + c) * (s1 + 1.0f);
                add[j] = *(const f32x4*)(MOD + b * 6144 + c); }
            for (int m = m0; m < m0 + 16; ++m) {
                const GAS f32x4* xr = (const GAS f32x4*)(X_IN + (size_t)m * D) + lane;
                f32x4 v[4]; float s = 0.f;
#pragma unroll
                for (int j = 0; j < 4; ++j) { v[j] = xr[64 * j]; s += (v[j].x * v[j].x + v[j].y * v[j].y) + (v[j].z * v[j].z + v[j].w * v[j].w); }
                const float rstd = 1.0f / sqrtf(wave_sum(s) * (1.f / D) + RMS_EPS);
                GAS unsigned* o4 = (GAS unsigned*)((unsigned char*)XN + (size_t)m * D) + lane;
#pragma unroll
                for (int j = 0; j < 4; ++j) { const f32x4 y = v[j] * rstd * mul[j] + add[j]; const float sx = (float)(1 << SH_X); o4[64 * j] = cvt4_fp8(y.x * sx, y.y * sx, y.z * sx, y.w * sx); }
            }
        }
        for (int it = blockIdx.x; it < 256; it += F.G) {
            const int b = it >> 5, e = tid & 255, dh = tid >> 8, d0 = 32 * (it & 31) + 16 * dh;
            float wv[16];
#pragma unroll
            for (int j = 0; j < 16; ++j) wv[j] = w_router[(size_t)(d0 + j) * 256 + e];
            float part = 0.f; unsigned pk[8];
#pragma unroll
            for (int j = 0; j < 16; j += 2) {
                const float a0 = norm2_g[d0 + j] * (1.0f + MOD[b * 6144 + 4096 + d0 + j]), a1 = norm2_g[d0 + j + 1] * (1.0f + MOD[b * 6144 + 4096 + d0 + j + 1]);
                part += MOD[b * 6144 + 3072 + d0 + j] * wv[j]; part += MOD[b * 6144 + 3072 + d0 + j + 1] * wv[j + 1];
                pk[j >> 1] = cvt_pk_bf16(wv[j] * a0, wv[j + 1] * a1); }
            GAS v4u* wp = (GAS v4u*)((bf16*)(ws + WS_WRB) + ((size_t)(b * 256 + e) * 1024 + d0));
            v4u o0, o1; o0.x = pk[0]; o0.y = pk[1]; o0.z = pk[2]; o0.w = pk[3]; o1.x = pk[4]; o1.y = pk[5]; o1.z = pk[6]; o1.w = pk[7]; wp[0] = o0; wp[1] = o1;
            ((float*)(ws + WS_PART))[(size_t)(b * 64 + (it & 31) * 2 + dh) * 256 + e] = part;
        }
    REP_END(1) }
    SEAM(1);

    if (IN(2)) { REP_BEGIN(2)
        if ((int)blockIdx.x < NGB) {
            pg8::DenseSched S; S.init(T, NIN, 1024, NGB, (int)blockIdx.x, WIN_T);
            pg8::EpiWin E{(unsigned char*)QF, (unsigned char*)AQKV, (unsigned char*)GAB, (unsigned char*)GAB + (size_t)T * 2048, 0};
            pg8::gemm_phase<ALIGN_P2, true, pg8::EpiWin, pg8::DenseSched, 2>(lds, (const char*)XN, 1024, S, E, SC_WGU, SC_X);
        } else {
            LAS float* scr2 = (LAS float*)(lds + wave * 16384);
            conv_run(nitems0 + ((int)blockIdx.x - NGB) * NWAVES + wave, NITEMS - NCONV11, (F.G - NGB) * NWAVES, scr2);
        }
    REP_END(2) }
    SEAM(2);

    if (IN(3)) { REP_BEGIN(3)
        const int fr = lane & 15, fq = lane >> 4;
        bf16* QTB = (bf16*)(ws + WS_QTB); unsigned char* UT = (unsigned char*)(ws + WS_UT); float* DKB = (float*)(ws + WS_DK);
        {
            constexpr int NH1 = NB * 4 * 64, NATT = NB * 3 * 4 * 32;
            {
                const int kq = tid & 31, rg = tid >> 5, vrow = tid >> 3, v16 = (tid & 7) * 16;
                unsigned rq[4], rf[4]; v4u rv0;
                const unsigned char* QF8 = (const unsigned char*)QF;
#define H1_LOAD(w) do { const int b_ = (w) >> 8, h_ = ((w) >> 6) & 3, c_ = (w) & 63; const size_t r0_ = (size_t)(b_ * SEQ + c_ * 64); \
                _Pragma("unroll") for (int rr = 0; rr < 4; ++rr) { const size_t ro = (r0_ + rg * 4 + rr) * 1536 + h_ * 128 + 4 * kq; rq[rr] = *(const unsigned*)(QF8 + ro); rf[rr] = *(const unsigned*)(QF8 + ro + 512); } \
                rv0 = *(const v4u*)(QF8 + (r0_ + vrow) * 1536 + 1024 + h_ * 128 + v16); } while (0)
                if ((int)blockIdx.x < NH1) { H1_LOAD((int)blockIdx.x); }
                _Pragma("unroll") for (int sr = 0; sr < (((REPMASK >> 16) & 1) ? 2 : 1); ++sr) { if (sr) { H1_LOAD((int)blockIdx.x); }
                int hprev = -1; float lbv[4] = {0.f, 0.f, 0.f, 0.f};
                for (int wi = blockIdx.x, j1 = 0; wi < NH1; wi += F.G, ++j1) {
                    const int b = wi >> 8, h = (wi >> 6) & 3, c = wi & 63;
                    constexpr int QT_S = 272, KH_S = 144, VR_S = 288;
                    LAS unsigned char* Qt = lds;
                    LAS unsigned char* Kt = lds + 17408;
                    LAS unsigned char* Kh = lds + 34816;
                    LAS unsigned char* Vr = lds + 53248;
                    LAS unsigned char* Asc = lds + 71680;
                    LAS float* btot = (LAS float*)(lds + 80896);
                    if (h != hprev) { hprev = h;
                        const f32x4 l0 = *(const f32x4*)(lb_logits + h * 128 + 4 * kq), l1 = *(const f32x4*)(lb_logits + 512 + h * 128 + 4 * kq);
#pragma unroll
                        for (int ch = 0; ch < 4; ++ch) lbv[ch] = 1.0f / (1.0f + __expf(l1[ch] - l0[ch])); }
                    const size_t row0 = (size_t)(b * SEQ + c * 64);
                    const float rq_ = 1.0f / (float)(1 << SH_Q);
                    LBAR();
                    for (int i = tid; i < 9216 / 4; i += NWAVES * 64) ((LAS unsigned*)Asc)[i] = 0u;
                    float kk[4][4], bl[4][4]; float run[4] = {0.f, 0.f, 0.f, 0.f};
#pragma unroll
                    for (int rr = 0; rr < 4; ++rr) { const f32x2_t lo = __builtin_amdgcn_cvt_pk_f32_fp8((int)rf[rr], false), hi = __builtin_amdgcn_cvt_pk_f32_fp8((int)rf[rr], true); const float fv[4] = {lo[0], lo[1], hi[0], hi[1]};
#pragma unroll
                        for (int ch = 0; ch < 4; ++ch) { const float sg = fsigmoid(fv[ch] * rq_); const float f = lbv[ch] + (1.0f - lbv[ch]) * sg; run[ch] += __logf(f); bl[rr][ch] = run[ch]; kk[rr][ch] = (1.0f - lbv[ch]) * (1.0f - sg); } }
                    *(LAS f32x4*)(btot + rg * 128 + 4 * kq) = (f32x4){run[0], run[1], run[2], run[3]};
                    {   const unsigned vw[4] = {rv0.x, rv0.y, rv0.z, rv0.w}; unsigned w8[8];
#pragma unroll
                        for (int j = 0; j < 4; ++j) { const f32x2_t lo = __builtin_amdgcn_cvt_pk_f32_fp8((int)vw[j], false), hi = __builtin_amdgcn_cvt_pk_f32_fp8((int)vw[j], true); w8[2 * j] = cvt_pk_bf16(lo[0] * rq_, lo[1] * rq_); w8[2 * j + 1] = cvt_pk_bf16(hi[0] * rq_, hi[1] * rq_); }
                        *(LAS v4u*)(Vr + vrow * VR_S + v16 * 2) = (v4u){w8[0], w8[1], w8[2], w8[3]}; *(LAS v4u*)(Vr + vrow * VR_S + v16 * 2 + 16) = (v4u){w8[4], w8[5], w8[6], w8[7]}; }
                    LBAR();
                    float pre[4] = {0.f, 0.f, 0.f, 0.f}, bend[4] = {0.f, 0.f, 0.f, 0.f};
#pragma unroll
                    for (int g = 0; g < 16; ++g) { const f32x4 tg = *(const LAS f32x4*)(btot + g * 128 + 4 * kq);
#pragma unroll
                        for (int ch = 0; ch < 4; ++ch) { if (g < rg) pre[ch] += tg[ch]; bend[ch] += tg[ch]; } }
#pragma unroll
                    for (int rr = 0; rr < 4; ++rr) { const f32x2_t lo = __builtin_amdgcn_cvt_pk_f32_fp8((int)rq[rr], false), hi = __builtin_amdgcn_cvt_pk_f32_fp8((int)rq[rr], true); const float qf4[4] = {lo[0], lo[1], hi[0], hi[1]};
                        float qv[4], kv[4], kh[4];
#pragma unroll
                        for (int ch = 0; ch < 4; ++ch) { const float bb = pre[ch] + bl[rr][ch]; qv[ch] = qf4[ch] * rq_ * __expf(bb); kv[ch] = kk[rr][ch] * __expf(fminf(-bb, 80.f)); kh[ch] = kk[rr][ch] * __expf(bend[ch] - bb); }
                        *(LAS v2u*)(Qt + (rg * 4 + rr) * QT_S + kq * 8) = (v2u){cvt_pk_bf16(qv[0], qv[1]), cvt_pk_bf16(qv[2], qv[3])};
                        *(LAS v2u*)(Kt + (rg * 4 + rr) * QT_S + kq * 8) = (v2u){cvt_pk_bf16(kv[0], kv[1]), cvt_pk_bf16(kv[2], kv[3])};
                        *(LAS v2u*)(Kh + (rg * 4 + rr) * VR_S + kq * 8) = (v2u){cvt_pk_bf16(kh[0], kh[1]), cvt_pk_bf16(kh[2], kh[3])}; }
                    if (rg == 0) *(f32x4*)(DKB + (size_t)wi * 128 + 4 * kq) = (f32x4){__expf(bend[0]), __expf(bend[1]), __expf(bend[2]), __expf(bend[3])};
                    { const int wn = wi + (int)F.G; if (wn < NH1) { H1_LOAD(wn); } }
                    LBAR();
                    for (int idx = wave; idx < 10; idx += 8) {
                        const int ti = idx < 1 ? 0 : idx < 3 ? 1 : idx < 6 ? 2 : 3; const int si = idx - (ti * (ti + 1)) / 2;
                        f32x4 a4 = (f32x4){0.f, 0.f, 0.f, 0.f};
#pragma unroll
                        for (int ks = 0; ks < 4; ++ks) { const bf16x8 af = *(const LAS bf16x8*)(Qt + (16 * ti + fr) * QT_S + (32 * ks + 8 * fq) * 2); const bf16x8 bfr = *(const LAS bf16x8*)(Kt + (16 * si + fr) * QT_S + (32 * ks + 8 * fq) * 2);
                            a4 = __builtin_amdgcn_mfma_f32_16x16x32_bf16(af, bfr, a4, 0, 0, 0); }
#pragma unroll
                        for (int i = 0; i < 4; ++i) { const int tt = 16 * ti + 4 * fq + i, ss = 16 * si + fr; const float v = (ss <= tt) ? a4[i] : 0.f;
                            *(LAS unsigned short*)(Asc + tt * KH_S + ss * 2) = (unsigned short)(cvt_pk_bf16(v, 0.f) & 0xffff); }
                    }
#pragma unroll
                    for (int j = 0; j < 2; ++j) { const int p = tid + 512 * j, prow = p >> 4, c16 = p & 15; if (DBG_H1_ST || sr) *(v4u*)(QTB + (row0 + prow) * 512 + h * 128 + c16 * 8) = *(const LAS v4u*)(Qt + prow * QT_S + c16 * 16); }
                    bf16x8 vf[2];
#pragma unroll
                    for (int ks = 0; ks < 2; ++ks) {
                        const v2u a0 = __builtin_bit_cast(v2u, __builtin_amdgcn_ds_read_tr16_b64_v4i16((LAS v4i16_t*)(Vr + (32 * ks + 8 * fq + (fr >> 2)) * VR_S + (16 * wave + 4 * (fr & 3)) * 2)));
                        const v2u a1 = __builtin_bit_cast(v2u, __builtin_amdgcn_ds_read_tr16_b64_v4i16((LAS v4i16_t*)(Vr + (32 * ks + 8 * fq + 4 + (fr >> 2)) * VR_S + (16 * wave + 4 * (fr & 3)) * 2)));
                        vf[ks] = __builtin_bit_cast(bf16x8, (v4u){a0.x, a0.y, a1.x, a1.y}); }
                    {   unsigned uw[8];
#pragma unroll
                        for (int kt = 0; kt < 8; ++kt) { f32x4 u4 = (f32x4){0.f, 0.f, 0.f, 0.f};
#pragma unroll
                            for (int ks = 0; ks < 2; ++ks) {
                                const v2u a0 = __builtin_bit_cast(v2u, __builtin_amdgcn_ds_read_tr16_b64_v4i16((LAS v4i16_t*)(Kh + (32 * ks + 8 * fq + (fr >> 2)) * VR_S + (32 * (fr & 3) + 4 * kt) * 2)));
                                const v2u a1 = __builtin_bit_cast(v2u, __builtin_amdgcn_ds_read_tr16_b64_v4i16((LAS v4i16_t*)(Kh + (32 * ks + 8 * fq + 4 + (fr >> 2)) * VR_S + (32 * (fr & 3) + 4 * kt) * 2)));
                                u4 = __builtin_amdgcn_mfma_f32_16x16x32_bf16(__builtin_bit_cast(bf16x8, (v4u){a0.x, a0.y, a1.x, a1.y}), vf[ks], u4, 0, 0, 0); }
                            const float su = (float)(1 << SH_U); uw[kt] = cvt4_fp8(u4[0] * su, u4[1] * su, u4[2] * su, u4[3] * su); }
                        unsigned char* up = UT + ((size_t)wi * 128 + 16 * wave + fr) * 128 + 32 * fq;
                        if (DBG_H1_ST || sr) { *(v4u*)up = (v4u){uw[0], uw[1], uw[2], uw[3]}; *(v4u*)(up + 16) = (v4u){uw[4], uw[5], uw[6], uw[7]}; } }
                    LBAR();
                    {   const int tt = wave & 3, vh = wave >> 2; bf16x8 af[2]; unsigned ow[8];
#pragma unroll
                        for (int ks = 0; ks < 2; ++ks) af[ks] = *(const LAS bf16x8*)(Asc + (16 * tt + fr) * KH_S + (32 * ks + 8 * fq) * 2);
#pragma unroll
                        for (int vt = 0; vt < 4; ++vt) { f32x4 o4 = (f32x4){0.f, 0.f, 0.f, 0.f};
#pragma unroll
                            for (int ks = 0; ks < 2; ++ks) {
                                const v2u a0 = __builtin_bit_cast(v2u, __builtin_amdgcn_ds_read_tr16_b64_v4i16((LAS v4i16_t*)(Vr + (32 * ks + 8 * fq + (fr >> 2)) * VR_S + (64 * vh + 16 * (fr & 3) + 4 * vt) * 2)));
                                const v2u a1 = __builtin_bit_cast(v2u, __builtin_amdgcn_ds_read_tr16_b64_v4i16((LAS v4i16_t*)(Vr + (32 * ks + 8 * fq + 4 + (fr >> 2)) * VR_S + (64 * vh + 16 * (fr & 3) + 4 * vt) * 2)));
                                o4 = __builtin_amdgcn_mfma_f32_16x16x32_bf16(__builtin_bit_cast(bf16x8, (v4u){a0.x, a0.y, a1.x, a1.y}), af[ks], o4, 0, 0, 0); }
                            ow[2 * vt] = cvt_pk_bf16(o4[0], o4[1]); ow[2 * vt + 1] = cvt_pk_bf16(o4[2], o4[3]); }
                        bf16* op = OA + (row0 + 16 * tt + fr) * 512 + h * 128 + 64 * vh + 16 * fq;
                        if (DBG_H1_ST || sr) { *(v4u*)op = (v4u){ow[0], ow[1], ow[2], ow[3]}; *(v4u*)(op + 8) = (v4u){ow[4], ow[5], ow[6], ow[7]}; } }
                } }
#undef H1_LOAD
            }
            {
                constexpr int K_S = 144, VT_S = 528;
                LAS unsigned char* Kl = lds;
                LAS unsigned char* Vt = lds + 36864;
                v4u kx[2], vx[2]; v2u qn[2];
#define ATT_DECODE(un) const int rn = (un) & 31, hh = ((un) >> 5) & 3, g = ((un) >> 7) % 3, b = (un) / 384; \
                const int dl = g == 0 ? 0 : g == 1 ? 2 : 4, d = 1 << dl, nbk = 32 >> dl, r = rn / nbk, n = rn % nbk; \
                const unsigned char* base = (const unsigned char*)AQKV + (size_t)(b * SEQ) * 2304 + (g * 4 + hh) * 64; const int qi = 16 * wave + fr; const int tq = (n * 128 + qi) * d + r;
#define ATT_LOAD(un) do { ATT_DECODE(un)       \
                _Pragma("unroll") for (int j = 0; j < 2; ++j) { const int p = tid + 512 * j, key = p >> 2, c16 = p & 3; const int l = (n - 1) * 128 + key; \
                    kx[j] = (v4u){0u, 0u, 0u, 0u}; vx[j] = kx[j]; \
                    if (l >= 0) { const unsigned char* rowp = base + (size_t)(l * d + r) * 2304 + c16 * 16; kx[j] = *(const v4u*)(rowp + 768); vx[j] = *(const v4u*)(rowp + 1536); } } \
                _Pragma("unroll") for (int ks = 0; ks < 2; ++ks) qn[ks] = *(const v2u*)(base + (size_t)tq * 2304 + 32 * ks + 8 * fq); } while (0)
                if (F.vcu < NATT) { ATT_LOAD(F.vcu); }
                _Pragma("unroll") for (int sr = 0; sr < (((REPMASK >> 17) & 1) ? 2 : 1); ++sr) { if (sr) { ATT_LOAD(F.vcu); }
                for (int un = F.vcu; un < NATT; un += F.G) {
                    ATT_DECODE(un)
                    LBAR();
#pragma unroll
                    for (int j = 0; j < 2; ++j) { const int p = tid + 512 * j, key = p >> 2, c16 = p & 3;
                        *(LAS v4u*)(Kl + key * K_S + c16 * 32) = f8x8_to_bf16(kx[j].x, kx[j].y); *(LAS v4u*)(Kl + key * K_S + c16 * 32 + 16) = f8x8_to_bf16(kx[j].z, kx[j].w);
                        *(LAS v4u*)(Vt + key * K_S + c16 * 32) = f8x8_to_bf16(vx[j].x, vx[j].y); *(LAS v4u*)(Vt + key * K_S + c16 * 32 + 16) = f8x8_to_bf16(vx[j].z, vx[j].w); }
                    bf16x8 qf[2]; qf[0] = __builtin_bit_cast(bf16x8, f8x8_to_bf16(qn[0].x, qn[0].y)); qf[1] = __builtin_bit_cast(bf16x8, f8x8_to_bf16(qn[1].x, qn[1].y));
                    if (un + (int)F.G < NATT && !(DBG_ATT_NOLOAD && sr)) { ATT_LOAD(un + (int)F.G); }
                    LBAR();
                    float p[10][4]; float mx = -INFINITY;
#pragma unroll
                    for (int jt = 0; jt < 10; ++jt) { const int kt = (wave + jt) < 15 ? (wave + jt) : 15; f32x4 s4 = (f32x4){0.f, 0.f, 0.f, 0.f};
#pragma unroll
                        for (int ks = 0; ks < 2; ++ks) { const bf16x8 af = *(const LAS bf16x8*)(Kl + (16 * kt + fr) * K_S + (32 * ks + 8 * fq) * 2); s4 = __builtin_amdgcn_mfma_f32_16x16x32_bf16(af, qf[ks], s4, 0, 0, 0); }
#pragma unroll
                        for (int i = 0; i < 4; ++i) { const int kj = 16 * (wave + jt) + 4 * fq + i; const bool ok = (kj >= qi) && (kj <= qi + 128) && (n > 0 || kj >= 128);
                            const float sv = ok ? s4[i] * (0.125f / (float)(1 << (2 * SH_Q))) : -INFINITY; p[jt][i] = sv; mx = fmaxf(mx, sv); } }
                    mx = fmaxf(mx, __shfl_xor(mx, 16)); mx = fmaxf(mx, __shfl_xor(mx, 32));
                    float ls = 0.f;
#pragma unroll
                    for (int jt = 0; jt < 10; ++jt)
#pragma unroll
                        for (int i = 0; i < 4; ++i) { const float e = __expf(p[jt][i] - mx); p[jt][i] = e; ls += e; }
                    ls += __shfl_xor(ls, 16); ls += __shfl_xor(ls, 32);
                    f32x4 o4[4];
#pragma unroll
                    for (int dt = 0; dt < 4; ++dt) o4[dt] = (f32x4){0.f, 0.f, 0.f, 0.f};
#pragma unroll
                    for (int pp = 0; pp < 5; ++pp) { const int k0 = (wave + 2 * pp) < 15 ? (wave + 2 * pp) : 15, k1 = (wave + 2 * pp + 1) < 15 ? (wave + 2 * pp + 1) : 15;
                        v4u pb; pb.x = cvt_pk_bf16(p[2 * pp][0], p[2 * pp][1]); pb.y = cvt_pk_bf16(p[2 * pp][2], p[2 * pp][3]); pb.z = cvt_pk_bf16(p[2 * pp + 1][0], p[2 * pp + 1][1]); pb.w = cvt_pk_bf16(p[2 * pp + 1][2], p[2 * pp + 1][3]);
                        const bf16x8 pf = __builtin_bit_cast(bf16x8, pb);
#pragma unroll
                        for (int dt = 0; dt < 4; ++dt) {
                            const v2u a0 = __builtin_bit_cast(v2u, __builtin_amdgcn_ds_read_tr16_b64_v4i16((LAS v4i16_t*)(Vt + (16 * k0 + 4 * fq + (fr >> 2)) * K_S + (16 * (fr & 3) + 4 * dt) * 2)));
                            const v2u a1 = __builtin_bit_cast(v2u, __builtin_amdgcn_ds_read_tr16_b64_v4i16((LAS v4i16_t*)(Vt + (16 * k1 + 4 * fq + (fr >> 2)) * K_S + (16 * (fr & 3) + 4 * dt) * 2)));
                            const v4u av = (v4u){a0.x, a0.y, a1.x, a1.y};
                            o4[dt] = __builtin_amdgcn_mfma_f32_16x16x32_bf16(__builtin_bit_cast(bf16x8, av), pf, o4[dt], 0, 0, 0); } }
                    const float inv = 1.0f / (ls * (float)(1 << SH_Q)); const size_t trow = (size_t)(b * SEQ + tq);
                    bf16* og = OG + ((size_t)g * T + trow) * 256 + hh * 64 + 16 * fq;
                    { unsigned ow[8];
#pragma unroll
                      for (int dt = 0; dt < 4; ++dt) { ow[2 * dt] = cvt_pk_bf16(o4[dt][0] * inv, o4[dt][1] * inv); ow[2 * dt + 1] = cvt_pk_bf16(o4[dt][2] * inv, o4[dt][3] * inv); }
                      *(v4u*)og = (v4u){ow[0], ow[1], ow[2], ow[3]}; *(v4u*)(og + 8) = (v4u){ow[4], ow[5], ow[6], ow[7]}; }
                    if (fq == 0) LSE[((size_t)(g * 4 + hh) * NB + b) * SEQ + r * (SEQ >> dl) + n * 128 + qi] = mx + __logf(ls);
                } }
#undef ATT_LOAD
#undef ATT_DECODE
            }
        }
        xcd_barrier(bar);
        for (int vb = blockIdx.x; vb < 256; vb += F.G) {
            const int bh = vb >> 3, eg = (vb & 7) * 512 + tid, v = eg >> 5, kq = eg & 31;
            LAS float* Dl = (LAS float*)lds;
            __syncthreads();
            for (int i = tid; i < 64 * 128; i += NWAVES * 64) Dl[i] = DKB[(size_t)bh * 64 * 128 + i];
            unsigned char* up = UT + ((size_t)bh * 64 * 128 + v) * 128 + kq * 4;
            __syncthreads();
            float S0 = 0.f, S1 = 0.f, S2 = 0.f, S3 = 0.f; const float su = (float)(1 << SH_U), ru = 1.0f / su;
            for (int c0 = 0; c0 < 64; c0 += 32) {
                unsigned u[32];
                { const unsigned char* lp = up + (size_t)c0 * 128 * 128;
#pragma unroll
                  for (int c = 0; c < 32; ++c) { u[c] = *(const unsigned*)lp; lp += 128 * 128; asm volatile("" : "+v"(lp)); } }
                unsigned char* sp = up + (size_t)c0 * 128 * 128;
#pragma unroll
                for (int c = 0; c < 32; ++c) { const f32x4 d = *(const LAS f32x4*)(Dl + (c0 + c) * 128 + kq * 4);
                    *(unsigned*)sp = cvt4_fp8(S0 * su, S1 * su, S2 * su, S3 * su); sp += 128 * 128; asm volatile("" : "+v"(sp));
                    const f32x2_t ua = __builtin_amdgcn_cvt_pk_f32_fp8((int)u[c], false), ub = __builtin_amdgcn_cvt_pk_f32_fp8((int)u[c], true);
                    S0 = d[0] * S0 + ua[0] * ru; S1 = d[1] * S1 + ua[1] * ru; S2 = d[2] * S2 + ub[0] * ru; S3 = d[3] * S3 + ub[1] * ru; }
            }
        }
        for (int m0 = F.gw * 16; m0 < T; m0 += F.NGW * 16)
            for (int m = m0; m < m0 + 16; ++m) {
                const int hh = lane >> 4;
                const int bb = m >> 12, tt = m & 4095;
                const float l0 = LSE[((size_t)(0 + hh) * NB + bb) * SEQ + tt], l1 = LSE[((size_t)(4 + hh) * NB + bb) * SEQ + (tt & 3) * 1024 + (tt >> 2)], l2 = LSE[((size_t)(8 + hh) * NB + bb) * SEQ + (tt & 15) * 256 + (tt >> 4)];
                const float mxl = fmaxf(l0, fmaxf(l1, l2)); const float e0 = __expf(l0 - mxl), e1 = __expf(l1 - mxl), e2 = __expf(l2 - mxl); const float inv = 1.0f / (e0 + e1 + e2);
                const v2u a0 = *(const v2u*)(OG + ((size_t)0 * T + m) * 256 + 4 * lane), a1 = *(const v2u*)(OG + ((size_t)1 * T + m) * 256 + 4 * lane), a2 = *(const v2u*)(OG + ((size_t)2 * T + m) * 256 + 4 * lane);
                const float w0 = e0 * inv, w1 = e1 * inv, w2 = e2 * inv;
                const float sy = (float)(1 << SH_YAB);
                *(unsigned*)((unsigned char*)YA + (size_t)m * 768 + 512 + 4 * lane) = cvt4_fp8(sy * (w0 * bflo(a0.x) + w1 * bflo(a1.x) + w2 * bflo(a2.x)), sy * (w0 * bfhi(a0.x) + w1 * bfhi(a1.x) + w2 * bfhi(a2.x)),
                                                                                                     sy * (w0 * bflo(a0.y) + w1 * bflo(a1.y) + w2 * bflo(a2.y)), sy * (w0 * bfhi(a0.y) + w1 * bfhi(a1.y) + w2 * bfhi(a2.y)));
            }
        xcd_barrier(bar);
        {
            LAS float* Ot = (LAS float*)lds;
            const int t = tid >> 3, seg = (tid & 7) * 16;
            v2u sfN[4]; bf16x8 afN[4][4]; v4u oiN0, oiN1, hzN;
#define P3C_LOAD(un_) do { const int b_ = (un_) >> 8, h_ = ((un_) >> 6) & 3, c_ = (un_) & 63; const size_t r0_ = (size_t)(b_ * SEQ + c_ * 64); \
                _Pragma("unroll") for (int ks = 0; ks < 4; ++ks) sfN[ks] = *(const v2u*)(UT + ((size_t)(un_) * 128 + 16 * wave + fr) * 128 + 32 * ks + 8 * fq); \
                _Pragma("unroll") for (int tt = 0; tt < 4; ++tt) _Pragma("unroll") for (int ks = 0; ks < 4; ++ks) afN[tt][ks] = *(const bf16x8*)(QTB + (r0_ + 16 * tt + fr) * 512 + h_ * 128 + 32 * ks + 8 * fq); \
                oiN0 = *(const v4u*)(OA + (r0_ + t) * 512 + h_ * 128 + seg); oiN1 = *(const v4u*)(OA + (r0_ + t) * 512 + h_ * 128 + seg + 8); \
                hzN = *(const v4u*)((const unsigned char*)GAB + (size_t)T * 2048 + (r0_ + t) * 512 + h_ * 128 + seg); } while (0)
            if (F.vcu < NB * 4 * 64) { P3C_LOAD(F.vcu); }
            int hprev3 = -1; f32x4 ggv[4];
#pragma unroll
            for (int j = 0; j < 4; ++j) ggv[j] = (f32x4){0.f, 0.f, 0.f, 0.f};
            for (int unit = F.vcu; unit < NB * 4 * 64; unit += F.G) {
                const int b = unit >> 8, h = (unit >> 6) & 3, c = unit & 63; const size_t row0 = (size_t)(b * SEQ + c * 64);
                if (h != hprev3) { hprev3 = h;
#pragma unroll
                    for (int j = 0; j < 4; ++j) ggv[j] = *(const f32x4*)(hg_norm_g + h * 128 + seg + 4 * j); }
                bf16x8 sf[4], af[4][4]; f32x4 o4[4];
#pragma unroll
                for (int ks = 0; ks < 4; ++ks) { const f32x2_t s0 = __builtin_amdgcn_cvt_pk_f32_fp8((int)sfN[ks].x, false), s1 = __builtin_amdgcn_cvt_pk_f32_fp8((int)sfN[ks].x, true), s2 = __builtin_amdgcn_cvt_pk_f32_fp8((int)sfN[ks].y, false), s3 = __builtin_amdgcn_cvt_pk_f32_fp8((int)sfN[ks].y, true);
                    const float ru = 1.0f / (float)(1 << SH_U); v4u sw; sw.x = cvt_pk_bf16(s0[0] * ru, s0[1] * ru); sw.y = cvt_pk_bf16(s1[0] * ru, s1[1] * ru); sw.z = cvt_pk_bf16(s2[0] * ru, s2[1] * ru); sw.w = cvt_pk_bf16(s3[0] * ru, s3[1] * ru);
                    sf[ks] = __builtin_bit_cast(bf16x8, sw);
#pragma unroll
                    for (int tt = 0; tt < 4; ++tt) af[tt][ks] = afN[tt][ks]; }
                const v4u oi0 = oiN0, oi1 = oiN1, hz = hzN;
                if (unit + (int)F.G < NB * 4 * 64) { P3C_LOAD(unit + (int)F.G); }
#pragma unroll
                for (int tt = 0; tt < 4; ++tt) { o4[tt] = (f32x4){0.f, 0.f, 0.f, 0.f};
#pragma unroll
                    for (int ks = 0; ks < 4; ++ks) o4[tt] = __builtin_amdgcn_mfma_f32_16x16x32_bf16(af[tt][ks], sf[ks], o4[tt], 0, 0, 0); }
                LBAR();
#pragma unroll
                for (int tt = 0; tt < 4; ++tt)
#pragma unroll
                    for (int i = 0; i < 4; ++i) Ot[(16 * tt + 4 * fq + i) * 132 + 16 * wave + fr] = o4[tt][i];
                LBAR();
                float o[16];
                { const unsigned ow[8] = {oi0.x, oi0.y, oi0.z, oi0.w, oi1.x, oi1.y, oi1.z, oi1.w};
#pragma unroll
                  for (int j = 0; j < 4; ++j) { const f32x4 q4 = *(const LAS f32x4*)(Ot + t * 132 + seg + 4 * j); o[4 * j] = q4[0] + bflo(ow[2 * j]); o[4 * j + 1] = q4[1] + bfhi(ow[2 * j]); o[4 * j + 2] = q4[2] + bflo(ow[2 * j + 1]); o[4 * j + 3] = q4[3] + bfhi(ow[2 * j + 1]); } }
                float ss = 0.f;
#pragma unroll
                for (int j = 0; j < 16; ++j) ss += o[j] * o[j];
                ss += __shfl_xor(ss, 1); ss += __shfl_xor(ss, 2); ss += __shfl_xor(ss, 4);
                const float rstd = 1.0f / sqrtf(ss * (1.f / 128.f) + RMS_EPS);
                const unsigned hw[4] = {hz.x, hz.y, hz.z, hz.w}; const float rs = rstd * (1.0f / (float)(1 << SH_G));
                unsigned yw[4]; const float rsy = rs * (float)(1 << SH_YAB);
#pragma unroll
                for (int j = 0; j < 4; ++j) { const f32x2_t s0 = __builtin_amdgcn_cvt_pk_f32_fp8((int)hw[j], false), s1 = __builtin_amdgcn_cvt_pk_f32_fp8((int)hw[j], true); const f32x4 gg = ggv[j];
                    yw[j] = cvt4_fp8(o[4 * j] * rsy * gg[0] * s0[0], o[4 * j + 1] * rsy * gg[1] * s0[1], o[4 * j + 2] * rsy * gg[2] * s1[0], o[4 * j + 3] * rsy * gg[3] * s1[1]); }
                *(v4u*)((unsigned char*)YA + (row0 + t) * 768 + h * 128 + seg) = (v4u){yw[0], yw[1], yw[2], yw[3]};
            }
#undef P3C_LOAD
        }
    REP_END(3) }

    SEAM(4);

    if (IN(5)) { REP_BEGIN(5)
        { pg8::DenseSched S; S.init(T, 1024, 768, F.G, (int)blockIdx.x, WA_T); pg8::EpiMerge E{(const unsigned char*)GAB, (unsigned char*)MERGED}; pg8::gemm_phase<ALIGN_DEFAULT, true, pg8::EpiMerge, pg8::DenseSched, 2>(lds, (const char*)YA, 768, S, E, SC_WAB, SC_YAB); }
    REP_END(5) }
    SEAM(5);

    if (IN(6)) { REP_BEGIN(6)
        pg8::DenseSched S; S.init(T, 1024, 1024, F.G, (int)blockIdx.x, WO_T); pg8::EpiOut E{X_IN, (bf16*)(ws + WS_X1B), MOD};
        pg8::gemm_phase<ALIGN_DEFAULT, true>(lds, (const char*)MERGED, 1024, S, E, SC_WGU, SC_M);
    REP_END(6) }
    SEAM(6);

    if (IN(7)) { REP_BEGIN(7)
        const int NRB = (F.G >= 256) ? 128 : F.G / 2;
        if ((int)blockIdx.x < NRB) {
            pg8::RouterSched S{T / 256, NRB, (int)blockIdx.x, (const char*)(ws + WS_WRB)}; pg8::EpiRL E{LOGITS};
            pg8::gemm_phase<ALIGN_DEFAULT, false>(lds, (const char*)(ws + WS_X1B), 2048, S, E);
        } else {
            const int rb = (int)blockIdx.x - NRB, nrow = F.G - NRB;
            for (int b = rb; b < NB; b += nrow) if (tid < 256) { float sum = 0.f;
                for (int p0 = 0; p0 < 64; p0 += 16) { float v[16];
#pragma unroll
                    for (int j = 0; j < 16; ++j) v[j] = ((const float*)(ws + WS_PART))[(size_t)(b * 64 + p0 + j) * 256 + tid];
#pragma unroll
                    for (int j = 0; j < 16; ++j) sum += v[j]; }
                ((float*)(ws + WS_CB))[b * 256 + tid] = sum; }
            for (int m0 = (rb * NWAVES + wave) * 16; m0 < T; m0 += nrow * NWAVES * 16) {
                const int b = m0 >> 12;
                f32x4 mul[4], add[4];
#pragma unroll
                for (int j = 0; j < 4; ++j) { const int c = 4 * lane + 256 * j;
                    const f32x4 s2 = *(const f32x4*)(MOD + b * 6144 + 4096 + c);
                    mul[j] = *(const f32x4*)(norm2_g + c) * (s2 + 1.0f);
                    add[j] = *(const f32x4*)(MOD + b * 6144 + 3072 + c); }
                for (int m = m0; m < m0 + 16; ++m) {
                    const GAS v2u* xr = (const GAS v2u*)((const bf16*)(ws + WS_X1B) + (size_t)m * D) + lane;
                    f32x4 v[4]; float s = 0.f;
#pragma unroll
                    for (int j = 0; j < 4; ++j) { const v2u xw = xr[64 * j]; v[j] = (f32x4){bflo(xw.x), bfhi(xw.x), bflo(xw.y), bfhi(xw.y)}; s += (v[j].x * v[j].x + v[j].y * v[j].y) + (v[j].z * v[j].z + v[j].w * v[j].w); }
                    const float rstd = 1.0f / sqrtf(wave_sum(s) * (1.f / D) + RMS_EPS);
                    if (lane == 0) ((float*)(ws + WS_RSTD))[m] = rstd;
                    GAS unsigned* o4 = (GAS unsigned*)((unsigned char*)(ws + WS_H2F8) + (size_t)m * D) + lane;
#pragma unroll
                    for (int j = 0; j < 4; ++j) { const f32x4 y = v[j] * rstd * mul[j] + add[j]; const float sx = (float)(1 << SH_X); o4[64 * j] = cvt4_fp8(y.x * sx, y.y * sx, y.z * sx, y.w * sx); }
                }
            }
        }
    REP_END(7) }
    SEAM(7);

    if (IN(9)) { REP_BEGIN(9)
        LAS unsigned* whist = (LAS unsigned*)lds;
        LAS unsigned* wbase = whist + 2048;
        LAS int* pe_l = (LAS int*)(lds + 16384); LAS int* pr_l = pe_l + 1024; LAS float* pw_l = (LAS float*)(pr_l + 1024);
        for (int cid = F.vcu; cid < T / 128; cid += F.G) {
            const int m0w = cid * 128;
            __syncthreads();
            for (int i = tid; i < 2048; i += NWAVES * 64) whist[i] = 0u;
            __syncthreads();
            float cb4[4], rb4[4];
#pragma unroll
            for (int i = 0; i < 4; ++i) { cb4[i] = ((const float*)(ws + WS_CB))[(cid >> 5) * 256 + lane + 64 * i]; rb4[i] = router_bias[lane + 64 * i]; }
            for (int jg = 0; jg < 16 / TKI; ++jg) {
                float sc[TKI][4]; unsigned key[TKI][4];
#pragma unroll
                for (int tt = 0; tt < TKI; ++tt) { const int t = m0w + wave * 16 + jg * TKI + tt; const float rs = ((const float*)(ws + WS_RSTD))[t];
#pragma unroll
                    for (int i = 0; i < 4; ++i) { sc[tt][i] = fsigmoid(rs * LOGITS[(size_t)t * 256 + lane + 64 * i] + cb4[i]); const float sl = fmaxf(sc[tt][i] + rb4[i], 0.f);
                        key[tt][i] = (__float_as_uint(sl) & 0xFFFFFF00u) | (unsigned)(255 - (lane + 64 * i)); } }
                float myw[TKI], ssum[TKI]; int mye[TKI];
#pragma unroll
                for (int tt = 0; tt < TKI; ++tt) { myw[tt] = 0.f; ssum[tt] = 0.f; mye[tt] = 0; }
                for (int k = 0; k < 8; ++k) {
#pragma unroll
                    for (int tt = 0; tt < TKI; ++tt) {
                        unsigned bk = max(max(key[tt][0], key[tt][1]), max(key[tt][2], key[tt][3]));
                        bk = max(bk, (unsigned)__builtin_amdgcn_update_dpp(0, (int)bk, 0xB1, 0xF, 0xF, false));
                        bk = max(bk, (unsigned)__builtin_amdgcn_update_dpp(0, (int)bk, 0x4E, 0xF, 0xF, false));
                        bk = max(bk, (unsigned)__builtin_amdgcn_update_dpp(0, (int)bk, 0x141, 0xF, 0xF, false));
                        bk = max(bk, (unsigned)__builtin_amdgcn_update_dpp(0, (int)bk, 0x140, 0xF, 0xF, false));
                        bk = max(bk, (unsigned)__builtin_amdgcn_update_dpp(0, (int)bk, 0x142, 0xA, 0xF, false));
                        bk = max(bk, (unsigned)__builtin_amdgcn_update_dpp(0, (int)bk, 0x143, 0xC, 0xF, false));
                        bk = (unsigned)__builtin_amdgcn_readlane((int)bk, 63);
                        const int idx = 255 - (int)(bk & 0xFFu), own = idx & 63, ii = idx >> 6;
                        float sv = ii == 0 ? sc[tt][0] : ii == 1 ? sc[tt][1] : ii == 2 ? sc[tt][2] : sc[tt][3];
                        sv = __int_as_float(__builtin_amdgcn_readlane(__float_as_int(sv), own));
#pragma unroll
                        for (int i = 0; i < 4; ++i) if (lane == own && ii == i) key[tt][i] = 0u;
                        ssum[tt] += sv;
                        if (lane == k) { mye[tt] = idx; myw[tt] = sv; }
                    }
                }
#pragma unroll
                for (int tt = 0; tt < TKI; ++tt) {
                    const float w = myw[tt] / ssum[tt] * 2.5f; const int j = jg * TKI + tt;
                    if (lane < 8) { LAS unsigned* hp = whist + wave * 256 + mye[tt]; const unsigned lr = *hp; *hp = lr + 1u;
                        const int ix = (wave * 16 + j) * 8 + lane; pe_l[ix] = mye[tt]; pr_l[ix] = (int)lr; pw_l[ix] = w; }
                    LDS_WAIT();
                }
            }
            __syncthreads();
            if (tid < 256) { unsigned run = 0u;
#pragma unroll
                for (int w = 0; w < 8; ++w) { wbase[w * 256 + tid] = run; run += whist[w * 256 + tid]; }
                HISTG[cid * 256 + tid] = run; }
            __syncthreads();
            for (int i = tid; i < 1024; i += NWAVES * 64) { const int e = pe_l[i]; const size_t gi = (size_t)m0w * 8 + i; PE[gi] = e; PR[gi] = pr_l[i] + (int)wbase[(i >> 7) * 256 + e]; PW[gi] = pw_l[i]; }
        }
    REP_END(9) }
    SEAM(9);

    if (IN(10) || IN(11) || IN(12)) {
        LAS int* tab = (LAS int*)(lds + TAB_OFF);
        LAS int* est = (LAS int*)lds; LAS int* tst = est + 256; LAS int* cntl = tst + 256; LAS int* ntl = cntl + 256; LAS int* cbl = ntl + 64;
        REP_BEGIN(10)
        for (int cid = F.vcu; cid < T / 128; cid += F.G) {
            __syncthreads();
            {
                const int e = tid & 255, hf = tid >> 8; int tot = 0, cb = 0;
                for (int c0 = hf * 128; c0 < hf * 128 + 128; c0 += 16) { int v[16];
#pragma unroll
                    for (int j = 0; j < 16; ++j) v[j] = (int)HISTG[(c0 + j) * 256 + e];
#pragma unroll
                    for (int j = 0; j < 16; ++j) { tot += v[j]; cb += (c0 + j < cid) ? v[j] : 0; } }
                if (hf) { cntl[e] = tot; cbl[e] = cb; }
                __syncthreads();
                if (!hf) { cntl[e] += tot; cbl[e] += cb; }
            }
            __syncthreads();
            if (wave == 0) {
                int c4[4], loc = 0, locT = 0;
#pragma unroll
                for (int i = 0; i < 4; ++i) { c4[i] = cntl[4 * lane + i]; loc += c4[i]; locT += (c4[i] + 255) >> 8; }
                int inc = loc, incT = locT;
#pragma unroll
                for (int o = 1; o < 64; o <<= 1) { const int a = __shfl_up(inc, o), bt = __shfl_up(incT, o); if (lane >= o) { inc += a; incT += bt; } }
                int ex = inc - loc, exT = incT - locT;
#pragma unroll
                for (int i = 0; i < 4; ++i) { est[4 * lane + i] = exT * 256; tst[4 * lane + i] = exT; ex += c4[i]; exT += (c4[i] + 255) >> 8; }
                if (lane == 63) ntl[0] = incT;
            }
            __syncthreads();
            if (tid < 256) { const int cn = cntl[tid], t0 = tst[tid], e0 = est[tid]; for (int j = 0; j * 256 < cn; ++j) { const int rem = cn - j * 256; tab[(t0 + j) * 4 + 0] = tid; tab[(t0 + j) * 4 + 1] = e0 + j * 256; tab[(t0 + j) * 4 + 2] = rem < 256 ? rem : 256; tab[(t0 + j) * 4 + 3] = 0; } }
            if (tid < T / 256) { const int ti = ntl[0] + tid; tab[ti * 4 + 0] = NEXP; tab[ti * 4 + 1] = NSLOTP + 256 * tid; tab[ti * 4 + 2] = 256; tab[ti * 4 + 3] = 0; }
            if (tid == 0) { F.MISC[16] = (unsigned)ntl[0]; F.MISC[17] = (unsigned)(ntl[0] + T / 256); }
            __syncthreads();
            if (IN(10)) {
                for (int i = cid * 128 + tid; i < cid * 128 + 128; i += NWAVES * 64) SLOT_TOK[NSLOTP + i] = i;
                for (int e = blockIdx.x; e < NEXP; e += F.G) { const int cn = cntl[e], e0 = est[e], pend = e0 + (((cn + 255) >> 8) << 8); for (int i = e0 + cn + tid; i < pend; i += NWAVES * 64) __hip_atomic_store(SLOT_TOK + i, 0, RLX_AGENT); }
                for (int i = tid; i < 1024; i += NWAVES * 64) { const size_t gi = (size_t)cid * 1024 + i; const int e = PE[gi]; const int slot = est[e] + cbl[e] + PR[gi]; __hip_atomic_store(SLOT_TOK + slot, (int)(gi >> 3), RLX_AGENT); TOK_SLOT[gi] = slot; }
            }
        }
        REP_END(10)
        __syncthreads();
    }
    SEAM(10);

    if (IN(11)) { REP_BEGIN(11)
        int Gp = F.G, c11 = F.vcu, cid = -1;
        if (NGB < F.G && NCONV11 > 0) {
            const int units = (int)F.MISC[17] * 2, gmax = F.G - CONV11_MINWG, R = (units + gmax - 1) / gmax; Gp = (units + R - 1) / R;
            const int x = (int)blockIdx.x & 7, j = (int)blockIdx.x >> 3, qb = Gp >> 3, qr = Gp & 7, qx = qb + (x < qr ? 1 : 0), mn = x < qr ? x : qr;
            if (j < qx) c11 = x * qb + mn + j; else cid = x * (32 - qb) - mn + (j - qx);
        }
        Gp = __builtin_amdgcn_readfirstlane(Gp); c11 = __builtin_amdgcn_readfirstlane(c11); cid = __builtin_amdgcn_readfirstlane(cid);
        if (cid < 0) { pg8::RoutedSched<2, true> S{(const LAS int*)(lds + TAB_OFF), (int)F.MISC[17], Gp, c11, 1024u, (const char*)WGU, (size_t)512 * 1024, SLOT_TOK};
          pg8::EpiGU E{(unsigned char*)HMID}; pg8::gemm_phase<ALIGN_DEFAULT, true>(lds, (const char*)(ws + WS_H2F8), 1024, S, E, SC_WGU, SC_X); }
        else conv_run(NITEMS - NCONV11 + cid * NWAVES + wave, NITEMS, (F.G - Gp) * NWAVES, (LAS float*)(lds + wave * 16384));
    REP_END(11) }
    SEAM(11);

    if (IN(12)) { REP_BEGIN(12)
        { pg8::RoutedSched<4, false> S{(const LAS int*)(lds + TAB_OFF), (int)F.MISC[17], F.G, F.vcu, 256u, (const char*)WD, (size_t)1024 * 256, nullptr};
          pg8::EpiRD E{(unsigned char*)YSLOT, SLOT_W}; pg8::gemm_phase<ALIGN_P12, true, pg8::EpiRD, pg8::RoutedSched<4, false>, 2>(lds, (const char*)HMID, 256, S, E, SC_WD, SC_HMID); }

    REP_END(12) }
    SEAM(12);

    if (IN(13)) { REP_BEGIN(13)
        float* dst13 = (rep + 1 < REPS(13)) ? (float*)(ws + WS_QF) : out;
        for (int m0 = F.gw * 16; m0 < T; m0 += F.NGW * 16) {
            const int b = m0 >> 12;
            f32x4 g2[4], fg[4];
#pragma unroll
            for (int j = 0; j < 4; ++j) { const int c = 256 * j + 4 * lane; g2[j] = *(const f32x4*)(MOD + b * 6144 + 5120 + c) * (1.0f / (float)(1 << SH_Y)); fg[j] = *(const f32x4*)(final_g + c); }
            for (int m = m0; m < m0 + 16; ++m) {
                unsigned yr[9][4];
#pragma unroll
                for (int j = 0; j < 4; ++j) yr[0][j] = *(const unsigned*)(YSH + (size_t)m * 1024 + 256 * j + 4 * lane);
#pragma unroll
                for (int k = 0; k < 8; ++k) { const int slot = TOK_SLOT[m * 8 + k]; const unsigned char* sp = (const unsigned char*)YSLOT + (size_t)slot * 1024 + 4 * lane;
#pragma unroll
                    for (int j = 0; j < 4; ++j) yr[k + 1][j] = *(const unsigned*)(sp + 256 * j); }
                f32x4 v[4];
#pragma unroll
                for (int j = 0; j < 4; ++j) { const v2u xw = *(const v2u*)((const bf16*)(ws + WS_X1B) + (size_t)m * D + 256 * j + 4 * lane); v[j] = (f32x4){bflo(xw.x), bfhi(xw.x), bflo(xw.y), bfhi(xw.y)}; }
                f32x4 a[4];
#pragma unroll
                for (int j = 0; j < 4; ++j) a[j] = (f32x4){0.f, 0.f, 0.f, 0.f};
#pragma unroll
                for (int k = (DBG_MOE >= 1 ? 0 : 9); k < (DBG_MOE >= 2 ? 9 : 1); ++k) {
                    const float wk = k == 0 ? 1.0f : PW[m * 8 + (k > 0 ? k - 1 : 0)];
#pragma unroll
                    for (int j = 0; j < 4; ++j) { const f32x2_t lo = __builtin_amdgcn_cvt_pk_f32_fp8((int)yr[k][j], false), hi = __builtin_amdgcn_cvt_pk_f32_fp8((int)yr[k][j], true); a[j] += (f32x4){lo[0], lo[1], hi[0], hi[1]} * wk; } }
                float s = 0.f;
#pragma unroll
                for (int j = 0; j < 4; ++j) { v[j] = v[j] + g2[j] * a[j]; s += (v[j].x * v[j].x + v[j].y * v[j].y) + (v[j].z * v[j].z + v[j].w * v[j].w); }
                const float rstd = 1.0f / sqrtf(wave_sum(s) * (1.f / D) + RMS_EPS);
                GAS f32x4* dr = (GAS f32x4*)(dst13 + (size_t)m * D + 4 * lane);
#pragma unroll
                for (int j = 0; j < 4; ++j) dr[64 * j] = v[j] * rstd * fg[j];
            }
        }
    REP_END(13) }
#if defined(DBG_DUMP)
    {
        xcd_barrier(bar);
        const bf16* SRC = DBG_DUMP_SRC; const int ld = DBG_DUMP_LD, off = DBG_DUMP_OFF;
        for (int m = F.gw; m < T; m += F.NGW) {
#pragma unroll
            for (int j = 0; j < 4; ++j) { const int c = 4 * lane + 256 * j; const int cc = c % DBG_DUMP_W; const v2u y = *(const v2u*)(SRC + (size_t)m * ld + off + cc); *(f32x4*)(out + (size_t)m * 1024 + c) = (f32x4){bflo(y.x), bfhi(y.x), bflo(y.y), bfhi(y.y)}; }
        }
    }
#endif
#undef IN
#undef SEAM
}

#undef X_IN
#undef cvec
#undef ada_w
#undef ada_b
#undef norm1_g
#undef w_in
#undef lb_logits
#undef hg_norm_g
#undef w_branch_a
#undef w_branch_b
#undef w_out
#undef norm2_g
#undef w_router
#undef router_bias
#undef w_exp_gate
#undef w_exp_up
#undef w_exp_down
#undef w_sh_gate
#undef w_sh_up
#undef w_sh_down
#undef final_g
#undef out
#undef WIN_T
#undef WA_T
#undef WB_T
#undef WO_T
#undef RS_T
#undef WSD_T
#undef WD
#undef WGU
#undef PE
#undef PR
#undef PW
#undef SLOT_TOK
#undef SLOT_W
#undef TOK_SLOT
#undef LSE
#undef QF
#undef OA
#undef OG
#undef MERGED
#undef HMID
#undef YSH
#undef AQKV
#undef GAB
#undef XN
#undef YA
#undef YB
#undef H2
#undef LOGITS
#undef YSLOT
#undef MOD
#undef HISTG
#undef ATTQ
#ifndef DBG_MOE
#define DBG_MOE 2
#endif
#ifndef MK_CUTS
#define MK_CUTS 1
#endif
extern "C" void kernel_launch(void* const* d_in, const int* in_sizes, int n_in, void* d_out, int out_size, void* d_ws, size_t ws_size, hipStream_t stream) {
    static int grid = 0;
    if (grid == 0) {
        if (n_in != 21 || out_size != T * D || ws_size < WS_END) { fprintf(stderr, "kernel_launch: unexpected shapes (n_in %d out %d ws %zu)\n", n_in, out_size, ws_size); grid = -1; return; }
        int dev = 0, cus = 0, per_cu = 0;
        if (hipGetDevice(&dev) != hipSuccess || hipDeviceGetAttribute(&cus, hipDeviceAttributeMultiprocessorCount, dev) != hipSuccess) { grid = -1; return; }
        if (hipFuncSetAttribute((const void*)mk_fwd, hipFuncAttributeMaxDynamicSharedMemorySize, LDS_BYTES) != hipSuccess) { fprintf(stderr, "kernel_launch: hipFuncSetAttribute failed\n"); grid = -1; return; }
        if (hipOccupancyMaxActiveBlocksPerMultiprocessor(&per_cu, (const void*)mk_fwd, NWAVES * 64, LDS_BYTES) != hipSuccess || per_cu < 1) fprintf(stderr, "kernel_launch: occupancy query reports %d\n", per_cu);
        (void)hipGetLastError();
        grid = cus;
    }
    if (grid < 0) return;
    if (hipMemsetAsync((char*)d_ws + WS_CTL, 0, CTL_ZERO_BYTES, stream) != hipSuccess) return;
    Args a{};
    for (int i = 0; i < 21; ++i) a.in[i] = (const float*)d_in[i];
    a.out = (float*)d_out; a.ws = (unsigned char*)d_ws;
#if MK_CUTS == 1
    a.ph_lo = 0; a.ph_hi = 14;
    hipLaunchKernelGGL(mk_fwd, dim3(grid), dim3(NWAVES * 64), LDS_BYTES, stream, a);
#else
    for (int p = 0; p < 14; ++p) { a.ph_lo = p; a.ph_hi = p + 1; hipLaunchKernelGGL(mk_fwd, dim3(grid), dim3(NWAVES * 64), LDS_BYTES, stream, a); }
#endif
}
```

```cpp
#include <hip/hip_runtime.h>
#include <cstdio>
#include <cstdint>
#ifndef DBG_MOE
#define DBG_MOE 2
#endif

#define GAS __attribute__((address_space(1)))
#define LAS __attribute__((address_space(3)))
typedef unsigned short bf16;
typedef unsigned v4u __attribute__((ext_vector_type(4)));
typedef unsigned v2u __attribute__((ext_vector_type(2)));
typedef float f32x4 __attribute__((ext_vector_type(4)));
typedef short bf16x8 __attribute__((ext_vector_type(8)));
typedef short bf16x4 __attribute__((ext_vector_type(4)));
typedef short v4i16_t __attribute__((ext_vector_type(4)));
typedef GAS unsigned gu32;

constexpr int NB = 8, SEQ = 4096, D = 1024, T = NB * SEQ;
constexpr int NIN = 6400;
constexpr int NEXP = 256, TOPK = 8, DEXP = 256;
constexpr int NSLOT = T * TOPK;
constexpr int MAXRT = NSLOT / 256 + NEXP;
constexpr int NSLOTP = MAXRT * 256;
constexpr int MAXTILES = MAXRT + T / 256;
constexpr float RMS_EPS = 1e-6f;
constexpr int NWAVES = 8;
constexpr int SH_WD = 5, SH_HMID = 2, SH_WGU = 6, SH_X = 2, SH_Y = 3, SH_G = 2, SH_U = 2, SH_M = 3, SH_YAB = 2, SH_WAB = 5, SH_Q = 2;
constexpr int SC_WD = 0x01010101 * (127 - SH_WD), SC_HMID = 0x01010101 * (127 - SH_HMID), SC_WGU = 0x01010101 * (127 - SH_WGU), SC_X = 0x01010101 * (127 - SH_X), SC_M = 0x01010101 * (127 - SH_M), SC_YAB = 0x01010101 * (127 - SH_YAB), SC_WAB = 0x01010101 * (127 - SH_WAB);

constexpr size_t MiB = 1u << 20;
constexpr size_t WS_CTL = 0, CTL_ZERO_BYTES = 1 * MiB;
constexpr size_t WS_WIN_T = 1 * MiB;
constexpr size_t WS_WA_T = 14 * MiB;
constexpr size_t WS_WB_T = 15 * MiB;
constexpr size_t WS_WO_T = 16 * MiB;
constexpr size_t WS_RS_T = 18 * MiB;
constexpr size_t WS_WSD_T = 20 * MiB;
constexpr size_t WS_PE = 21 * MiB, WS_PR = 22 * MiB, WS_PW = 23 * MiB;
constexpr size_t WS_SLOT_TOK = 24 * MiB, WS_SLOT_W = 25 * MiB, WS_TOK_SLOT = 27 * MiB;
constexpr size_t WS_LSE = 28 * MiB;
constexpr size_t WS_HISTG = 31 * MiB;
constexpr size_t WS_MOD = 30 * MiB;
constexpr size_t WS_WD = 32 * MiB;
constexpr size_t WS_QF = 160 * MiB;
constexpr size_t WS_OA = 288 * MiB;
constexpr size_t WS_OG = 320 * MiB;
constexpr size_t WS_MERGED = 288 * MiB;
constexpr size_t WS_HMID = 160 * MiB;
constexpr size_t WS_YSH = 304 * MiB;
constexpr size_t WS_WGU = 384 * MiB;
constexpr size_t WS_AQKV = 640 * MiB;
constexpr size_t WS_GAB = 784 * MiB;
constexpr size_t WS_XN = 912 * MiB;
constexpr size_t WS_YA = 640 * MiB;
constexpr size_t WS_YB = 368 * MiB;
constexpr size_t WS_H2 = 640 * MiB;
constexpr size_t WS_H2F8 = 912 * MiB;
constexpr size_t WS_X1B = 736 * MiB;
constexpr size_t WS_LOGITS = 704 * MiB;
constexpr size_t WS_YSLOT = 384 * MiB;
constexpr size_t WS_UT = 912 * MiB;
constexpr size_t WS_QTB = 976 * MiB;
constexpr size_t WS_DK = 1008 * MiB;
constexpr size_t WS_PART = 18 * MiB;
constexpr size_t WS_CB = 19 * MiB;
constexpr size_t WS_RSTD = 19 * MiB + 65536;
constexpr size_t WS_WRB = 1009 * MiB;
constexpr size_t WS_END = 1013 * MiB;
constexpr int CW_TMO = 0, CW_CODE = 1, CW_BAR = 4096, CW_GCNT = 16384, CW_ATTQ = 20480, CW_MOD = 65536;

constexpr int RING_BYTES = 131072;
constexpr int TAB_OFF = RING_BYTES;
constexpr int MISC_OFF = TAB_OFF + MAXTILES * 16;
constexpr int LDS_BYTES = MISC_OFF + 256;

#define RLX_AGENT __ATOMIC_RELAXED, __HIP_MEMORY_SCOPE_AGENT
#define LDS_WAIT() asm volatile("s_waitcnt lgkmcnt(0)" ::: "memory")
#define VM_WAIT() asm volatile("s_waitcnt vmcnt(0)" ::: "memory")
#define LBAR() do { asm volatile("s_waitcnt lgkmcnt(0)" ::: "memory"); __builtin_amdgcn_s_barrier(); asm volatile("" ::: "memory"); } while (0)
typedef float f32x2_t __attribute__((ext_vector_type(2))); typedef __bf16 bf16x2_t __attribute__((ext_vector_type(2)));
__device__ __forceinline__ unsigned cvt_pk_bf16(float lo, float hi) { f32x2_t v = {lo, hi}; bf16x2_t b = __builtin_convertvector(v, bf16x2_t); return __builtin_bit_cast(unsigned, b); }
typedef int v8i __attribute__((ext_vector_type(8))); typedef int v4i_t __attribute__((ext_vector_type(4)));
__device__ __forceinline__ unsigned cvt4_fp8(float a, float b, float c, float d) {
    a = __builtin_amdgcn_fmed3f(a, -448.f, 448.f); b = __builtin_amdgcn_fmed3f(b, -448.f, 448.f); c = __builtin_amdgcn_fmed3f(c, -448.f, 448.f); d = __builtin_amdgcn_fmed3f(d, -448.f, 448.f);
    int w = 0; w = __builtin_amdgcn_cvt_pk_fp8_f32(a, b, w, false); w = __builtin_amdgcn_cvt_pk_fp8_f32(c, d, w, true); return (unsigned)w; }
__device__ __forceinline__ v4u f8x8_to_bf16(unsigned w0, unsigned w1) {
    const f32x2_t a = __builtin_amdgcn_cvt_pk_f32_fp8((int)w0, false), b = __builtin_amdgcn_cvt_pk_f32_fp8((int)w0, true), c = __builtin_amdgcn_cvt_pk_f32_fp8((int)w1, false), d = __builtin_amdgcn_cvt_pk_f32_fp8((int)w1, true);
    v4u o; o.x = cvt_pk_bf16(a[0], a[1]); o.y = cvt_pk_bf16(b[0], b[1]); o.z = cvt_pk_bf16(c[0], c[1]); o.w = cvt_pk_bf16(d[0], d[1]); return o; }
__device__ __forceinline__ float bf2f(unsigned h) { return __uint_as_float(h << 16); }
__device__ __forceinline__ float bflo(unsigned w) { return __uint_as_float(w << 16); }
__device__ __forceinline__ float bfhi(unsigned w) { return __uint_as_float(w & 0xffff0000u); }
__device__ __forceinline__ float fsigmoid(float x) { return __builtin_amdgcn_rcpf(1.0f + __expf(-x)); }
__device__ __forceinline__ float fsilu(float x) { return x * fsigmoid(x); }
__device__ __forceinline__ float wave_sum(float v) {
#pragma unroll
    for (int o = 1; o < 64; o <<= 1) v += __shfl_xor(v, o);
    return v;
}

#define XB_TMO      128
#define XB_XCNT(j)  (256  + 64 * (j))
#define XB_XSUB(j)  (1280 + 64 * (j))
#define XB_XGEN(j)  (2304 + 64 * (j))
#define XB_TOP      3328
#define XB_TOPGEN   3392
#define XCD_BAR_WORDS 3456
#define XB_SPIN_CAP (1u << 18)
__device__ __forceinline__ unsigned xb_ld(unsigned* p)              { return __hip_atomic_load(p, __ATOMIC_RELAXED, __HIP_MEMORY_SCOPE_AGENT); }
__device__ __forceinline__ unsigned xb_add(unsigned* p, unsigned v) { return __hip_atomic_fetch_add(p, v, __ATOMIC_RELAXED, __HIP_MEMORY_SCOPE_AGENT); }
__device__ __forceinline__ unsigned xb_xcc_id() { return (unsigned)__builtin_amdgcn_s_getreg((3 << 11) | 20) & 0xFu; }
#define XB_SPIN(cond, bar) do { unsigned _sp = 0; while (cond) { __builtin_amdgcn_s_sleep(1); \
    if ((++_sp & 255u) == 0u) { if (xb_ld(&(bar)[XB_TMO])) break; if (_sp > XB_SPIN_CAP) { atomicAdd(&(bar)[XB_TMO], 1u); break; } } } } while (0)
struct XcdBarrier { unsigned* bar; unsigned x; volatile LAS unsigned* st; };
__device__ __forceinline__ XcdBarrier xcd_barrier_post(unsigned* bar, volatile LAS unsigned* st) {
    XcdBarrier b; b.bar = bar; b.x = xb_xcc_id(); b.st = st;
    if (threadIdx.x == 0) (void)xb_add(&bar[XB_XCNT(b.x)], 1u);
    return b;
}
__device__ __forceinline__ void xcd_barrier_complete(unsigned* bar, unsigned x, unsigned& nloc, unsigned& nx) {
    const unsigned G = gridDim.x * gridDim.y * gridDim.z;
    unsigned sum, cnt, mine, sp = 0u;
    for (;;) {
        sum = 0u; cnt = 0u; mine = 0u;
#pragma unroll
        for (unsigned j = 0; j < 16; ++j) { const unsigned c = xb_ld(&bar[XB_XCNT(j)]); sum += c; cnt += (c > 0u) ? 1u : 0u; mine = (j == x) ? c : mine; }
        if (sum == G) break;
        __builtin_amdgcn_s_sleep(1);
        if ((++sp & 255u) == 0u) { if (xb_ld(&bar[XB_TMO])) break; if (sp > XB_SPIN_CAP) { atomicAdd(&bar[XB_TMO], 1u); break; } }
    }
    nloc = mine > 0u ? mine : 1u; nx = cnt > 0u ? cnt : 1u;
}
__device__ __forceinline__ void xcd_barrier(const XcdBarrier& b) {
    asm volatile("s_waitcnt vmcnt(0)" ::: "memory");
    __syncthreads();
    if (threadIdx.x == 0) {
        unsigned* bar = b.bar;
        __builtin_amdgcn_s_waitcnt(0);
        unsigned nloc = b.st[0], nx = b.st[1];
        if (nloc == 0u) { xcd_barrier_complete(bar, b.x, nloc, nx); b.st[0] = nloc; b.st[1] = nx; }
        const unsigned old = xb_add(&bar[XB_XSUB(b.x)], 1u);
        const unsigned gen = old / nloc;
        if (old + 1u == (gen + 1u) * nloc) {
            __builtin_amdgcn_fence(__ATOMIC_RELEASE, "agent");
            asm volatile("s_waitcnt vmcnt(0)" ::: "memory");
            const unsigned og = xb_add(&bar[XB_TOP], 1u);
            const unsigned tg = og / nx;
            if (og + 1u == (tg + 1u) * nx) xb_add(&bar[XB_TOPGEN], 1u);
            else XB_SPIN(xb_ld(&bar[XB_TOPGEN]) == tg, bar);
            __builtin_amdgcn_fence(__ATOMIC_ACQUIRE, "agent");
            xb_add(&bar[XB_XGEN(b.x)], 1u);
            asm volatile("s_waitcnt vmcnt(0)" ::: "memory");
        } else {
            XB_SPIN(xb_ld(&bar[XB_XGEN(b.x)]) == gen, bar);
            __builtin_amdgcn_fence(__ATOMIC_ACQUIRE, "agent");
            asm volatile("s_waitcnt vmcnt(0)" ::: "memory");
        }
    }
    __syncthreads();
}

__device__ __forceinline__ void glds16s(const void* sbase, unsigned voff, unsigned lds_dst) {
    unsigned keep;
    asm volatile("s_mov_b32 %0, m0\n\ts_mov_b32 m0, %3\n\ts_nop 0\n\tglobal_load_lds_dwordx4 %1, %2\n\ts_mov_b32 m0, %0" : "=&s"(keep) : "v"(voff), "s"(sbase), "s"(lds_dst) : "memory");
}
namespace pg8 {
constexpr int BM = 256, BK = 64, HALF = 128, HTB = HALF * BK * 2, NXCD = 8, WGM = 8;
__host__ __device__ __forceinline__ int lds_byte(int r, int c) { const int st = (r >> 4) * 2 + (c >> 5), rr = r & 15, cc = c & 31, ob = rr * 64 + cc * 2; return st * 1024 + (ob ^ (((ob >> 9) & 1) << 5)); }
__host__ __device__ __forceinline__ void stage_rc(int b, int& R, int& C) { const int st = b / 1024, sb = b % 1024, swz = sb ^ (((sb >> 9) & 1) << 5); R = (st >> 1) * 16 + swz / 64; C = (st & 1) * 32 + (swz % 64) / 2; }
__host__ __device__ __forceinline__ int perm32(int rho) { const int n = rho >> 4, i = rho & 15; return 8 * (i >> 2) + 4 * n + (i & 3); }
struct Unit { int pm, pn, e, row0, rows; };

struct DenseSched {
    int nM, nN, nwg, G, c; unsigned rowbytes; int arow0; const char* Bt;
    __device__ void init(int M, int N, int Kbytes, int G_, int c_, const void* Bt_, int arow0_ = 0) { nM = M / BM; nN = N / BM; nwg = nM * nN; G = G_; c = c_; rowbytes = (unsigned)Kbytes; arow0 = arow0_; Bt = (const char*)Bt_; }
    __device__ __forceinline__ bool next(int i, Unit& u) const {
        const long L = (long)i * G + c; if (L >= nwg) return false;
        int wgid = (int)L; { const int q = nwg / NXCD, r = nwg % NXCD, xcd = wgid % NXCD, off = wgid / NXCD; wgid = (xcd < r ? xcd * (q + 1) : r * (q + 1) + (xcd - r) * q) + off; }
        const int nig = WGM * nN, gid = wgid / nig, fm = gid * WGM, gsz = (nM - fm) < WGM ? (nM - fm) : WGM;
        u.pm = fm + ((wgid % nig) % gsz); u.pn = (wgid % nig) / gsz; u.e = 0; u.row0 = u.pm * BM; u.rows = BM; return true;
    }
    __device__ __forceinline__ unsigned a_off(const Unit& u, int r) const { return (unsigned)(arow0 + u.pm * BM + r) * rowbytes; }
    __device__ __forceinline__ const char* b_base(const Unit& u) const { return Bt + (size_t)u.pn * BM * rowbytes; }
};
template <int NPN, bool GATHER>
struct RoutedSched {
    const LAS int* tab; int ntiles, G, c; unsigned rowbytes; const char* Bt; size_t estride; const int* rowlist;
    __device__ __forceinline__ bool next(int i, Unit& u) const {
        const long L = (long)i * G + c; if (L >= (long)ntiles * NPN) return false;
        const int ti = (int)(L / NPN); u.pn = (int)(L % NPN); u.pm = ti;
        u.e = __builtin_amdgcn_readfirstlane(tab[ti * 4 + 0]); u.row0 = __builtin_amdgcn_readfirstlane(tab[ti * 4 + 1]); u.rows = __builtin_amdgcn_readfirstlane(tab[ti * 4 + 2]); return true;
    }
    __device__ __forceinline__ unsigned a_off(const Unit& u, int r) const {
        const int s = u.row0 + r;
        if (GATHER) return (unsigned)rowlist[s] * rowbytes; else return (unsigned)s * rowbytes;
    }
    __device__ __forceinline__ const char* b_base(const Unit& u) const { return Bt + (size_t)u.e * estride + (size_t)u.pn * BM * rowbytes; }
};

struct RouterSched {
    int n, G, c; const char* Bt;
    __device__ __forceinline__ bool next(int i, Unit& u) const { const long L = (long)i * G + c; if (L >= n) return false; u.pm = (int)L; u.pn = 0; u.e = 0; u.row0 = u.pm * BM; u.rows = BM; return true; }
    __device__ __forceinline__ unsigned a_off(const Unit& u, int r) const { return (unsigned)(u.pm * BM + r) * 2048u; }
    __device__ __forceinline__ const char* b_base(const Unit& u) const { return Bt + (size_t)(u.pm >> 4) * (256 * 2048); }
};

template <bool ALIGN_EPI, bool FP8, class Epi, class Sched, int CM = 1>
__device__ __forceinline__ void gemm_phase(LAS unsigned char* lds, const char* Abase, const int Kbytes, const Sched& S, const Epi& E, const int scaleW = 0x7F7F7F7F, const int scaleX = 0x7F7F7F7F) {
    int tid = threadIdx.x; asm volatile("" : "+v"(tid));
    const int wid = __builtin_amdgcn_readfirstlane(tid >> 6), lane = tid & 63, wr = wid >> 2, wc = wid & 3, fr = lane & 15, fq = lane >> 4;
    const int nt = Kbytes / (BK * 2);
    unsigned voffB[2];
#pragma unroll
    for (int i = 0; i < 2; ++i) { int R, C; stage_rc(tid * 16 + i * 8192, R, C); const int Rb = (CM == 2) ? 2 * (R & ~31) + 16 * ((R & 15) >> 2) + 4 * ((R >> 4) & 1) + (R & 3) : (CM ? 2 * (R & ~31) : (R & ~31)) + perm32(R & 31); voffB[i] = (unsigned)(Rb * Kbytes + C * 2); }
    const size_t kstep = (size_t)(BK * 2);
    const size_t hstepB = (size_t)(CM == 2 ? 8 : CM ? 32 : HALF) * Kbytes;
    const unsigned ldsw = (unsigned)wid * 1024u;
    const unsigned lds0 = (unsigned)(uintptr_t)lds;
    const int aoff = lds_byte(wr * 64 + fr, fq * 8), boff = lds_byte(wc * 32 + fr, fq * 8);
#define PG8_SA(b, h) (((b) * 2 + (h)) * HTB)
#define PG8_SB(b, h) ((4 + (b) * 2 + (h)) * HTB)
#define PG8_STAGE(bufoff, gbase, voff) do { _Pragma("unroll") for (int _i = 0; _i < 2; ++_i) \
        glds16s((const void*)(gbase), (voff)[_i], lds0 + (unsigned)((bufoff) + _i * 8192) + ldsw); } while (0)
#define PG8_LD2(p) __builtin_shufflevector(*(const LAS v4i_t*)(p), *(const LAS v4i_t*)((p) + 1024), 0, 1, 2, 3, 4, 5, 6, 7)
#define PG8_LDA(dst, b, h) do { _Pragma("unroll") for (int m = 0; m < 4; ++m) dst[m] = PG8_LD2(lds + PG8_SA(b, h) + aoff + m * 2048); } while (0)
#define PG8_LDB(dst, b, h) do { _Pragma("unroll") for (int n = 0; n < 2; ++n) dst[n] = PG8_LD2(lds + PG8_SB(b, h) + boff + n * 2048); } while (0)
#define PG8_LO(v) __builtin_bit_cast(bf16x8, __builtin_shufflevector(v, v, 0, 1, 2, 3))
#define PG8_HI(v) __builtin_bit_cast(bf16x8, __builtin_shufflevector(v, v, 4, 5, 6, 7))
#define PG8_MMA(ai, bj, At, Bt) do { __builtin_amdgcn_s_setprio(1); _Pragma("unroll") for (int m = 0; m < 4; ++m) _Pragma("unroll") for (int n = 0; n < 2; ++n) { \
        if constexpr (FP8) acc[ai][bj][m][n] = __builtin_amdgcn_mfma_scale_f32_16x16x128_f8f6f4(Bt[n], At[m], acc[ai][bj][m][n], 0, 0, 0, scaleW, 0, scaleX); \
        else { acc[ai][bj][m][n] = __builtin_amdgcn_mfma_f32_16x16x32_bf16(PG8_LO(Bt[n]), PG8_LO(At[m]), acc[ai][bj][m][n], 0, 0, 0); acc[ai][bj][m][n] = __builtin_amdgcn_mfma_f32_16x16x32_bf16(PG8_HI(Bt[n]), PG8_HI(At[m]), acc[ai][bj][m][n], 0, 0, 0); } } __builtin_amdgcn_s_setprio(0); } while (0)
#define PG8_WAIT_V(n) asm volatile("s_waitcnt vmcnt(" #n ")" ::: "memory")
#define PG8_WAIT_L(n) asm volatile("s_waitcnt lgkmcnt(" #n ")" ::: "memory")
#define PG8_BAR __builtin_amdgcn_s_barrier()
#define PG8_SCHED __builtin_amdgcn_sched_barrier(0)
#define PG8_AOFF(u, o0, o1) do { int _t = tid; asm volatile("" : "+v"(_t)); _Pragma("unroll") for (int _i = 0; _i < 2; ++_i) { int _R, _C; stage_rc(_t * 16 + _i * 8192, _R, _C); \
        o0[_i] = S.a_off(u, _R) + (unsigned)_C * 2u; o1[_i] = S.a_off(u, _R + HALF) + (unsigned)_C * 2u; } } while (0)
    Unit cur, nxt; int ui = 0;
    if (!S.next(0, cur)) return;
    f32x4 acc[2][2][4][2];
#pragma unroll
    for (int a = 0; a < 2; ++a)
#pragma unroll
        for (int b = 0; b < 2; ++b)
#pragma unroll
            for (int m = 0; m < 4; ++m)
#pragma unroll
                for (int n = 0; n < 2; ++n) acc[a][b][m][n] = (f32x4){0.f, 0.f, 0.f, 0.f};
    v8i At[4], B0[2], B1[2];
    unsigned cA0[2], cA1[2];
    PG8_AOFF(cur, cA0, cA1);
    const char* cB = S.b_base(cur); const char* nB = cB;
    PG8_STAGE(PG8_SB(0, 0), cB, voffB); PG8_STAGE(PG8_SB(0, 1), cB + hstepB, voffB); PG8_STAGE(PG8_SA(0, 0), Abase, cA0); PG8_STAGE(PG8_SA(0, 1), Abase, cA1);
    if (wr == 1) PG8_BAR;
    PG8_WAIT_V(2); PG8_BAR;
    PG8_STAGE(PG8_SB(1, 0), cB + kstep, voffB); PG8_STAGE(PG8_SA(1, 0), Abase + kstep, cA0); PG8_STAGE(PG8_SB(1, 1), cB + hstepB + kstep, voffB);
    PG8_WAIT_V(6); PG8_BAR;
    for (;;) {
        const bool has_next = S.next(ui + 1, nxt);
#pragma unroll 1
        for (int t = 0; t < nt; t += 2) {
            const bool last = (t == nt - 2);
            if constexpr (Epi::MID_T > 0) { if (t == Epi::MID_T) { PG8_SCHED; E.mid(acc, cur, wr, wc, fr, fq); PG8_SCHED; } }
            if (last && has_next) nB = S.b_base(nxt);
            const char* a1 = Abase + (size_t)(t + 1) * kstep;
            const char* a2 = last ? Abase : Abase + (size_t)(t + 2) * kstep; const char* b2 = last ? nB : cB + (size_t)(t + 2) * kstep;
            const char* a3 = a2 + kstep; const char* b3 = b2 + kstep;
            PG8_LDB(B0, 0, 0); PG8_LDB(B1, 0, 1); PG8_SCHED; PG8_LDA(At, 0, 0); PG8_STAGE(PG8_SA(1, 1), a1, cA1);
            if (last && has_next) { PG8_AOFF(nxt, cA0, cA1); }
            PG8_WAIT_V(8); PG8_WAIT_L(0); PG8_BAR; PG8_MMA(0, 0, At, B0); PG8_MMA(0, 1, At, B1); PG8_BAR; PG8_SCHED;
            PG8_LDA(At, 0, 1); PG8_STAGE(PG8_SB(0, 0), b2, voffB); PG8_STAGE(PG8_SB(0, 1), b2 + hstepB, voffB); PG8_STAGE(PG8_SA(0, 0), a2, cA0);
            PG8_WAIT_V(8); PG8_WAIT_L(0); PG8_BAR; PG8_MMA(1, 0, At, B0); PG8_MMA(1, 1, At, B1); PG8_BAR; PG8_SCHED;
            PG8_LDB(B0, 1, 0); PG8_LDB(B1, 1, 1); PG8_SCHED; PG8_LDA(At, 1, 0); PG8_STAGE(PG8_SA(0, 1), a2, cA1);
            PG8_WAIT_V(8); PG8_WAIT_L(0); PG8_BAR; PG8_MMA(0, 0, At, B0); PG8_MMA(0, 1, At, B1); PG8_BAR; PG8_SCHED;
            PG8_LDA(At, 1, 1); PG8_STAGE(PG8_SB(1, 0), b3, voffB); PG8_STAGE(PG8_SB(1, 1), b3 + hstepB, voffB); PG8_STAGE(PG8_SA(1, 0), a3, cA0);
            PG8_WAIT_V(8); PG8_WAIT_L(0); PG8_BAR; PG8_MMA(1, 0, At, B0); PG8_MMA(1, 1, At, B1); PG8_BAR; PG8_SCHED;
        }
        if constexpr (ALIGN_EPI) { if (wr == 0) PG8_BAR; }
        { Unit eu = cur; int efr = fr, efq = fq; asm volatile("" : "+s"(eu.pm), "+s"(eu.pn), "+s"(eu.e), "+s"(eu.row0), "+s"(eu.rows), "+v"(efr), "+v"(efq)); E(acc, eu, wr, wc, efr, efq); }
        if (!has_next) break;
#pragma unroll
        for (int a = 0; a < 2; ++a)
#pragma unroll
            for (int b = 0; b < 2; ++b)
#pragma unroll
                for (int m = 0; m < 4; ++m)
#pragma unroll
                    for (int n = 0; n < 2; ++n) acc[a][b][m][n] = (f32x4){0.f, 0.f, 0.f, 0.f};
        cur = nxt; cB = nB; ++ui;
        if constexpr (ALIGN_EPI) { if (wr == 1) PG8_BAR; }
    }
    PG8_WAIT_V(0);
    if constexpr (!ALIGN_EPI) { if (wr == 0) PG8_BAR; }
    PG8_BAR;
#undef PG8_SA
#undef PG8_SB
#undef PG8_STAGE
#undef PG8_LDA
#undef PG8_LDB
#undef PG8_MMA
#undef PG8_LO
#undef PG8_HI
#undef PG8_LD2
#undef PG8_WAIT_V
#undef PG8_WAIT_L
#undef PG8_BAR
#undef PG8_SCHED
#undef PG8_AOFF
}

constexpr int WCS = 64, BJS = 32;
#define EPI_ROWS_BEGIN _Pragma("unroll") for (int ai = 0; ai < 2; ++ai) _Pragma("unroll") for (int m = 0; m < 4; ++m) { const int rt = ai * HALF + wr * 64 + m * 16 + fr;
#define EPI_ROWS_END }
__device__ __forceinline__ v4u pack8(const f32x4 a, const f32x4 b) { v4u w; w.x = cvt_pk_bf16(a[0], a[1]); w.y = cvt_pk_bf16(a[2], a[3]); w.z = cvt_pk_bf16(b[0], b[1]); w.w = cvt_pk_bf16(b[2], b[3]); return w; }

__device__ __forceinline__ v2u act8_fp8(const f32x4 a, const f32x4 b, const bool silu) {
    const float sc = (float)(1 << SH_G); float x[8] = {a[0], a[1], a[2], a[3], b[0], b[1], b[2], b[3]};
#pragma unroll
    for (int j = 0; j < 8; ++j) { const float sg = fsigmoid(x[j]); x[j] = (silu ? x[j] * sg : sg) * sc; }
    v2u w; w.x = cvt4_fp8(x[0], x[1], x[2], x[3]); w.y = cvt4_fp8(x[4], x[5], x[6], x[7]); return w;
}
struct EpiWin { static constexpr int MID_T = 0;
    unsigned char *QF8, *AQKV8, *GAB8, *HG8; int dry;
    __device__ __forceinline__ void operator()(const f32x4 (&acc)[2][2][4][2], const Unit& u, int wr, int wc, int fr, int fq) const {
        if (dry) return;
        if (u.pn >= 17 || u.pn == 6 || u.pn == 7) {
            const bool silu = u.pn < 8; unsigned char* base = silu ? HG8 : GAB8; const int ldc = silu ? 512 : 2048, ct = silu ? u.pn - 6 : u.pn - 17;
            const int col0 = ct * BM + wc * 64 + 16 * fq;
            EPI_ROWS_BEGIN { unsigned char* rowp = base + (size_t)(u.pm * BM + rt) * ldc + col0;
                const v2u lo = act8_fp8(acc[ai][0][m][0], acc[ai][0][m][1], silu), hi = act8_fp8(acc[ai][1][m][0], acc[ai][1][m][1], silu);
                *(v4u*)rowp = (v4u){lo.x, lo.y, hi.x, hi.y}; } EPI_ROWS_END
            return;
        }
        unsigned char* base; int ldc, ct;
        if (u.pn < 8) { base = QF8; ldc = 1536; ct = u.pn; } else { base = AQKV8; ldc = 2304; ct = u.pn - 8; }
        const int col0 = ct * BM + wc * 64 + 16 * fq; const float sq = (float)(1 << SH_Q);
        EPI_ROWS_BEGIN { unsigned char* rowp = base + (size_t)(u.pm * BM + rt) * ldc + col0;
            const f32x4 a = acc[ai][0][m][0] * sq, b = acc[ai][0][m][1] * sq, c = acc[ai][1][m][0] * sq, d = acc[ai][1][m][1] * sq;
            *(v4u*)rowp = (v4u){cvt4_fp8(a[0], a[1], a[2], a[3]), cvt4_fp8(b[0], b[1], b[2], b[3]), cvt4_fp8(c[0], c[1], c[2], c[3]), cvt4_fp8(d[0], d[1], d[2], d[3])}; } EPI_ROWS_END
    }
};
template <bool ADD> struct EpiBranch { static constexpr int MID_T = 0;
    const unsigned char* G; int goff; bf16* O;
    __device__ __forceinline__ void operator()(const f32x4 (&acc)[2][2][4][2], const Unit& u, int wr, int wc, int fr, int fq) const {
        const int col0 = u.pn * BM + wc * WCS + 8 * fq;
        EPI_ROWS_BEGIN { const size_t row = (size_t)(u.pm * BM + rt);
#pragma unroll
            for (int bj = 0; bj < 2; ++bj) {
                const v2u g = *(const v2u*)(G + row * 2048 + goff + col0 + bj * BJS); const float gs = 1.0f / (float)(1 << SH_G);
                const f32x2_t g0 = __builtin_amdgcn_cvt_pk_f32_fp8((int)g.x, false), g1 = __builtin_amdgcn_cvt_pk_f32_fp8((int)g.x, true), g2 = __builtin_amdgcn_cvt_pk_f32_fp8((int)g.y, false), g3 = __builtin_amdgcn_cvt_pk_f32_fp8((int)g.y, true);
                f32x4 a = acc[ai][bj][m][0] * (f32x4){g0[0], g0[1], g1[0], g1[1]} * gs, b = acc[ai][bj][m][1] * (f32x4){g2[0], g2[1], g3[0], g3[1]} * gs;
                bf16* op = O + row * 1024 + col0 + bj * BJS;
                if (ADD) { const v4u o = *(const v4u*)op; a[0] += bflo(o.x); a[1] += bfhi(o.x); a[2] += bflo(o.y); a[3] += bfhi(o.y); b[0] += bflo(o.z); b[1] += bfhi(o.z); b[2] += bflo(o.w); b[3] += bfhi(o.w); }
                *(v4u*)op = pack8(a, b); } } EPI_ROWS_END
    }
};
struct EpiMerge {
    static constexpr int MID_T = 4;
    const unsigned char* G; unsigned char* O;
    __device__ __forceinline__ static void dec8(const v2u g, float (&f)[8]) { const f32x2_t a = __builtin_amdgcn_cvt_pk_f32_fp8((int)g.x, false), b = __builtin_amdgcn_cvt_pk_f32_fp8((int)g.x, true), c = __builtin_amdgcn_cvt_pk_f32_fp8((int)g.y, false), d = __builtin_amdgcn_cvt_pk_f32_fp8((int)g.y, true);
        f[0] = a[0]; f[1] = a[1]; f[2] = b[0]; f[3] = b[1]; f[4] = c[0]; f[5] = c[1]; f[6] = d[0]; f[7] = d[1]; }
    __device__ __forceinline__ void mid(f32x4 (&acc)[2][2][4][2], const Unit& u, int wr, int wc, int fr, int fq) const {
        const int col0 = u.pn * BM + wc * 64 + 16 * fq;
        EPI_ROWS_BEGIN { const size_t row = (size_t)(u.pm * BM + rt);
            const v4u ga = *(const v4u*)(G + row * 2048 + col0), gb = *(const v4u*)(G + row * 2048 + 1024 + col0);
#pragma unroll
            for (int bj = 0; bj < 2; ++bj) { float sa[8], sb[8]; dec8(bj ? (v2u){ga.z, ga.w} : (v2u){ga.x, ga.y}, sa); dec8(bj ? (v2u){gb.z, gb.w} : (v2u){gb.x, gb.y}, sb);
#pragma unroll
                for (int j = 0; j < 4; ++j) { acc[ai][bj][m][0][j] *= sa[j] * __builtin_amdgcn_rcpf(fmaxf(sb[j], 0.001953125f)); acc[ai][bj][m][1][j] *= sa[4 + j] * __builtin_amdgcn_rcpf(fmaxf(sb[4 + j], 0.001953125f)); } } } EPI_ROWS_END
    }
    __device__ __forceinline__ void operator()(const f32x4 (&acc)[2][2][4][2], const Unit& u, int wr, int wc, int fr, int fq) const {
        const int col0 = u.pn * BM + wc * 64 + 16 * fq;
        EPI_ROWS_BEGIN { const size_t row = (size_t)(u.pm * BM + rt);
            const v4u gb = *(const v4u*)(G + row * 2048 + 1024 + col0); unsigned ow[4];
#pragma unroll
            for (int bj = 0; bj < 2; ++bj) { float sb[8]; dec8(bj ? (v2u){gb.z, gb.w} : (v2u){gb.x, gb.y}, sb); const float gs = 1.0f / (float)(1 << SH_G);
                f32x4 a = acc[ai][bj][m][0], b = acc[ai][bj][m][1];
#pragma unroll
                for (int j = 0; j < 4; ++j) { a[j] *= fmaxf(sb[j], 0.001953125f) * (gs * (float)(1 << SH_M)); b[j] *= fmaxf(sb[4 + j], 0.001953125f) * (gs * (float)(1 << SH_M)); }
                ow[2 * bj] = cvt4_fp8(a[0], a[1], a[2], a[3]); ow[2 * bj + 1] = cvt4_fp8(b[0], b[1], b[2], b[3]); }
            *(v4u*)(O + row * 1024 + col0) = (v4u){ow[0], ow[1], ow[2], ow[3]}; } EPI_ROWS_END
    }
};
struct EpiOut { static constexpr int MID_T = 0;
    const float* x; bf16* x1; const float* mod;
    __device__ __forceinline__ void operator()(const f32x4 (&acc)[2][2][4][2], const Unit& u, int wr, int wc, int fr, int fq) const {
        const int col0 = u.pn * BM + wc * WCS + 8 * fq; const int b = u.pm >> 4;
        f32x4 gt[2][2];
#pragma unroll
        for (int bj = 0; bj < 2; ++bj)
#pragma unroll
            for (int n = 0; n < 2; ++n) { const int c = 2048 + col0 + bj * BJS + 4 * n; gt[bj][n] = *(const f32x4*)(mod + b * 6144 + c); }
        EPI_ROWS_BEGIN { const size_t off = (size_t)(u.pm * BM + rt) * 1024 + col0;
#pragma unroll
            for (int bj = 0; bj < 2; ++bj) { const size_t o2 = off + bj * BJS;
                *(v4u*)(x1 + o2) = pack8(*(const f32x4*)(x + o2) + gt[bj][0] * acc[ai][bj][m][0], *(const f32x4*)(x + o2 + 4) + gt[bj][1] * acc[ai][bj][m][1]); } } EPI_ROWS_END
    }
};
__device__ __forceinline__ v4u swiglu8(const f32x4 g0, const f32x4 g1, const f32x4 u0, const f32x4 u1) {
    f32x4 a, b;
#pragma unroll
    for (int j = 0; j < 4; ++j) { a[j] = fsilu(g0[j]) * u0[j]; b[j] = fsilu(g1[j]) * u1[j]; }
    return pack8(a, b);
}
__device__ __forceinline__ v2u swiglu8_fp8(const f32x4 g0, const f32x4 g1, const f32x4 u0, const f32x4 u1) {
    const float sc = (float)(1 << SH_HMID); float a[4], b[4];
#pragma unroll
    for (int j = 0; j < 4; ++j) { a[j] = fsilu(g0[j]) * u0[j] * sc; b[j] = fsilu(g1[j]) * u1[j] * sc; }
    v2u w; w.x = cvt4_fp8(a[0], a[1], a[2], a[3]); w.y = cvt4_fp8(b[0], b[1], b[2], b[3]); return w;
}
struct EpiRS { static constexpr int MID_T = 0;
    float* logits; unsigned char* hsh;
    __device__ __forceinline__ void operator()(const f32x4 (&acc)[2][2][4][2], const Unit& u, int wr, int wc, int fr, int fq) const {
        if (u.pn == 0) {
            EPI_ROWS_BEGIN { float* rowp = logits + (size_t)(u.pm * BM + rt) * 256 + wc * WCS + 8 * fq;
#pragma unroll
                for (int bj = 0; bj < 2; ++bj)
#pragma unroll
                    for (int n = 0; n < 2; ++n) *(f32x4*)(rowp + bj * BJS + 4 * n) = acc[ai][bj][m][n]; } EPI_ROWS_END
        } else {
            const int hc = (u.pn - 1) * HALF + wc * WCS + 8 * fq;
            EPI_ROWS_BEGIN { *(v2u*)(hsh + (size_t)(u.pm * BM + rt) * 256 + hc) = swiglu8_fp8(acc[ai][0][m][0], acc[ai][0][m][1], acc[ai][1][m][0], acc[ai][1][m][1]); } EPI_ROWS_END
        }
    }
};
struct EpiRL { static constexpr int MID_T = 0;
    float* logits;
    __device__ __forceinline__ void operator()(const f32x4 (&acc)[2][2][4][2], const Unit& u, int wr, int wc, int fr, int fq) const {
        EPI_ROWS_BEGIN { float* rowp = logits + (size_t)(u.pm * BM + rt) * 256 + wc * WCS + 8 * fq;
#pragma unroll
            for (int bj = 0; bj < 2; ++bj)
#pragma unroll
                for (int n = 0; n < 2; ++n) *(f32x4*)(rowp + bj * BJS + 4 * n) = acc[ai][bj][m][n]; } EPI_ROWS_END
    }
};
struct EpiGU { static constexpr int MID_T = 0;
    unsigned char* hmid;
    __device__ __forceinline__ void operator()(const f32x4 (&acc)[2][2][4][2], const Unit& u, int wr, int wc, int fr, int fq) const {
        const int hc = u.pn * HALF + wc * 32 + 8 * fq;
        EPI_ROWS_BEGIN { if (rt < u.rows) *(v2u*)(hmid + (size_t)(u.row0 + rt) * 256 + hc) = swiglu8_fp8(acc[ai][0][m][0], acc[ai][0][m][1], acc[ai][1][m][0], acc[ai][1][m][1]); } EPI_ROWS_END
    }
};
struct EpiSD { static constexpr int MID_T = 0;
    bf16* ysh;
    __device__ __forceinline__ void operator()(const f32x4 (&acc)[2][2][4][2], const Unit& u, int wr, int wc, int fr, int fq) const {
        const int col0 = u.pn * BM + wc * WCS + 8 * fq;
        EPI_ROWS_BEGIN { bf16* rowp = ysh + (size_t)(u.pm * BM + rt) * 1024 + col0;
#pragma unroll
            for (int bj = 0; bj < 2; ++bj) *(v4u*)(rowp + bj * BJS) = pack8(acc[ai][bj][m][0], acc[ai][bj][m][1]); } EPI_ROWS_END
    }
};
struct EpiRD { static constexpr int MID_T = 0;
    unsigned char* yslot; const float* slot_w;
    __device__ __forceinline__ void operator()(const f32x4 (&acc)[2][2][4][2], const Unit& u, int wr, int wc, int fr, int fq) const {
        const int col0 = u.pn * BM + wc * 64 + 16 * fq;
        EPI_ROWS_BEGIN { if (rt < u.rows) { const float w = (float)(1 << SH_Y); unsigned char* rowp = yslot + (size_t)(u.row0 + rt) * 1024 + col0;
            const f32x4 a = acc[ai][0][m][0] * w, b = acc[ai][0][m][1] * w, c = acc[ai][1][m][0] * w, d = acc[ai][1][m][1] * w;
            *(v4u*)rowp = (v4u){cvt4_fp8(a[0], a[1], a[2], a[3]), cvt4_fp8(b[0], b[1], b[2], b[3]), cvt4_fp8(c[0], c[1], c[2], c[3]), cvt4_fp8(d[0], d[1], d[2], d[3])}; } } EPI_ROWS_END
    }
};
}

struct Args { const float* in[21]; float* out; unsigned char* ws; int ph_lo, ph_hi; };
struct Frame {
    LAS unsigned char* lds; volatile LAS unsigned* MISC; gu32* ctl;
    int tid, lane, wave, vcu, G, gw, NGW;
};

__device__ __forceinline__ void transpose_item(const float* W, int ldn, bf16* WT, int ldk, int k0, int n0, int drow0, LAS float* scr, int lane) {
#pragma unroll 8
    for (int i = 0; i < 32; ++i) { const int kk = 2 * i + (lane >> 5); scr[kk * 33 + (lane & 31)] = W[(size_t)(k0 + kk) * ldn + n0 + (lane & 31)]; }
    LDS_WAIT(); asm volatile("" ::: "memory");
    const int c = lane & 7;
#pragma unroll
    for (int j = 0; j < 4; ++j) { const int n = (lane >> 3) + 8 * j; const LAS float* s = scr + (8 * c) * 33 + n;
        v4u o; o.x = cvt_pk_bf16(s[0 * 33], s[1 * 33]); o.y = cvt_pk_bf16(s[2 * 33], s[3 * 33]); o.z = cvt_pk_bf16(s[4 * 33], s[5 * 33]); o.w = cvt_pk_bf16(s[6 * 33], s[7 * 33]);
        *(GAS v4u*)(WT + (size_t)(drow0 + n) * ldk + k0 + 8 * c) = o; }
    LDS_WAIT(); asm volatile("" ::: "memory");
}
struct ConvDesc { const float* W; unsigned char* WT; int ldn, ldk, k0, n0, drow0; float scale; };
__device__ __forceinline__ void ti_load(const ConvDesc& d, int lane, f32x4 (&r)[16]) {
#pragma unroll
    for (int i = 0; i < 16; ++i) r[i] = *(const f32x4*)(d.W + (size_t)(d.k0 + 8 * i + (lane >> 3)) * d.ldn + d.n0 + (lane & 7) * 4);
}
#ifndef TR8_MAP
#define TR8_MAP 0
#endif
typedef int v2i_t __attribute__((ext_vector_type(2)));
__device__ __forceinline__ void ti_store(const ConvDesc& d, const f32x4 (&r)[16], LAS float* scr, int lane) {
    LAS unsigned char* Tl = (LAS unsigned char*)scr; const float sc = d.scale;
#pragma unroll
    for (int i = 0; i < 16; ++i) *(LAS unsigned*)(Tl + (8 * i + (lane >> 3)) * 32 + (lane & 7) * 4) = cvt4_fp8(r[i][0] * sc, r[i][1] * sc, r[i][2] * sc, r[i][3] * sc);
    LDS_WAIT(); asm volatile("" ::: "memory");
    const int g = lane >> 4, l = lane & 15, nh = g & 1, ch = g >> 1, n = 16 * nh + l;
    const int rr = TR8_MAP ? (l & 7) : (l >> 1), cc = TR8_MAP ? (l >> 3) : (l & 1);
    LAS unsigned char* T2 = Tl + 4096;
#pragma unroll
    for (int j = 0; j < 4; ++j) { const int c = 4 * ch + j;
        const v2i_t lo = __builtin_amdgcn_ds_read_tr8_b64_v2i32((LAS v2i_t*)(Tl + (16 * c + rr) * 32 + 16 * nh + 8 * cc));
        const v2i_t hi = __builtin_amdgcn_ds_read_tr8_b64_v2i32((LAS v2i_t*)(Tl + (16 * c + 8 + rr) * 32 + 16 * nh + 8 * cc));
        *(LAS v4u*)(T2 + n * 144 + 16 * c) = (v4u){(unsigned)lo.x, (unsigned)lo.y, (unsigned)hi.x, (unsigned)hi.y}; }
    LDS_WAIT(); asm volatile("" ::: "memory");
#pragma unroll
    for (int j = 0; j < 4; ++j) { const int n2 = (lane >> 3) + 8 * j, c2 = lane & 7;
        *(GAS v4u*)(d.WT + (size_t)(d.drow0 + n2) * d.ldk + d.k0 + 16 * c2) = *(const LAS v4u*)(T2 + n2 * 144 + 16 * c2); }
    LDS_WAIT(); asm volatile("" ::: "memory");
}
__device__ __forceinline__ ConvDesc conv_desc_fp8(const float* W, int K, int N, unsigned char* WT, int mode, int rowbase, int item, float scale) {
    const int nblk = N / 32, kb = item / nblk, nb = item % nblk, k0 = 128 * kb, n0 = 32 * nb;
    int drow0 = rowbase + n0;
    if (mode) drow0 = rowbase + (n0 >> 5) * 64 + (mode - 1) * 32;
    return ConvDesc{W, WT, N, K, k0, n0, drow0, scale};
}
__device__ __forceinline__ void conv_item(const float* W, int K, int N, bf16* WT, int mode, int rowbase, int item, LAS float* scr, int lane) {
    const int nblk = N / 32, kb = item / nblk, nb = item % nblk, k0 = 64 * kb, n0 = 32 * nb;
    int drow0 = rowbase + n0;
    if (mode) drow0 = rowbase + (n0 >> 7) * 256 + (mode - 1) * 128 + (n0 & 127);
    transpose_item(W, N, WT, K, k0, n0, drow0, scr, lane);
}

__global__ void __launch_bounds__(NWAVES * 64, 2) mk_fwd(Args args) {
    extern __shared__ __attribute__((aligned(16))) unsigned char lds_raw[];
    Frame F;
    F.lds = (LAS unsigned char*)lds_raw;
    F.MISC = (volatile LAS unsigned*)(F.lds + MISC_OFF);
    F.tid = threadIdx.x; F.lane = F.tid & 63; F.wave = __builtin_amdgcn_readfirstlane(F.tid >> 6);
    F.G = gridDim.x; { const int bx = blockIdx.x; F.vcu = (F.G % 8 == 0) ? (bx % 8) * (F.G / 8) + bx / 8 : bx; }
    F.gw = F.vcu * NWAVES + F.wave; F.NGW = F.G * NWAVES;
    unsigned char* ws = args.ws;
    F.ctl = (gu32*)(ws + WS_CTL);
    const int tid = F.tid, lane = F.lane, wave = F.wave;
    LAS unsigned char* lds = F.lds;

#define X_IN (args.in[0])
#define cvec (args.in[1])
#define ada_w (args.in[2])
#define ada_b (args.in[3])
#define norm1_g (args.in[4])
#define w_in (args.in[5])
#define lb_logits (args.in[6])
#define hg_norm_g (args.in[7])
#define w_branch_a (args.in[8])
#define w_branch_b (args.in[9])
#define w_out (args.in[10])
#define norm2_g (args.in[11])
#define w_router (args.in[12])
#define router_bias (args.in[13])
#define w_exp_gate (args.in[14])
#define w_exp_up (args.in[15])
#define w_exp_down (args.in[16])
#define w_sh_gate (args.in[17])
#define w_sh_up (args.in[18])
#define w_sh_down (args.in[19])
#define final_g (args.in[20])
#define out (args.out)
#define WIN_T ((bf16*)(ws + WS_WIN_T))
#define WA_T ((bf16*)(ws + WS_WA_T))
#define WB_T ((bf16*)(ws + WS_WB_T))
#define WO_T ((bf16*)(ws + WS_WO_T))
#define RS_T ((bf16*)(ws + WS_RS_T))
#define WSD_T ((bf16*)(ws + WS_WSD_T))
#define WD ((bf16*)(ws + WS_WD))
#define WGU ((bf16*)(ws + WS_WGU))
#define PE ((int*)(ws + WS_PE))
#define PR ((int*)(ws + WS_PR))
#define PW ((float*)(ws + WS_PW))
#define SLOT_TOK ((int*)(ws + WS_SLOT_TOK))
#define SLOT_W ((float*)(ws + WS_SLOT_W))
#define TOK_SLOT ((int*)(ws + WS_TOK_SLOT))
#define LSE ((float*)(ws + WS_LSE))
#define QF ((bf16*)(ws + WS_QF))
#define OA ((bf16*)(ws + WS_OA))
#define OG ((bf16*)(ws + WS_OG))
#define MERGED ((bf16*)(ws + WS_MERGED))
#define HMID ((bf16*)(ws + WS_HMID))
#define YSH (((unsigned char*)(ws + WS_YSLOT)) + (size_t)NSLOTP * 1024)
#define AQKV ((bf16*)(ws + WS_AQKV))
#define GAB ((bf16*)(ws + WS_GAB))
#define XN ((bf16*)(ws + WS_XN))
#define YA ((bf16*)(ws + WS_YA))
#define YB ((bf16*)(ws + WS_YB))
#define H2 ((bf16*)(ws + WS_H2))
#define LOGITS ((float*)(ws + WS_LOGITS))
#define YSLOT ((bf16*)(ws + WS_YSLOT))
#define MOD ((float*)(ws + WS_MOD))
#define HISTG ((unsigned*)(ws + WS_HISTG))
#define ATTQ (((unsigned*)(ws + WS_CTL)) + CW_ATTQ)
    for (int u = tid; u < 64; u += NWAVES * 64) ((LAS unsigned*)(lds + MISC_OFF))[u] = 0u;
    __syncthreads();
    XcdBarrier bar = xcd_barrier_post((unsigned*)(F.ctl + CW_BAR), F.MISC + 8);
    const int lo = args.ph_lo, hi = args.ph_hi;
#ifndef PHMASK
#define PHMASK 0x3fff
#endif
#define IN(k) (((PHMASK >> (k)) & 1) && lo <= (k) && (k) < hi)
#define SEAM(k) do { if (IN(k) && IN((k) + 1)) xcd_barrier(bar); } while (0)
#ifndef ALIGN_P2
#define ALIGN_P2 true
#endif
#ifndef ALIGN_P12
#define ALIGN_P12 true
#endif
#ifndef ALIGN_DEFAULT
#define ALIGN_DEFAULT true
#endif
#ifndef REPMASK
#define REPMASK 0
#endif
#ifndef CONV2_ITEMS
#define CONV2_ITEMS 42000
#endif
#ifndef DBG_H1_ST
#define DBG_H1_ST 1
#endif
#ifndef DBG_ATT_NOLOAD
#define DBG_ATT_NOLOAD 0
#endif
#ifndef TKI
#define TKI 8
#endif
#ifndef CONV11_ITEMS
#define CONV11_ITEMS 7000
#endif
#ifndef CONV11_MINWG
#define CONV11_MINWG 16
#endif
#ifndef P2_GEMM_WGS
#define P2_GEMM_WGS 178
#endif
#define REPS(k) (((REPMASK >> (k)) & 1) ? 2 : 1)
#define REP_BEGIN(k) _Pragma("unroll") for (int rep = 0; rep < REPS(k); ++rep) {
#define REP_END(k) if (rep + 1 < REPS(k)) xcd_barrier(bar); }

        constexpr int I_IN = 8 * 200, I_A = 4 * 32, I_B = 2 * 32, I_O = 8 * 32, I_SD = 2 * 32, I_E = 8 * 8, I_ED = 2 * 32;
        constexpr int NSMALL = I_IN + I_A + I_B + I_O + I_SD;
        constexpr int NITEMS = NSMALL + 2 * (NEXP + 1) * I_E + NEXP * I_ED;
    constexpr int NCONV2 = CONV2_ITEMS;
    const int NGB = (F.G == 256 && NCONV2 > 0) ? P2_GEMM_WGS : F.G;
    constexpr int NCONV11 = CONV11_ITEMS;
    static_assert(NITEMS - NCONV2 - NCONV11 >= I_IN, "the input-projection weights must be converted in P0");
    const int nitems0 = (NGB < F.G) ? NITEMS - NCONV2 - NCONV11 : NITEMS;
    auto conv_desc = [&](int it) __attribute__((always_inline)) -> ConvDesc {
            int r = it;
            if (r < I_IN) return conv_desc_fp8(w_in, 1024, NIN, (unsigned char*)WIN_T, 0, 0, r, (float)(1 << SH_WGU)); r -= I_IN;
            if (r < I_A) { const int kb = r / 32, nb = r % 32; return ConvDesc{w_branch_a, (unsigned char*)WA_T, 1024, 768, 128 * kb, 32 * nb, 32 * nb, (float)(1 << SH_WAB)}; } r -= I_A;
            if (r < I_B) { const int kb = r / 32, nb = r % 32; return ConvDesc{w_branch_b, (unsigned char*)WA_T + 512, 1024, 768, 128 * kb, 32 * nb, 32 * nb, (float)(1 << SH_WAB)}; } r -= I_B;
            if (r < I_O) return conv_desc_fp8(w_out, 1024, 1024, (unsigned char*)WO_T, 0, 0, r, (float)(1 << SH_WGU)); r -= I_O;
            if (r < I_SD) return conv_desc_fp8(w_sh_down, 256, 1024, (unsigned char*)WD, 0, NEXP * 1024, r, (float)(1 << SH_WD)); r -= I_SD;
            if (r < 2 * (NEXP + 1) * I_E) { const int seg = r / ((NEXP + 1) * I_E), rr = r % ((NEXP + 1) * I_E), e = rr / I_E, ii = rr % I_E;
                const float* src = (seg == 0) ? (e < NEXP ? w_exp_gate + (size_t)e * 1024 * 256 : w_sh_gate) : (e < NEXP ? w_exp_up + (size_t)e * 1024 * 256 : w_sh_up);
                return conv_desc_fp8(src, 1024, 256, (unsigned char*)WGU, seg + 1, e * 512, ii, (float)(1 << SH_WGU)); }
            r -= 2 * (NEXP + 1) * I_E; const int e = r / I_ED, ii = r % I_ED;
            return conv_desc_fp8(w_exp_down + (size_t)e * 256 * 1024, 256, 1024, (unsigned char*)WD, 0, e * 1024, ii, (float)(1 << SH_WD));
    };
    auto conv_run = [&](int first, int end, int stride, LAS float* scr) __attribute__((always_inline)) {
        int it = first; if (it >= end) return;
        ConvDesc d = conv_desc(it); f32x4 r[16]; ti_load(d, lane, r);
        for (;;) {
            const int nx = it + stride; const bool more = nx < end;
            ConvDesc dn = d; f32x4 rn[16];
            if (more) { dn = conv_desc(nx); ti_load(dn, lane, rn); }
            ti_store(d, r, scr, lane);
            if (!more) break;
            d = dn; it = nx;
#pragma unroll
            for (int i = 0; i < 16; ++i) r[i] = rn[i];
        }
    };

    if (IN(0)) { REP_BEGIN(0)
        {
            LAS float* sc = (LAS float*)lds; LAS float* red = (LAS float*)(lds + 32768);
            for (int i = tid; i < NB * D; i += NWAVES * 64) sc[i] = fsilu(cvec[i]);
            __syncthreads();
            _Pragma("unroll") for (int sr = 0; sr < (((REPMASK >> 19) & 1) ? 2 : 1); ++sr)
            for (int cbk = blockIdx.x; cbk < 256; cbk += F.G) {
                const int j0 = cbk * 24, kg = tid >> 3, cc = tid & 7;
                float a8[8][3];
#pragma unroll
                for (int b = 0; b < 8; ++b) { a8[b][0] = 0.f; a8[b][1] = 0.f; a8[b][2] = 0.f; }
                for (int r = 0; r < 16; ++r) { const int i = kg * 16 + r; const float* wp = ada_w + (size_t)i * 6144 + j0 + 3 * cc; const float w0 = wp[0], w1 = wp[1], w2 = wp[2];
#pragma unroll
                    for (int b = 0; b < 8; ++b) { const float sv = sc[b * 1024 + i]; a8[b][0] += sv * w0; a8[b][1] += sv * w1; a8[b][2] += sv * w2; } }
#pragma unroll
                for (int b = 0; b < 8; ++b) { red[(kg * 8 + b) * 24 + 3 * cc + 0] = a8[b][0]; red[(kg * 8 + b) * 24 + 3 * cc + 1] = a8[b][1]; red[(kg * 8 + b) * 24 + 3 * cc + 2] = a8[b][2]; }
                __syncthreads();
                if (tid < 192) { const int b = tid / 24, col = tid % 24; float sum = ada_b[j0 + col];
                    for (int g = 0; g < 64; ++g) sum += red[(g * 8 + b) * 24 + col];
                    MOD[b * 6144 + j0 + col] = sum; }
                __syncthreads();
            }
        }
        LAS float* scr = (LAS float*)(lds + wave * 16384);
        conv_run(F.gw, nitems0, F.NGW, scr);
    REP_END(0) }
    SEAM(0);

    if (IN(1)) { REP_BEGIN(1)
        for (int m0 = F.gw * 16; m0 < T; m0 += F.NGW * 16) {
            const int b = m0 >> 12;
            f32x4 mul[4], add[4];
#pragma unroll
            for (int j = 0; j < 4; ++j) { const int c = 4 * lane + 256 * j;
                const f32x4 s1 = *(const f32x4*)(MOD + b * 6144 + 1024 + c);
                mul[j] = *(const f32x4*)(norm1_g + c) * (s1 + 1.0f);
                add[j] = *(const f32x4*)(MOD + b * 6144 + c); }
            for (int m = m0; m < m0 + 16; ++m) {
                const GAS f32x4* xr = (const GAS f32x4*)(X_IN + (size_t)m * D) + lane;
                f32x4 v[4]; float s = 0.f;
#pragma unroll
                for (int j = 0; j < 4; ++j) { v[j] = xr[64 * j]; s += (v[j].x * v[j].x + v[j].y * v[j].y) + (v[j].z * v[j].z + v[j].w * v[j].w); }
                const float rstd = 1.0f / sqrtf(wave_sum(s) * (1.f / D) + RMS_EPS);
                GAS unsigned* o4 = (GAS unsigned*)((unsigned char*)XN + (size_t)m * D) + lane;
#pragma unroll
                for (int j = 0; j < 4; ++j) { const f32x4 y = v[j] * rstd * mul[j] + add[j]; const float sx = (float)(1 << SH_X); o4[64 * j] = cvt4_fp8(y.x * sx, y.y * sx, y.z * sx, y.w * sx); }
            }
        }
        for (int it = blockIdx.x; it < 256; it += F.G) {
            const int b = it >> 5, e = tid & 255, dh = tid >> 8, d0 = 32 * (it & 31) + 16 * dh;
            float wv[16];
#pragma unroll
            for (int j = 0; j < 16; ++j) wv[j] = w_router[(size_t)(d0 + j) * 256 + e];
            float part = 0.f; unsigned pk[8];
#pragma unroll
            for (int j = 0; j < 16; j += 2) {
                const float a0 = norm2_g[d0 + j] * (1.0f + MOD[b * 6144 + 4096 + d0 + j]), a1 = norm2_g[d0 + j + 1] * (1.0f + MOD[b * 6144 + 4096 + d0 + j + 1]);
                part += MOD[b * 6144 + 3072 + d0 + j] * wv[j]; part += MOD[b * 6144 + 3072 + d0 + j + 1] * wv[j + 1];
                pk[j >> 1] = cvt_pk_bf16(wv[j] * a0, wv[j + 1] * a1); }
            GAS v4u* wp = (GAS v4u*)((bf16*)(ws + WS_WRB) + ((size_t)(b * 256 + e) * 1024 + d0));
            v4u o0, o1; o0.x = pk[0]; o0.y = pk[1]; o0.z = pk[2]; o0.w = pk[3]; o1.x = pk[4]; o1.y = pk[5]; o1.z = pk[6]; o1.w = pk[7]; wp[0] = o0; wp[1] = o1;
            ((float*)(ws + WS_PART))[(size_t)(b * 64 + (it & 31) * 2 + dh) * 256 + e] = part;
        }
    REP_END(1) }
    SEAM(1);

    if (IN(2)) { REP_BEGIN(2)
        if ((int)blockIdx.x < NGB) {
            pg8::DenseSched S; S.init(T, NIN, 1024, NGB, (int)blockIdx.x, WIN_T);
            pg8::EpiWin E{(unsigned char*)QF, (unsigned char*)AQKV, (unsigned char*)GAB, (unsigned char*)GAB + (size_t)T * 2048, 0};
            pg8::gemm_phase<ALIGN_P2, true, pg8::EpiWin, pg8::DenseSched, 2>(lds, (const char*)XN, 1024, S, E, SC_WGU, SC_X);
        } else {
            LAS float* scr2 = (LAS float*)(lds + wave * 16384);
            conv_run(nitems0 + ((int)blockIdx.x - NGB) * NWAVES + wave, NITEMS - NCONV11, (F.G - NGB) * NWAVES, scr2);
        }
    REP_END(2) }
    SEAM(2);

    if (IN(3)) { REP_BEGIN(3)
        const int fr = lane & 15, fq = lane >> 4;
        bf16* QTB = (bf16*)(ws + WS_QTB); unsigned char* UT = (unsigned char*)(ws + WS_UT); float* DKB = (float*)(ws + WS_DK);
        {
            constexpr int NH1 = NB * 4 * 64, NATT = NB * 3 * 4 * 32;
            {
                const int kq = tid & 31, rg = tid >> 5, vrow = tid >> 3, v16 = (tid & 7) * 16;
                unsigned rq[4], rf[4]; v4u rv0;
                const unsigned char* QF8 = (const unsigned char*)QF;
#define H1_LOAD(w) do { const int b_ = (w) >> 8, h_ = ((w) >> 6) & 3, c_ = (w) & 63; const size_t r0_ = (size_t)(b_ * SEQ + c_ * 64); \
                _Pragma("unroll") for (int rr = 0; rr < 4; ++rr) { const size_t ro = (r0_ + rg * 4 + rr) * 1536 + h_ * 128 + 4 * kq; rq[rr] = *(const unsigned*)(QF8 + ro); rf[rr] = *(const unsigned*)(QF8 + ro + 512); } \
                rv0 = *(const v4u*)(QF8 + (r0_ + vrow) * 1536 + 1024 + h_ * 128 + v16); } while (0)
                if ((int)blockIdx.x < NH1) { H1_LOAD((int)blockIdx.x); }
                _Pragma("unroll") for (int sr = 0; sr < (((REPMASK >> 16) & 1) ? 2 : 1); ++sr) { if (sr) { H1_LOAD((int)blockIdx.x); }
                int hprev = -1; float lbv[4] = {0.f, 0.f, 0.f, 0.f};
                for (int wi = blockIdx.x, j1 = 0; wi < NH1; wi += F.G, ++j1) {
                    const int b = wi >> 8, h = (wi >> 6) & 3, c = wi & 63;
                    constexpr int QT_S = 272, KH_S = 144, VR_S = 288;
                    LAS unsigned char* Qt = lds;
                    LAS unsigned char* Kt = lds + 17408;
                    LAS unsigned char* Kh = lds + 34816;
                    LAS unsigned char* Vr = lds + 53248;
                    LAS unsigned char* Asc = lds + 71680;
                    LAS float* btot = (LAS float*)(lds + 80896);
                    if (h != hprev) { hprev = h;
                        const f32x4 l0 = *(const f32x4*)(lb_logits + h * 128 + 4 * kq), l1 = *(const f32x4*)(lb_logits + 512 + h * 128 + 4 * kq);
#pragma unroll
                        for (int ch = 0; ch < 4; ++ch) lbv[ch] = 1.0f / (1.0f + __expf(l1[ch] - l0[ch])); }
                    const size_t row0 = (size_t)(b * SEQ + c * 64);
                    const float rq_ = 1.0f / (float)(1 << SH_Q);
                    LBAR();
                    for (int i = tid; i < 9216 / 4; i += NWAVES * 64) ((LAS unsigned*)Asc)[i] = 0u;
                    float kk[4][4], bl[4][4]; float run[4] = {0.f, 0.f, 0.f, 0.f};
#pragma unroll
                    for (int rr = 0; rr < 4; ++rr) { const f32x2_t lo = __builtin_amdgcn_cvt_pk_f32_fp8((int)rf[rr], false), hi = __builtin_amdgcn_cvt_pk_f32_fp8((int)rf[rr], true); const float fv[4] = {lo[0], lo[1], hi[0], hi[1]};
#pragma unroll
                        for (int ch = 0; ch < 4; ++ch) { const float sg = fsigmoid(fv[ch] * rq_); const float f = lbv[ch] + (1.0f - lbv[ch]) * sg; run[ch] += __logf(f); bl[rr][ch] = run[ch]; kk[rr][ch] = (1.0f - lbv[ch]) * (1.0f - sg); } }
                    *(LAS f32x4*)(btot + rg * 128 + 4 * kq) = (f32x4){run[0], run[1], run[2], run[3]};
                    {   const unsigned vw[4] = {rv0.x, rv0.y, rv0.z, rv0.w}; unsigned w8[8];
#pragma unroll
                        for (int j = 0; j < 4; ++j) { const f32x2_t lo = __builtin_amdgcn_cvt_pk_f32_fp8((int)vw[j], false), hi = __builtin_amdgcn_cvt_pk_f32_fp8((int)vw[j], true); w8[2 * j] = cvt_pk_bf16(lo[0] * rq_, lo[1] * rq_); w8[2 * j + 1] = cvt_pk_bf16(hi[0] * rq_, hi[1] * rq_); }
                        *(LAS v4u*)(Vr + vrow * VR_S + v16 * 2) = (v4u){w8[0], w8[1], w8[2], w8[3]}; *(LAS v4u*)(Vr + vrow * VR_S + v16 * 2 + 16) = (v4u){w8[4], w8[5], w8[6], w8[7]}; }
                    LBAR();
                    float pre[4] = {0.f, 0.f, 0.f, 0.f}, bend[4] = {0.f, 0.f, 0.f, 0.f};
#pragma unroll
                    for (int g = 0; g < 16; ++g) { const f32x4 tg = *(const LAS f32x4*)(btot + g * 128 + 4 * kq);
#pragma unroll
                        for (int ch = 0; ch < 4; ++ch) { if (g < rg) pre[ch] += tg[ch]; bend[ch] += tg[ch]; } }
#pragma unroll
                    for (int rr = 0; rr < 4; ++rr) { const f32x2_t lo = __builtin_amdgcn_cvt_pk_f32_fp8((int)rq[rr], false), hi = __builtin_amdgcn_cvt_pk_f32_fp8((int)rq[rr], true); const float qf4[4] = {lo[0], lo[1], hi[0], hi[1]};
                        float qv[4], kv[4], kh[4];
#pragma unroll
                        for (int ch = 0; ch < 4; ++ch) { const float bb = pre[ch] + bl[rr][ch]; qv[ch] = qf4[ch] * rq_ * __expf(bb); kv[ch] = kk[rr][ch] * __expf(fminf(-bb, 80.f)); kh[ch] = kk[rr][ch] * __expf(bend[ch] - bb); }
                        *(LAS v2u*)(Qt + (rg * 4 + rr) * QT_S + kq * 8) = (v2u){cvt_pk_bf16(qv[0], qv[1]), cvt_pk_bf16(qv[2], qv[3])};
                        *(LAS v2u*)(Kt + (rg * 4 + rr) * QT_S + kq * 8) = (v2u){cvt_pk_bf16(kv[0], kv[1]), cvt_pk_bf16(kv[2], kv[3])};
                        *(LAS v2u*)(Kh + (rg * 4 + rr) * VR_S + kq * 8) = (v2u){cvt_pk_bf16(kh[0], kh[1]), cvt_pk_bf16(kh[2], kh[3])}; }
                    if (rg == 0) *(f32x4*)(DKB + (size_t)wi * 128 + 4 * kq) = (f32x4){__expf(bend[0]), __expf(bend[1]), __expf(bend[2]), __expf(bend[3])};
                    { const int wn = wi + (int)F.G; if (wn < NH1) { H1_LOAD(wn); } }
                    LBAR();
                    for (int idx = wave; idx < 10; idx += 8) {
                        const int ti = idx < 1 ? 0 : idx < 3 ? 1 : idx < 6 ? 2 : 3; const int si = idx - (ti * (ti + 1)) / 2;
                        f32x4 a4 = (f32x4){0.f, 0.f, 0.f, 0.f};
#pragma unroll
                        for (int ks = 0; ks < 4; ++ks) { const bf16x8 af = *(const LAS bf16x8*)(Qt + (16 * ti + fr) * QT_S + (32 * ks + 8 * fq) * 2); const bf16x8 bfr = *(const LAS bf16x8*)(Kt + (16 * si + fr) * QT_S + (32 * ks + 8 * fq) * 2);
                            a4 = __builtin_amdgcn_mfma_f32_16x16x32_bf16(af, bfr, a4, 0, 0, 0); }
#pragma unroll
                        for (int i = 0; i < 4; ++i) { const int tt = 16 * ti + 4 * fq + i, ss = 16 * si + fr; const float v = (ss <= tt) ? a4[i] : 0.f;
                            *(LAS unsigned short*)(Asc + tt * KH_S + ss * 2) = (unsigned short)(cvt_pk_bf16(v, 0.f) & 0xffff); }
                    }
#pragma unroll
                    for (int j = 0; j < 2; ++j) { const int p = tid + 512 * j, prow = p >> 4, c16 = p & 15; if (DBG_H1_ST || sr) *(v4u*)(QTB + (row0 + prow) * 512 + h * 128 + c16 * 8) = *(const LAS v4u*)(Qt + prow * QT_S + c16 * 16); }
                    bf16x8 vf[2];
#pragma unroll
                    for (int ks = 0; ks < 2; ++ks) {
                        const v2u a0 = __builtin_bit_cast(v2u, __builtin_amdgcn_ds_read_tr16_b64_v4i16((LAS v4i16_t*)(Vr + (32 * ks + 8 * fq + (fr >> 2)) * VR_S + (16 * wave + 4 * (fr & 3)) * 2)));
                        const v2u a1 = __builtin_bit_cast(v2u, __builtin_amdgcn_ds_read_tr16_b64_v4i16((LAS v4i16_t*)(Vr + (32 * ks + 8 * fq + 4 + (fr >> 2)) * VR_S + (16 * wave + 4 * (fr & 3)) * 2)));
                        vf[ks] = __builtin_bit_cast(bf16x8, (v4u){a0.x, a0.y, a1.x, a1.y}); }
                    {   unsigned uw[8];
#pragma unroll
                        for (int kt = 0; kt < 8; ++kt) { f32x4 u4 = (f32x4){0.f, 0.f, 0.f, 0.f};
#pragma unroll
                            for (int ks = 0; ks < 2; ++ks) {
                                const v2u a0 = __builtin_bit_cast(v2u, __builtin_amdgcn_ds_read_tr16_b64_v4i16((LAS v4i16_t*)(Kh + (32 * ks + 8 * fq + (fr >> 2)) * VR_S + (64 * (kt >> 2) + 16 * (fr & 3) + 4 * (kt & 3)) * 2)));
                                const v2u a1 = __builtin_bit_cast(v2u, __builtin_amdgcn_ds_read_tr16_b64_v4i16((LAS v4i16_t*)(Kh + (32 * ks + 8 * fq + 4 + (fr >> 2)) * VR_S + (64 * (kt >> 2) + 16 * (fr & 3) + 4 * (kt & 3)) * 2)));
                                u4 = __builtin_amdgcn_mfma_f32_16x16x32_bf16(__builtin_bit_cast(bf16x8, (v4u){a0.x, a0.y, a1.x, a1.y}), vf[ks], u4, 0, 0, 0); }
                            const float su = (float)(1 << SH_U); uw[kt] = cvt4_fp8(u4[0] * su, u4[1] * su, u4[2] * su, u4[3] * su); }
                        unsigned char* up = UT + ((size_t)wi * 128 + 16 * wave + fr) * 128 + 16 * fq;
                        if (DBG_H1_ST || sr) { *(v4u*)up = (v4u){uw[0], uw[1], uw[2], uw[3]}; *(v4u*)(up + 64) = (v4u){uw[4], uw[5], uw[6], uw[7]}; } }
                    LBAR();
                    {   const int tt = wave & 3, vh = wave >> 2; bf16x8 af[2]; unsigned ow[8];
#pragma unroll
                        for (int ks = 0; ks < 2; ++ks) af[ks] = *(const LAS bf16x8*)(Asc + (16 * tt + fr) * KH_S + (32 * ks + 8 * fq) * 2);
#pragma unroll
                        for (int vt = 0; vt < 4; ++vt) { f32x4 o4 = (f32x4){0.f, 0.f, 0.f, 0.f};
#pragma unroll
                            for (int ks = 0; ks < 2; ++ks) {
                                const v2u a0 = __builtin_bit_cast(v2u, __builtin_amdgcn_ds_read_tr16_b64_v4i16((LAS v4i16_t*)(Vr + (32 * ks + 8 * fq + (fr >> 2)) * VR_S + (64 * vh + 32 * (vt >> 1) + 8 * (fr & 3) + 4 * (vt & 1)) * 2)));
                                const v2u a1 = __builtin_bit_cast(v2u, __builtin_amdgcn_ds_read_tr16_b64_v4i16((LAS v4i16_t*)(Vr + (32 * ks + 8 * fq + 4 + (fr >> 2)) * VR_S + (64 * vh + 32 * (vt >> 1) + 8 * (fr & 3) + 4 * (vt & 1)) * 2)));
                                o4 = __builtin_amdgcn_mfma_f32_16x16x32_bf16(__builtin_bit_cast(bf16x8, (v4u){a0.x, a0.y, a1.x, a1.y}), af[ks], o4, 0, 0, 0); }
                            ow[2 * vt] = cvt_pk_bf16(o4[0], o4[1]); ow[2 * vt + 1] = cvt_pk_bf16(o4[2], o4[3]); }
                        bf16* op = OA + (row0 + 16 * tt + fr) * 512 + h * 128 + 64 * vh + 8 * fq;
                        if (DBG_H1_ST || sr) { *(v4u*)op = (v4u){ow[0], ow[1], ow[2], ow[3]}; *(v4u*)(op + 32) = (v4u){ow[4], ow[5], ow[6], ow[7]}; } }
                } }
#undef H1_LOAD
            }
            {
                constexpr int K_S = 144, VT_S = 528;
                LAS unsigned char* Kl = lds;
                LAS unsigned char* Vt = lds + 36864;
                v4u kx[2], vx[2]; v2u qn[2];
#define ATT_DECODE(un) const int rn = (un) & 31, hh = ((un) >> 5) & 3, g = ((un) >> 7) % 3, b = (un) / 384; \
                const int dl = g == 0 ? 0 : g == 1 ? 2 : 4, d = 1 << dl, nbk = 32 >> dl, r = rn / nbk, n = rn % nbk; \
                const unsigned char* base = (const unsigned char*)AQKV + (size_t)(b * SEQ) * 2304 + (g * 4 + hh) * 64; const int qi = 16 * wave + fr; const int tq = (n * 128 + qi) * d + r;
#define ATT_LOAD(un) do { ATT_DECODE(un)       \
                _Pragma("unroll") for (int j = 0; j < 2; ++j) { const int p = tid + 512 * j, key = p >> 2, c16 = p & 3; const int l = (n - 1) * 128 + key; \
                    kx[j] = (v4u){0u, 0u, 0u, 0u}; vx[j] = kx[j]; \
                    if (l >= 0) { const unsigned char* rowp = base + (size_t)(l * d + r) * 2304 + c16 * 16; kx[j] = *(const v4u*)(rowp + 768); vx[j] = *(const v4u*)(rowp + 1536); } } \
                _Pragma("unroll") for (int ks = 0; ks < 2; ++ks) qn[ks] = *(const v2u*)(base + (size_t)tq * 2304 + 32 * ks + 8 * fq); } while (0)
                if (F.vcu < NATT) { ATT_LOAD(F.vcu); }
                _Pragma("unroll") for (int sr = 0; sr < (((REPMASK >> 17) & 1) ? 2 : 1); ++sr) { if (sr) { ATT_LOAD(F.vcu); }
                for (int un = F.vcu; un < NATT; un += F.G) {
                    ATT_DECODE(un)
                    LBAR();
#pragma unroll
                    for (int j = 0; j < 2; ++j) { const int p = tid + 512 * j, key = p >> 2, c16 = p & 3;
                        *(LAS v4u*)(Kl + key * K_S + c16 * 32) = f8x8_to_bf16(kx[j].x, kx[j].y); *(LAS v4u*)(Kl + key * K_S + c16 * 32 + 16) = f8x8_to_bf16(kx[j].z, kx[j].w);
                        *(LAS v4u*)(Vt + key * K_S + c16 * 32) = f8x8_to_bf16(vx[j].x, vx[j].y); *(LAS v4u*)(Vt + key * K_S + c16 * 32 + 16) = f8x8_to_bf16(vx[j].z, vx[j].w); }
                    bf16x8 qf[2]; qf[0] = __builtin_bit_cast(bf16x8, f8x8_to_bf16(qn[0].x, qn[0].y)); qf[1] = __builtin_bit_cast(bf16x8, f8x8_to_bf16(qn[1].x, qn[1].y));
                    if (un + (int)F.G < NATT && !(DBG_ATT_NOLOAD && sr)) { ATT_LOAD(un + (int)F.G); }
                    LBAR();
                    float p[10][4]; float mx = -INFINITY;
#pragma unroll
                    for (int jt = 0; jt < 10; ++jt) { const int kt = (wave + jt) < 15 ? (wave + jt) : 15; f32x4 s4 = (f32x4){0.f, 0.f, 0.f, 0.f};
#pragma unroll
                        for (int ks = 0; ks < 2; ++ks) { const bf16x8 af = *(const LAS bf16x8*)(Kl + (16 * kt + fr) * K_S + (32 * ks + 8 * fq) * 2); s4 = __builtin_amdgcn_mfma_f32_16x16x32_bf16(af, qf[ks], s4, 0, 0, 0); }
#pragma unroll
                        for (int i = 0; i < 4; ++i) { const int kj = 16 * (wave + jt) + 4 * fq + i; const bool ok = (kj >= qi) && (kj <= qi + 128) && (n > 0 || kj >= 128);
                            const float sv = ok ? s4[i] * (0.125f / (float)(1 << (2 * SH_Q))) : -INFINITY; p[jt][i] = sv; mx = fmaxf(mx, sv); } }
                    mx = fmaxf(mx, __shfl_xor(mx, 16)); mx = fmaxf(mx, __shfl_xor(mx, 32));
                    float ls = 0.f;
#pragma unroll
                    for (int jt = 0; jt < 10; ++jt)
#pragma unroll
                        for (int i = 0; i < 4; ++i) { const float e = __expf(p[jt][i] - mx); p[jt][i] = e; ls += e; }
                    ls += __shfl_xor(ls, 16); ls += __shfl_xor(ls, 32);
                    f32x4 o4[4];
#pragma unroll
                    for (int dt = 0; dt < 4; ++dt) o4[dt] = (f32x4){0.f, 0.f, 0.f, 0.f};
#pragma unroll
                    for (int pp = 0; pp < 5; ++pp) { const int k0 = (wave + 2 * pp) < 15 ? (wave + 2 * pp) : 15, k1 = (wave + 2 * pp + 1) < 15 ? (wave + 2 * pp + 1) : 15;
                        v4u pb; pb.x = cvt_pk_bf16(p[2 * pp][0], p[2 * pp][1]); pb.y = cvt_pk_bf16(p[2 * pp][2], p[2 * pp][3]); pb.z = cvt_pk_bf16(p[2 * pp + 1][0], p[2 * pp + 1][1]); pb.w = cvt_pk_bf16(p[2 * pp + 1][2], p[2 * pp + 1][3]);
                        const bf16x8 pf = __builtin_bit_cast(bf16x8, pb);
#pragma unroll
                        for (int dt = 0; dt < 4; ++dt) {
                            const v2u a0 = __builtin_bit_cast(v2u, __builtin_amdgcn_ds_read_tr16_b64_v4i16((LAS v4i16_t*)(Vt + (16 * k0 + 4 * fq + (fr >> 2)) * K_S + (32 * (dt >> 1) + 8 * (fr & 3) + 4 * (dt & 1)) * 2)));
                            const v2u a1 = __builtin_bit_cast(v2u, __builtin_amdgcn_ds_read_tr16_b64_v4i16((LAS v4i16_t*)(Vt + (16 * k1 + 4 * fq + (fr >> 2)) * K_S + (32 * (dt >> 1) + 8 * (fr & 3) + 4 * (dt & 1)) * 2)));
                            const v4u av = (v4u){a0.x, a0.y, a1.x, a1.y};
                            o4[dt] = __builtin_amdgcn_mfma_f32_16x16x32_bf16(__builtin_bit_cast(bf16x8, av), pf, o4[dt], 0, 0, 0); } }
                    const float inv = 1.0f / (ls * (float)(1 << SH_Q)); const size_t trow = (size_t)(b * SEQ + tq);
                    bf16* og = OG + ((size_t)g * T + trow) * 256 + hh * 64 + 8 * fq;
                    { unsigned ow[8];
#pragma unroll
                      for (int dt = 0; dt < 4; ++dt) { ow[2 * dt] = cvt_pk_bf16(o4[dt][0] * inv, o4[dt][1] * inv); ow[2 * dt + 1] = cvt_pk_bf16(o4[dt][2] * inv, o4[dt][3] * inv); }
                      *(v4u*)og = (v4u){ow[0], ow[1], ow[2], ow[3]}; *(v4u*)(og + 32) = (v4u){ow[4], ow[5], ow[6], ow[7]}; }
                    if (fq == 0) LSE[((size_t)(g * 4 + hh) * NB + b) * SEQ + r * (SEQ >> dl) + n * 128 + qi] = mx + __logf(ls);
                } }
#undef ATT_LOAD
#undef ATT_DECODE
            }
        }
        xcd_barrier(bar);
        for (int vb = blockIdx.x; vb < 256; vb += F.G) {
            const int bh = vb >> 3, eg = (vb & 7) * 512 + tid, v = eg >> 5, kq = eg & 31;
            LAS float* Dl = (LAS float*)lds;
            __syncthreads();
            for (int i = tid; i < 64 * 128; i += NWAVES * 64) Dl[i] = DKB[(size_t)bh * 64 * 128 + i];
            unsigned char* up = UT + ((size_t)bh * 64 * 128 + v) * 128 + kq * 4;
            __syncthreads();
            float S0 = 0.f, S1 = 0.f, S2 = 0.f, S3 = 0.f; const float su = (float)(1 << SH_U), ru = 1.0f / su;
            for (int c0 = 0; c0 < 64; c0 += 32) {
                unsigned u[32];
                { const unsigned char* lp = up + (size_t)c0 * 128 * 128;
#pragma unroll
                  for (int c = 0; c < 32; ++c) { u[c] = *(const unsigned*)lp; lp += 128 * 128; asm volatile("" : "+v"(lp)); } }
                unsigned char* sp = up + (size_t)c0 * 128 * 128;
#pragma unroll
                for (int c = 0; c < 32; ++c) { const f32x4 d = *(const LAS f32x4*)(Dl + (c0 + c) * 128 + kq * 4);
                    *(unsigned*)sp = cvt4_fp8(S0 * su, S1 * su, S2 * su, S3 * su); sp += 128 * 128; asm volatile("" : "+v"(sp));
                    const f32x2_t ua = __builtin_amdgcn_cvt_pk_f32_fp8((int)u[c], false), ub = __builtin_amdgcn_cvt_pk_f32_fp8((int)u[c], true);
                    S0 = d[0] * S0 + ua[0] * ru; S1 = d[1] * S1 + ua[1] * ru; S2 = d[2] * S2 + ub[0] * ru; S3 = d[3] * S3 + ub[1] * ru; }
            }
        }
        for (int m0 = F.gw * 16; m0 < T; m0 += F.NGW * 16)
            for (int m = m0; m < m0 + 16; ++m) {
                const int hh = lane >> 4;
                const int bb = m >> 12, tt = m & 4095;
                const float l0 = LSE[((size_t)(0 + hh) * NB + bb) * SEQ + tt], l1 = LSE[((size_t)(4 + hh) * NB + bb) * SEQ + (tt & 3) * 1024 + (tt >> 2)], l2 = LSE[((size_t)(8 + hh) * NB + bb) * SEQ + (tt & 15) * 256 + (tt >> 4)];
                const float mxl = fmaxf(l0, fmaxf(l1, l2)); const float e0 = __expf(l0 - mxl), e1 = __expf(l1 - mxl), e2 = __expf(l2 - mxl); const float inv = 1.0f / (e0 + e1 + e2);
                const v2u a0 = *(const v2u*)(OG + ((size_t)0 * T + m) * 256 + 4 * lane), a1 = *(const v2u*)(OG + ((size_t)1 * T + m) * 256 + 4 * lane), a2 = *(const v2u*)(OG + ((size_t)2 * T + m) * 256 + 4 * lane);
                const float w0 = e0 * inv, w1 = e1 * inv, w2 = e2 * inv;
                const float sy = (float)(1 << SH_YAB);
                *(unsigned*)((unsigned char*)YA + (size_t)m * 768 + 512 + 4 * lane) = cvt4_fp8(sy * (w0 * bflo(a0.x) + w1 * bflo(a1.x) + w2 * bflo(a2.x)), sy * (w0 * bfhi(a0.x) + w1 * bfhi(a1.x) + w2 * bfhi(a2.x)),
                                                                                                     sy * (w0 * bflo(a0.y) + w1 * bflo(a1.y) + w2 * bflo(a2.y)), sy * (w0 * bfhi(a0.y) + w1 * bfhi(a1.y) + w2 * bfhi(a2.y)));
            }
        xcd_barrier(bar);
        {
            LAS float* Ot = (LAS float*)lds;
            const int t = tid >> 3, seg = (tid & 7) * 16;
            v2u sfN[4]; bf16x8 afN[4][4]; v4u oiN0, oiN1, hzN;
#define P3C_LOAD(un_) do { const int b_ = (un_) >> 8, h_ = ((un_) >> 6) & 3, c_ = (un_) & 63; const size_t r0_ = (size_t)(b_ * SEQ + c_ * 64); \
                _Pragma("unroll") for (int ks = 0; ks < 4; ++ks) sfN[ks] = *(const v2u*)(UT + ((size_t)(un_) * 128 + 16 * wave + fr) * 128 + 32 * ks + 8 * fq); \
                _Pragma("unroll") for (int tt = 0; tt < 4; ++tt) _Pragma("unroll") for (int ks = 0; ks < 4; ++ks) afN[tt][ks] = *(const bf16x8*)(QTB + (r0_ + 16 * tt + fr) * 512 + h_ * 128 + 32 * ks + 8 * fq); \
                oiN0 = *(const v4u*)(OA + (r0_ + t) * 512 + h_ * 128 + seg); oiN1 = *(const v4u*)(OA + (r0_ + t) * 512 + h_ * 128 + seg + 8); \
                hzN = *(const v4u*)((const unsigned char*)GAB + (size_t)T * 2048 + (r0_ + t) * 512 + h_ * 128 + seg); } while (0)
            if (F.vcu < NB * 4 * 64) { P3C_LOAD(F.vcu); }
            int hprev3 = -1; f32x4 ggv[4];
#pragma unroll
            for (int j = 0; j < 4; ++j) ggv[j] = (f32x4){0.f, 0.f, 0.f, 0.f};
            for (int unit = F.vcu; unit < NB * 4 * 64; unit += F.G) {
                const int b = unit >> 8, h = (unit >> 6) & 3, c = unit & 63; const size_t row0 = (size_t)(b * SEQ + c * 64);
                if (h != hprev3) { hprev3 = h;
#pragma unroll
                    for (int j = 0; j < 4; ++j) ggv[j] = *(const f32x4*)(hg_norm_g + h * 128 + seg + 4 * j); }
                bf16x8 sf[4], af[4][4]; f32x4 o4[4];
#pragma unroll
                for (int ks = 0; ks < 4; ++ks) { const f32x2_t s0 = __builtin_amdgcn_cvt_pk_f32_fp8((int)sfN[ks].x, false), s1 = __builtin_amdgcn_cvt_pk_f32_fp8((int)sfN[ks].x, true), s2 = __builtin_amdgcn_cvt_pk_f32_fp8((int)sfN[ks].y, false), s3 = __builtin_amdgcn_cvt_pk_f32_fp8((int)sfN[ks].y, true);
                    const float ru = 1.0f / (float)(1 << SH_U); v4u sw; sw.x = cvt_pk_bf16(s0[0] * ru, s0[1] * ru); sw.y = cvt_pk_bf16(s1[0] * ru, s1[1] * ru); sw.z = cvt_pk_bf16(s2[0] * ru, s2[1] * ru); sw.w = cvt_pk_bf16(s3[0] * ru, s3[1] * ru);
                    sf[ks] = __builtin_bit_cast(bf16x8, sw);
#pragma unroll
                    for (int tt = 0; tt < 4; ++tt) af[tt][ks] = afN[tt][ks]; }
                const v4u oi0 = oiN0, oi1 = oiN1, hz = hzN;
                if (unit + (int)F.G < NB * 4 * 64) { P3C_LOAD(unit + (int)F.G); }
#pragma unroll
                for (int tt = 0; tt < 4; ++tt) { o4[tt] = (f32x4){0.f, 0.f, 0.f, 0.f};
#pragma unroll
                    for (int ks = 0; ks < 4; ++ks) o4[tt] = __builtin_amdgcn_mfma_f32_16x16x32_bf16(af[tt][ks], sf[ks], o4[tt], 0, 0, 0); }
                LBAR();
#pragma unroll
                for (int tt = 0; tt < 4; ++tt)
#pragma unroll
                    for (int i = 0; i < 4; ++i) Ot[(16 * tt + 4 * fq + i) * 132 + 16 * wave + fr] = o4[tt][i];
                LBAR();
                float o[16];
                { const unsigned ow[8] = {oi0.x, oi0.y, oi0.z, oi0.w, oi1.x, oi1.y, oi1.z, oi1.w};
#pragma unroll
                  for (int j = 0; j < 4; ++j) { const f32x4 q4 = *(const LAS f32x4*)(Ot + t * 132 + seg + 4 * j); o[4 * j] = q4[0] + bflo(ow[2 * j]); o[4 * j + 1] = q4[1] + bfhi(ow[2 * j]); o[4 * j + 2] = q4[2] + bflo(ow[2 * j + 1]); o[4 * j + 3] = q4[3] + bfhi(ow[2 * j + 1]); } }
                float ss = 0.f;
#pragma unroll
                for (int j = 0; j < 16; ++j) ss += o[j] * o[j];
                ss += __shfl_xor(ss, 1); ss += __shfl_xor(ss, 2); ss += __shfl_xor(ss, 4);
                const float rstd = 1.0f / sqrtf(ss * (1.f / 128.f) + RMS_EPS);
                const unsigned hw[4] = {hz.x, hz.y, hz.z, hz.w}; const float rs = rstd * (1.0f / (float)(1 << SH_G));
                unsigned yw[4]; const float rsy = rs * (float)(1 << SH_YAB);
#pragma unroll
                for (int j = 0; j < 4; ++j) { const f32x2_t s0 = __builtin_amdgcn_cvt_pk_f32_fp8((int)hw[j], false), s1 = __builtin_amdgcn_cvt_pk_f32_fp8((int)hw[j], true); const f32x4 gg = ggv[j];
                    yw[j] = cvt4_fp8(o[4 * j] * rsy * gg[0] * s0[0], o[4 * j + 1] * rsy * gg[1] * s0[1], o[4 * j + 2] * rsy * gg[2] * s1[0], o[4 * j + 3] * rsy * gg[3] * s1[1]); }
                *(v4u*)((unsigned char*)YA + (row0 + t) * 768 + h * 128 + seg) = (v4u){yw[0], yw[1], yw[2], yw[3]};
            }
#undef P3C_LOAD
        }
    REP_END(3) }

    SEAM(4);

    if (IN(5)) { REP_BEGIN(5)
        { pg8::DenseSched S; S.init(T, 1024, 768, F.G, (int)blockIdx.x, WA_T); pg8::EpiMerge E{(const unsigned char*)GAB, (unsigned char*)MERGED}; pg8::gemm_phase<ALIGN_DEFAULT, true, pg8::EpiMerge, pg8::DenseSched, 2>(lds, (const char*)YA, 768, S, E, SC_WAB, SC_YAB); }
    REP_END(5) }
    SEAM(5);

    if (IN(6)) { REP_BEGIN(6)
        pg8::DenseSched S; S.init(T, 1024, 1024, F.G, (int)blockIdx.x, WO_T); pg8::EpiOut E{X_IN, (bf16*)(ws + WS_X1B), MOD};
        pg8::gemm_phase<ALIGN_DEFAULT, true>(lds, (const char*)MERGED, 1024, S, E, SC_WGU, SC_M);
    REP_END(6) }
    SEAM(6);

    if (IN(7)) { REP_BEGIN(7)
        const int NRB = (F.G >= 256) ? 128 : F.G / 2;
        if ((int)blockIdx.x < NRB) {
            pg8::RouterSched S{T / 256, NRB, (int)blockIdx.x, (const char*)(ws + WS_WRB)}; pg8::EpiRL E{LOGITS};
            pg8::gemm_phase<ALIGN_DEFAULT, false>(lds, (const char*)(ws + WS_X1B), 2048, S, E);
        } else {
            const int rb = (int)blockIdx.x - NRB, nrow = F.G - NRB;
            for (int b = rb; b < NB; b += nrow) if (tid < 256) { float sum = 0.f;
                for (int p0 = 0; p0 < 64; p0 += 16) { float v[16];
#pragma unroll
                    for (int j = 0; j < 16; ++j) v[j] = ((const float*)(ws + WS_PART))[(size_t)(b * 64 + p0 + j) * 256 + tid];
#pragma unroll
                    for (int j = 0; j < 16; ++j) sum += v[j]; }
                ((float*)(ws + WS_CB))[b * 256 + tid] = sum; }
            for (int m0 = (rb * NWAVES + wave) * 16; m0 < T; m0 += nrow * NWAVES * 16) {
                const int b = m0 >> 12;
                f32x4 mul[4], add[4];
#pragma unroll
                for (int j = 0; j < 4; ++j) { const int c = 4 * lane + 256 * j;
                    const f32x4 s2 = *(const f32x4*)(MOD + b * 6144 + 4096 + c);
                    mul[j] = *(const f32x4*)(norm2_g + c) * (s2 + 1.0f);
                    add[j] = *(const f32x4*)(MOD + b * 6144 + 3072 + c); }
                for (int m = m0; m < m0 + 16; ++m) {
                    const GAS v2u* xr = (const GAS v2u*)((const bf16*)(ws + WS_X1B) + (size_t)m * D) + lane;
                    f32x4 v[4]; float s = 0.f;
#pragma unroll
                    for (int j = 0; j < 4; ++j) { const v2u xw = xr[64 * j]; v[j] = (f32x4){bflo(xw.x), bfhi(xw.x), bflo(xw.y), bfhi(xw.y)}; s += (v[j].x * v[j].x + v[j].y * v[j].y) + (v[j].z * v[j].z + v[j].w * v[j].w); }
                    const float rstd = 1.0f / sqrtf(wave_sum(s) * (1.f / D) + RMS_EPS);
                    if (lane == 0) ((float*)(ws + WS_RSTD))[m] = rstd;
                    GAS unsigned* o4 = (GAS unsigned*)((unsigned char*)(ws + WS_H2F8) + (size_t)m * D) + lane;
#pragma unroll
                    for (int j = 0; j < 4; ++j) { const f32x4 y = v[j] * rstd * mul[j] + add[j]; const float sx = (float)(1 << SH_X); o4[64 * j] = cvt4_fp8(y.x * sx, y.y * sx, y.z * sx, y.w * sx); }
                }
            }
        }
    REP_END(7) }
    SEAM(7);

    if (IN(9)) { REP_BEGIN(9)
        LAS unsigned* whist = (LAS unsigned*)lds;
        LAS unsigned* wbase = whist + 2048;
        LAS int* pe_l = (LAS int*)(lds + 16384); LAS int* pr_l = pe_l + 1024; LAS float* pw_l = (LAS float*)(pr_l + 1024);
        for (int cid = F.vcu; cid < T / 128; cid += F.G) {
            const int m0w = cid * 128;
            __syncthreads();
            for (int i = tid; i < 2048; i += NWAVES * 64) whist[i] = 0u;
            __syncthreads();
            float cb4[4], rb4[4];
#pragma unroll
            for (int i = 0; i < 4; ++i) { cb4[i] = ((const float*)(ws + WS_CB))[(cid >> 5) * 256 + lane + 64 * i]; rb4[i] = router_bias[lane + 64 * i]; }
            for (int jg = 0; jg < 16 / TKI; ++jg) {
                float sc[TKI][4]; unsigned key[TKI][4];
#pragma unroll
                for (int tt = 0; tt < TKI; ++tt) { const int t = m0w + wave * 16 + jg * TKI + tt; const float rs = ((const float*)(ws + WS_RSTD))[t];
#pragma unroll
                    for (int i = 0; i < 4; ++i) { sc[tt][i] = fsigmoid(rs * LOGITS[(size_t)t * 256 + lane + 64 * i] + cb4[i]); const float sl = fmaxf(sc[tt][i] + rb4[i], 0.f);
                        key[tt][i] = (__float_as_uint(sl) & 0xFFFFFF00u) | (unsigned)(255 - (lane + 64 * i)); } }
                float myw[TKI], ssum[TKI]; int mye[TKI];
#pragma unroll
                for (int tt = 0; tt < TKI; ++tt) { myw[tt] = 0.f; ssum[tt] = 0.f; mye[tt] = 0; }
                for (int k = 0; k < 8; ++k) {
#pragma unroll
                    for (int tt = 0; tt < TKI; ++tt) {
                        unsigned bk = max(max(key[tt][0], key[tt][1]), max(key[tt][2], key[tt][3]));
                        bk = max(bk, (unsigned)__builtin_amdgcn_update_dpp(0, (int)bk, 0xB1, 0xF, 0xF, false));
                        bk = max(bk, (unsigned)__builtin_amdgcn_update_dpp(0, (int)bk, 0x4E, 0xF, 0xF, false));
                        bk = max(bk, (unsigned)__builtin_amdgcn_update_dpp(0, (int)bk, 0x141, 0xF, 0xF, false));
                        bk = max(bk, (unsigned)__builtin_amdgcn_update_dpp(0, (int)bk, 0x140, 0xF, 0xF, false));
                        bk = max(bk, (unsigned)__builtin_amdgcn_update_dpp(0, (int)bk, 0x142, 0xA, 0xF, false));
                        bk = max(bk, (unsigned)__builtin_amdgcn_update_dpp(0, (int)bk, 0x143, 0xC, 0xF, false));
                        bk = (unsigned)__builtin_amdgcn_readlane((int)bk, 63);
                        const int idx = 255 - (int)(bk & 0xFFu), own = idx & 63, ii = idx >> 6;
                        float sv = ii == 0 ? sc[tt][0] : ii == 1 ? sc[tt][1] : ii == 2 ? sc[tt][2] : sc[tt][3];
                        sv = __int_as_float(__builtin_amdgcn_readlane(__float_as_int(sv), own));
#pragma unroll
                        for (int i = 0; i < 4; ++i) if (lane == own && ii == i) key[tt][i] = 0u;
                        ssum[tt] += sv;
                        if (lane == k) { mye[tt] = idx; myw[tt] = sv; }
                    }
                }
#pragma unroll
                for (int tt = 0; tt < TKI; ++tt) {
                    const float w = myw[tt] / ssum[tt] * 2.5f; const int j = jg * TKI + tt;
                    if (lane < 8) { LAS unsigned* hp = whist + wave * 256 + mye[tt]; const unsigned lr = *hp; *hp = lr + 1u;
                        const int ix = (wave * 16 + j) * 8 + lane; pe_l[ix] = mye[tt]; pr_l[ix] = (int)lr; pw_l[ix] = w; }
                    LDS_WAIT();
                }
            }
            __syncthreads();
            if (tid < 256) { unsigned run = 0u;
#pragma unroll
                for (int w = 0; w < 8; ++w) { wbase[w * 256 + tid] = run; run += whist[w * 256 + tid]; }
                HISTG[cid * 256 + tid] = run; }
            __syncthreads();
            for (int i = tid; i < 1024; i += NWAVES * 64) { const int e = pe_l[i]; const size_t gi = (size_t)m0w * 8 + i; PE[gi] = e; PR[gi] = pr_l[i] + (int)wbase[(i >> 7) * 256 + e]; PW[gi] = pw_l[i]; }
        }
    REP_END(9) }
    SEAM(9);

    if (IN(10) || IN(11) || IN(12)) {
        LAS int* tab = (LAS int*)(lds + TAB_OFF);
        LAS int* est = (LAS int*)lds; LAS int* tst = est + 256; LAS int* cntl = tst + 256; LAS int* ntl = cntl + 256; LAS int* cbl = ntl + 64;
        REP_BEGIN(10)
        for (int cid = F.vcu; cid < T / 128; cid += F.G) {
            __syncthreads();
            {
                const int e = tid & 255, hf = tid >> 8; int tot = 0, cb = 0;
                for (int c0 = hf * 128; c0 < hf * 128 + 128; c0 += 16) { int v[16];
#pragma unroll
                    for (int j = 0; j < 16; ++j) v[j] = (int)HISTG[(c0 + j) * 256 + e];
#pragma unroll
                    for (int j = 0; j < 16; ++j) { tot += v[j]; cb += (c0 + j < cid) ? v[j] : 0; } }
                if (hf) { cntl[e] = tot; cbl[e] = cb; }
                __syncthreads();
                if (!hf) { cntl[e] += tot; cbl[e] += cb; }
            }
            __syncthreads();
            if (wave == 0) {
                int c4[4], loc = 0, locT = 0;
#pragma unroll
                for (int i = 0; i < 4; ++i) { c4[i] = cntl[4 * lane + i]; loc += c4[i]; locT += (c4[i] + 255) >> 8; }
                int inc = loc, incT = locT;
#pragma unroll
                for (int o = 1; o < 64; o <<= 1) { const int a = __shfl_up(inc, o), bt = __shfl_up(incT, o); if (lane >= o) { inc += a; incT += bt; } }
                int ex = inc - loc, exT = incT - locT;
#pragma unroll
                for (int i = 0; i < 4; ++i) { est[4 * lane + i] = exT * 256; tst[4 * lane + i] = exT; ex += c4[i]; exT += (c4[i] + 255) >> 8; }
                if (lane == 63) ntl[0] = incT;
            }
            __syncthreads();
            if (tid < 256) { const int cn = cntl[tid], t0 = tst[tid], e0 = est[tid]; for (int j = 0; j * 256 < cn; ++j) { const int rem = cn - j * 256; tab[(t0 + j) * 4 + 0] = tid; tab[(t0 + j) * 4 + 1] = e0 + j * 256; tab[(t0 + j) * 4 + 2] = rem < 256 ? rem : 256; tab[(t0 + j) * 4 + 3] = 0; } }
            if (tid < T / 256) { const int ti = ntl[0] + tid; tab[ti * 4 + 0] = NEXP; tab[ti * 4 + 1] = NSLOTP + 256 * tid; tab[ti * 4 + 2] = 256; tab[ti * 4 + 3] = 0; }
            if (tid == 0) { F.MISC[16] = (unsigned)ntl[0]; F.MISC[17] = (unsigned)(ntl[0] + T / 256); }
            __syncthreads();
            if (IN(10)) {
                for (int i = cid * 128 + tid; i < cid * 128 + 128; i += NWAVES * 64) SLOT_TOK[NSLOTP + i] = i;
                for (int e = blockIdx.x; e < NEXP; e += F.G) { const int cn = cntl[e], e0 = est[e], pend = e0 + (((cn + 255) >> 8) << 8); for (int i = e0 + cn + tid; i < pend; i += NWAVES * 64) __hip_atomic_store(SLOT_TOK + i, 0, RLX_AGENT); }
                for (int i = tid; i < 1024; i += NWAVES * 64) { const size_t gi = (size_t)cid * 1024 + i; const int e = PE[gi]; const int slot = est[e] + cbl[e] + PR[gi]; __hip_atomic_store(SLOT_TOK + slot, (int)(gi >> 3), RLX_AGENT); TOK_SLOT[gi] = slot; }
            }
        }
        REP_END(10)
        __syncthreads();
    }
    SEAM(10);

    if (IN(11)) { REP_BEGIN(11)
        int Gp = F.G, c11 = F.vcu, cid = -1;
        if (NGB < F.G && NCONV11 > 0) {
            const int units = (int)F.MISC[17] * 2, gmax = F.G - CONV11_MINWG, R = (units + gmax - 1) / gmax; Gp = (units + R - 1) / R;
            const int x = (int)blockIdx.x & 7, j = (int)blockIdx.x >> 3, qb = Gp >> 3, qr = Gp & 7, qx = qb + (x < qr ? 1 : 0), mn = x < qr ? x : qr;
            if (j < qx) c11 = x * qb + mn + j; else cid = x * (32 - qb) - mn + (j - qx);
        }
        Gp = __builtin_amdgcn_readfirstlane(Gp); c11 = __builtin_amdgcn_readfirstlane(c11); cid = __builtin_amdgcn_readfirstlane(cid);
        if (cid < 0) { pg8::RoutedSched<2, true> S{(const LAS int*)(lds + TAB_OFF), (int)F.MISC[17], Gp, c11, 1024u, (const char*)WGU, (size_t)512 * 1024, SLOT_TOK};
          pg8::EpiGU E{(unsigned char*)HMID}; pg8::gemm_phase<ALIGN_DEFAULT, true>(lds, (const char*)(ws + WS_H2F8), 1024, S, E, SC_WGU, SC_X); }
        else conv_run(NITEMS - NCONV11 + cid * NWAVES + wave, NITEMS, (F.G - Gp) * NWAVES, (LAS float*)(lds + wave * 16384));
    REP_END(11) }
    SEAM(11);

    if (IN(12)) { REP_BEGIN(12)
        { pg8::RoutedSched<4, false> S{(const LAS int*)(lds + TAB_OFF), (int)F.MISC[17], F.G, F.vcu, 256u, (const char*)WD, (size_t)1024 * 256, nullptr};
          pg8::EpiRD E{(unsigned char*)YSLOT, SLOT_W}; pg8::gemm_phase<ALIGN_P12, true, pg8::EpiRD, pg8::RoutedSched<4, false>, 2>(lds, (const char*)HMID, 256, S, E, SC_WD, SC_HMID); }

    REP_END(12) }
    SEAM(12);

    if (IN(13)) { REP_BEGIN(13)
        float* dst13 = (rep + 1 < REPS(13)) ? (float*)(ws + WS_QF) : out;
        for (int m0 = F.gw * 16; m0 < T; m0 += F.NGW * 16) {
            const int b = m0 >> 12;
            f32x4 g2[4], fg[4];
#pragma unroll
            for (int j = 0; j < 4; ++j) { const int c = 256 * j + 4 * lane; g2[j] = *(const f32x4*)(MOD + b * 6144 + 5120 + c) * (1.0f / (float)(1 << SH_Y)); fg[j] = *(const f32x4*)(final_g + c); }
            for (int m = m0; m < m0 + 16; ++m) {
                unsigned yr[9][4];
#pragma unroll
                for (int j = 0; j < 4; ++j) yr[0][j] = *(const unsigned*)(YSH + (size_t)m * 1024 + 256 * j + 4 * lane);
#pragma unroll
                for (int k = 0; k < 8; ++k) { const int slot = TOK_SLOT[m * 8 + k]; const unsigned char* sp = (const unsigned char*)YSLOT + (size_t)slot * 1024 + 4 * lane;
#pragma unroll
                    for (int j = 0; j < 4; ++j) yr[k + 1][j] = *(const unsigned*)(sp + 256 * j); }
                f32x4 v[4];
#pragma unroll
                for (int j = 0; j < 4; ++j) { const v2u xw = *(const v2u*)((const bf16*)(ws + WS_X1B) + (size_t)m * D + 256 * j + 4 * lane); v[j] = (f32x4){bflo(xw.x), bfhi(xw.x), bflo(xw.y), bfhi(xw.y)}; }
                f32x4 a[4];
#pragma unroll
                for (int j = 0; j < 4; ++j) a[j] = (f32x4){0.f, 0.f, 0.f, 0.f};
#pragma unroll
                for (int k = (DBG_MOE >= 1 ? 0 : 9); k < (DBG_MOE >= 2 ? 9 : 1); ++k) {
                    const float wk = k == 0 ? 1.0f : PW[m * 8 + (k > 0 ? k - 1 : 0)];
#pragma unroll
                    for (int j = 0; j < 4; ++j) { const f32x2_t lo = __builtin_amdgcn_cvt_pk_f32_fp8((int)yr[k][j], false), hi = __builtin_amdgcn_cvt_pk_f32_fp8((int)yr[k][j], true); a[j] += (f32x4){lo[0], lo[1], hi[0], hi[1]} * wk; } }
                float s = 0.f;
#pragma unroll
                for (int j = 0; j < 4; ++j) { v[j] = v[j] + g2[j] * a[j]; s += (v[j].x * v[j].x + v[j].y * v[j].y) + (v[j].z * v[j].z + v[j].w * v[j].w); }
                const float rstd = 1.0f / sqrtf(wave_sum(s) * (1.f / D) + RMS_EPS);
                GAS f32x4* dr = (GAS f32x4*)(dst13 + (size_t)m * D + 4 * lane);
#pragma unroll
                for (int j = 0; j < 4; ++j) dr[64 * j] = v[j] * rstd * fg[j];
            }
        }
    REP_END(13) }
#if defined(DBG_DUMP)
    {
        xcd_barrier(bar);
        const bf16* SRC = DBG_DUMP_SRC; const int ld = DBG_DUMP_LD, off = DBG_DUMP_OFF;
        for (int m = F.gw; m < T; m += F.NGW) {
#pragma unroll
            for (int j = 0; j < 4; ++j) { const int c = 4 * lane + 256 * j; const int cc = c % DBG_DUMP_W; const v2u y = *(const v2u*)(SRC + (size_t)m * ld + off + cc); *(f32x4*)(out + (size_t)m * 1024 + c) = (f32x4){bflo(y.x), bfhi(y.x), bflo(y.y), bfhi(y.y)}; }
        }
    }
#endif
#undef IN
#undef SEAM
}

#undef X_IN
#undef cvec
#undef ada_w
#undef ada_b
#undef norm1_g
#undef w_in
#undef lb_logits
#undef hg_norm_g
#undef w_branch_a
#undef w_branch_b
#undef w_out
#undef norm2_g
#undef w_router
#undef router_bias
#undef w_exp_gate
#undef w_exp_up
#undef w_exp_down
#undef w_sh_gate
#undef w_sh_up
#undef w_sh_down
#undef final_g
#undef out
#undef WIN_T
#undef WA_T
#undef WB_T
#undef WO_T
#undef RS_T
#undef WSD_T
#undef WD
#undef WGU
#undef PE
#undef PR
#undef PW
#undef SLOT_TOK
#undef SLOT_W
#undef TOK_SLOT
#undef LSE
#undef QF
#undef OA
#undef OG
#undef MERGED
#undef HMID
#undef YSH
#undef AQKV
#undef GAB
#undef XN
#undef YA
#undef YB
#undef H2
#undef LOGITS
#undef YSLOT
#undef MOD
#undef HISTG
#undef ATTQ
#ifndef DBG_MOE
#define DBG_MOE 2
#endif
#ifndef MK_CUTS
#define MK_CUTS 1
#endif
extern "C" void kernel_launch(void* const* d_in, const int* in_sizes, int n_in, void* d_out, int out_size, void* d_ws, size_t ws_size, hipStream_t stream) {
    static int grid = 0;
    if (grid == 0) {
        if (n_in != 21 || out_size != T * D || ws_size < WS_END) { fprintf(stderr, "kernel_launch: unexpected shapes (n_in %d out %d ws %zu)\n", n_in, out_size, ws_size); grid = -1; return; }
        int dev = 0, cus = 0, per_cu = 0;
        if (hipGetDevice(&dev) != hipSuccess || hipDeviceGetAttribute(&cus, hipDeviceAttributeMultiprocessorCount, dev) != hipSuccess) { grid = -1; return; }
        if (hipFuncSetAttribute((const void*)mk_fwd, hipFuncAttributeMaxDynamicSharedMemorySize, LDS_BYTES) != hipSuccess) { fprintf(stderr, "kernel_launch: hipFuncSetAttribute failed\n"); grid = -1; return; }
        if (hipOccupancyMaxActiveBlocksPerMultiprocessor(&per_cu, (const void*)mk_fwd, NWAVES * 64, LDS_BYTES) != hipSuccess || per_cu < 1) fprintf(stderr, "kernel_launch: occupancy query reports %d\n", per_cu);
        (void)hipGetLastError();
        grid = cus;
    }
    if (grid < 0) return;
    if (hipMemsetAsync((char*)d_ws + WS_CTL, 0, CTL_ZERO_BYTES, stream) != hipSuccess) return;
    Args a{};
    for (int i = 0; i < 21; ++i) a.in[i] = (const float*)d_in[i];
    a.out = (float*)d_out; a.ws = (unsigned char*)d_ws;
#if MK_CUTS == 1
    a.ph_lo = 0; a.ph_hi = 14;
    hipLaunchKernelGGL(mk_fwd, dim3(grid), dim3(NWAVES * 64), LDS_BYTES, stream, a);
#else
    for (int p = 0; p < 14; ++p) { a.ph_lo = p; a.ph_hi = p + 1; hipLaunchKernelGGL(mk_fwd, dim3(grid), dim3(NWAVES * 64), LDS_BYTES, stream, a); }
#endif
}
```

```cpp
#include <hip/hip_runtime.h>
#include <cstdio>
#include <cstdint>
#ifndef DBG_MOE
#define DBG_MOE 2
#endif

#define GAS __attribute__((address_space(1)))
#define LAS __attribute__((address_space(3)))
typedef unsigned short bf16;
typedef unsigned v4u __attribute__((ext_vector_type(4)));
typedef unsigned v2u __attribute__((ext_vector_type(2)));
typedef float f32x4 __attribute__((ext_vector_type(4)));
typedef short bf16x8 __attribute__((ext_vector_type(8)));
typedef short bf16x4 __attribute__((ext_vector_type(4)));
typedef short v4i16_t __attribute__((ext_vector_type(4)));
typedef GAS unsigned gu32;

constexpr int NB = 8, SEQ = 4096, D = 1024, T = NB * SEQ;
constexpr int NIN = 6400;
constexpr int NEXP = 256, TOPK = 8, DEXP = 256;
constexpr int NSLOT = T * TOPK;
constexpr int MAXRT = NSLOT / 256 + NEXP;
constexpr int NSLOTP = MAXRT * 256;
constexpr int MAXTILES = MAXRT + T / 256;
constexpr float RMS_EPS = 1e-6f;
constexpr int NWAVES = 8;
constexpr int SH_WD = 5, SH_HMID = 2, SH_WGU = 6, SH_X = 2, SH_Y = 3, SH_G = 2, SH_U = 2, SH_M = 3, SH_YAB = 2, SH_WAB = 5, SH_Q = 2;
constexpr int SC_WD = 0x01010101 * (127 - SH_WD), SC_HMID = 0x01010101 * (127 - SH_HMID), SC_WGU = 0x01010101 * (127 - SH_WGU), SC_X = 0x01010101 * (127 - SH_X), SC_M = 0x01010101 * (127 - SH_M), SC_YAB = 0x01010101 * (127 - SH_YAB), SC_WAB = 0x01010101 * (127 - SH_WAB);

constexpr size_t MiB = 1u << 20;
constexpr size_t WS_CTL = 0, CTL_ZERO_BYTES = 1 * MiB;
constexpr size_t WS_WIN_T = 1 * MiB;
constexpr size_t WS_WA_T = 14 * MiB;
constexpr size_t WS_WB_T = 15 * MiB;
constexpr size_t WS_WO_T = 16 * MiB;
constexpr size_t WS_RS_T = 18 * MiB;
constexpr size_t WS_WSD_T = 20 * MiB;
constexpr size_t WS_PE = 21 * MiB, WS_PR = 22 * MiB, WS_PW = 23 * MiB;
constexpr size_t WS_SLOT_TOK = 24 * MiB, WS_SLOT_W = 25 * MiB, WS_TOK_SLOT = 27 * MiB;
constexpr size_t WS_LSE = 28 * MiB;
constexpr size_t WS_HISTG = 31 * MiB;
constexpr size_t WS_MOD = 30 * MiB;
constexpr size_t WS_WD = 32 * MiB;
constexpr size_t WS_QF = 160 * MiB;
constexpr size_t WS_OA = 288 * MiB;
constexpr size_t WS_OG = 320 * MiB;
constexpr size_t WS_MERGED = 288 * MiB;
constexpr size_t WS_HMID = 160 * MiB;
constexpr size_t WS_YSH = 304 * MiB;
constexpr size_t WS_WGU = 384 * MiB;
constexpr size_t WS_AQKV = 640 * MiB;
constexpr size_t WS_GAB = 784 * MiB;
constexpr size_t WS_XN = 912 * MiB;
constexpr size_t WS_YA = 640 * MiB;
constexpr size_t WS_YB = 368 * MiB;
constexpr size_t WS_H2 = 640 * MiB;
constexpr size_t WS_H2F8 = 912 * MiB;
constexpr size_t WS_X1B = 736 * MiB;
constexpr size_t WS_LOGITS = 704 * MiB;
constexpr size_t WS_YSLOT = 384 * MiB;
constexpr size_t WS_UT = 912 * MiB;
constexpr size_t WS_QTB = 976 * MiB;
constexpr size_t WS_DK = 1008 * MiB;
constexpr size_t WS_PART = 18 * MiB;
constexpr size_t WS_CB = 19 * MiB;
constexpr size_t WS_RSTD = 19 * MiB + 65536;
constexpr size_t WS_WRB = 1009 * MiB;
constexpr size_t WS_END = 1013 * MiB;
constexpr int CW_TMO = 0, CW_CODE = 1, CW_BAR = 4096, CW_GCNT = 16384, CW_ATTQ = 20480, CW_MOD = 65536;

constexpr int RING_BYTES = 131072;
constexpr int TAB_OFF = RING_BYTES;
constexpr int MISC_OFF = TAB_OFF + MAXTILES * 16;
constexpr int LDS_BYTES = MISC_OFF + 256;

#define RLX_AGENT __ATOMIC_RELAXED, __HIP_MEMORY_SCOPE_AGENT
#define LDS_WAIT() asm volatile("s_waitcnt lgkmcnt(0)" ::: "memory")
#define VM_WAIT() asm volatile("s_waitcnt vmcnt(0)" ::: "memory")
#define LBAR() do { asm volatile("s_waitcnt lgkmcnt(0)" ::: "memory"); __builtin_amdgcn_s_barrier(); asm volatile("" ::: "memory"); } while (0)
typedef float f32x2_t __attribute__((ext_vector_type(2))); typedef __bf16 bf16x2_t __attribute__((ext_vector_type(2)));
__device__ __forceinline__ unsigned cvt_pk_bf16(float lo, float hi) { f32x2_t v = {lo, hi}; bf16x2_t b = __builtin_convertvector(v, bf16x2_t); return __builtin_bit_cast(unsigned, b); }
typedef int v8i __attribute__((ext_vector_type(8))); typedef int v4i_t __attribute__((ext_vector_type(4)));
__device__ __forceinline__ unsigned cvt4_fp8(float a, float b, float c, float d) {
    a = __builtin_amdgcn_fmed3f(a, -448.f, 448.f); b = __builtin_amdgcn_fmed3f(b, -448.f, 448.f); c = __builtin_amdgcn_fmed3f(c, -448.f, 448.f); d = __builtin_amdgcn_fmed3f(d, -448.f, 448.f);
    int w = 0; w = __builtin_amdgcn_cvt_pk_fp8_f32(a, b, w, false); w = __builtin_amdgcn_cvt_pk_fp8_f32(c, d, w, true); return (unsigned)w; }
__device__ __forceinline__ v4u f8x8_to_bf16(unsigned w0, unsigned w1) {
    const f32x2_t a = __builtin_amdgcn_cvt_pk_f32_fp8((int)w0, false), b = __builtin_amdgcn_cvt_pk_f32_fp8((int)w0, true), c = __builtin_amdgcn_cvt_pk_f32_fp8((int)w1, false), d = __builtin_amdgcn_cvt_pk_f32_fp8((int)w1, true);
    v4u o; o.x = cvt_pk_bf16(a[0], a[1]); o.y = cvt_pk_bf16(b[0], b[1]); o.z = cvt_pk_bf16(c[0], c[1]); o.w = cvt_pk_bf16(d[0], d[1]); return o; }
__device__ __forceinline__ float bf2f(unsigned h) { return __uint_as_float(h << 16); }
__device__ __forceinline__ float bflo(unsigned w) { return __uint_as_float(w << 16); }
__device__ __forceinline__ float bfhi(unsigned w) { return __uint_as_float(w & 0xffff0000u); }
__device__ __forceinline__ float fsigmoid(float x) { return __builtin_amdgcn_rcpf(1.0f + __expf(-x)); }
__device__ __forceinline__ float fsilu(float x) { return x * fsigmoid(x); }
__device__ __forceinline__ float wave_sum(float v) {
#pragma unroll
    for (int o = 1; o < 64; o <<= 1) v += __shfl_xor(v, o);
    return v;
}

#define XB_TMO      128
#define XB_XCNT(j)  (256  + 64 * (j))
#define XB_XSUB(j)  (1280 + 64 * (j))
#define XB_XGEN(j)  (2304 + 64 * (j))
#define XB_TOP      3328
#define XB_TOPGEN   3392
#define XCD_BAR_WORDS 3456
#define XB_SPIN_CAP (1u << 18)
__device__ __forceinline__ unsigned xb_ld(unsigned* p)              { return __hip_atomic_load(p, __ATOMIC_RELAXED, __HIP_MEMORY_SCOPE_AGENT); }
__device__ __forceinline__ unsigned xb_add(unsigned* p, unsigned v) { return __hip_atomic_fetch_add(p, v, __ATOMIC_RELAXED, __HIP_MEMORY_SCOPE_AGENT); }
__device__ __forceinline__ unsigned xb_xcc_id() { return (unsigned)__builtin_amdgcn_s_getreg((3 << 11) | 20) & 0xFu; }
#define XB_SPIN(cond, bar) do { unsigned _sp = 0; while (cond) { __builtin_amdgcn_s_sleep(1); \
    if ((++_sp & 255u) == 0u) { if (xb_ld(&(bar)[XB_TMO])) break; if (_sp > XB_SPIN_CAP) { atomicAdd(&(bar)[XB_TMO], 1u); break; } } } } while (0)
struct XcdBarrier { unsigned* bar; unsigned x; volatile LAS unsigned* st; };
__device__ __forceinline__ XcdBarrier xcd_barrier_post(unsigned* bar, volatile LAS unsigned* st) {
    XcdBarrier b; b.bar = bar; b.x = xb_xcc_id(); b.st = st;
    if (threadIdx.x == 0) (void)xb_add(&bar[XB_XCNT(b.x)], 1u);
    return b;
}
__device__ __forceinline__ void xcd_barrier_complete(unsigned* bar, unsigned x, unsigned& nloc, unsigned& nx) {
    const unsigned G = gridDim.x * gridDim.y * gridDim.z;
    unsigned sum, cnt, mine, sp = 0u;
    for (;;) {
        sum = 0u; cnt = 0u; mine = 0u;
#pragma unroll
        for (unsigned j = 0; j < 16; ++j) { const unsigned c = xb_ld(&bar[XB_XCNT(j)]); sum += c; cnt += (c > 0u) ? 1u : 0u; mine = (j == x) ? c : mine; }
        if (sum == G) break;
        __builtin_amdgcn_s_sleep(1);
        if ((++sp & 255u) == 0u) { if (xb_ld(&bar[XB_TMO])) break; if (sp > XB_SPIN_CAP) { atomicAdd(&bar[XB_TMO], 1u); break; } }
    }
    nloc = mine > 0u ? mine : 1u; nx = cnt > 0u ? cnt : 1u;
}
__device__ __forceinline__ void xcd_barrier(const XcdBarrier& b) {
    asm volatile("s_waitcnt vmcnt(0)" ::: "memory");
    __syncthreads();
    if (threadIdx.x == 0) {
        unsigned* bar = b.bar;
        __builtin_amdgcn_s_waitcnt(0);
        unsigned nloc = b.st[0], nx = b.st[1];
        if (nloc == 0u) { xcd_barrier_complete(bar, b.x, nloc, nx); b.st[0] = nloc; b.st[1] = nx; }
        const unsigned old = xb_add(&bar[XB_XSUB(b.x)], 1u);
        const unsigned gen = old / nloc;
        if (old + 1u == (gen + 1u) * nloc) {
            __builtin_amdgcn_fence(__ATOMIC_RELEASE, "agent");
            asm volatile("s_waitcnt vmcnt(0)" ::: "memory");
            const unsigned og = xb_add(&bar[XB_TOP], 1u);
            const unsigned tg = og / nx;
            if (og + 1u == (tg + 1u) * nx) xb_add(&bar[XB_TOPGEN], 1u);
            else XB_SPIN(xb_ld(&bar[XB_TOPGEN]) == tg, bar);
            __builtin_amdgcn_fence(__ATOMIC_ACQUIRE, "agent");
            xb_add(&bar[XB_XGEN(b.x)], 1u);
            asm volatile("s_waitcnt vmcnt(0)" ::: "memory");
        } else {
            XB_SPIN(xb_ld(&bar[XB_XGEN(b.x)]) == gen, bar);
            __builtin_amdgcn_fence(__ATOMIC_ACQUIRE, "agent");
            asm volatile("s_waitcnt vmcnt(0)" ::: "memory");
        }
    }
    __syncthreads();
}

__device__ __forceinline__ void glds16s(const void* sbase, unsigned voff, unsigned lds_dst) {
    unsigned keep;
    asm volatile("s_mov_b32 %0, m0\n\ts_mov_b32 m0, %3\n\ts_nop 0\n\tglobal_load_lds_dwordx4 %1, %2\n\ts_mov_b32 m0, %0" : "=&s"(keep) : "v"(voff), "s"(sbase), "s"(lds_dst) : "memory");
}
namespace pg8 {
constexpr int BM = 256, BK = 64, HALF = 128, HTB = HALF * BK * 2, NXCD = 8, WGM = 8;
__host__ __device__ __forceinline__ int lds_byte(int r, int c) { const int st = (r >> 4) * 2 + (c >> 5), rr = r & 15, cc = c & 31, ob = rr * 64 + cc * 2; return st * 1024 + (ob ^ (((ob >> 9) & 1) << 5)); }
__host__ __device__ __forceinline__ void stage_rc(int b, int& R, int& C) { const int st = b / 1024, sb = b % 1024, swz = sb ^ (((sb >> 9) & 1) << 5); R = (st >> 1) * 16 + swz / 64; C = (st & 1) * 32 + (swz % 64) / 2; }
__host__ __device__ __forceinline__ int perm32(int rho) { const int n = rho >> 4, i = rho & 15; return 8 * (i >> 2) + 4 * n + (i & 3); }
struct Unit { int pm, pn, e, row0, rows; };

struct DenseSched {
    int nM, nN, nwg, G, c; unsigned rowbytes; int arow0; const char* Bt;
    __device__ void init(int M, int N, int Kbytes, int G_, int c_, const void* Bt_, int arow0_ = 0) { nM = M / BM; nN = N / BM; nwg = nM * nN; G = G_; c = c_; rowbytes = (unsigned)Kbytes; arow0 = arow0_; Bt = (const char*)Bt_; }
    __device__ __forceinline__ bool next(int i, Unit& u) const {
        const long L = (long)i * G + c; if (L >= nwg) return false;
        int wgid = (int)L; { const int q = nwg / NXCD, r = nwg % NXCD, xcd = wgid % NXCD, off = wgid / NXCD; wgid = (xcd < r ? xcd * (q + 1) : r * (q + 1) + (xcd - r) * q) + off; }
        const int nig = WGM * nN, gid = wgid / nig, fm = gid * WGM, gsz = (nM - fm) < WGM ? (nM - fm) : WGM;
        u.pm = fm + ((wgid % nig) % gsz); u.pn = (wgid % nig) / gsz; u.e = 0; u.row0 = u.pm * BM; u.rows = BM; return true;
    }
    __device__ __forceinline__ unsigned a_off(const Unit& u, int r) const { return (unsigned)(arow0 + u.pm * BM + r) * rowbytes; }
    __device__ __forceinline__ const char* b_base(const Unit& u) const { return Bt + (size_t)u.pn * BM * rowbytes; }
};
template <int NPN, bool GATHER>
struct RoutedSched {
    const LAS int* tab; int ntiles, G, c; unsigned rowbytes; const char* Bt; size_t estride; const int* rowlist;
    __device__ __forceinline__ bool next(int i, Unit& u) const {
        const long L = (long)i * G + c; if (L >= (long)ntiles * NPN) return false;
        const int ti = (int)(L / NPN); u.pn = (int)(L % NPN); u.pm = ti;
        u.e = __builtin_amdgcn_readfirstlane(tab[ti * 4 + 0]); u.row0 = __builtin_amdgcn_readfirstlane(tab[ti * 4 + 1]); u.rows = __builtin_amdgcn_readfirstlane(tab[ti * 4 + 2]); return true;
    }
    __device__ __forceinline__ unsigned a_off(const Unit& u, int r) const {
        const int s = u.row0 + r;
        if (GATHER) return (unsigned)rowlist[s] * rowbytes; else return (unsigned)s * rowbytes;
    }
    __device__ __forceinline__ const char* b_base(const Unit& u) const { return Bt + (size_t)u.e * estride + (size_t)u.pn * BM * rowbytes; }
};

struct RouterSched {
    int n, G, c; const char* Bt;
    __device__ __forceinline__ bool next(int i, Unit& u) const { const long L = (long)i * G + c; if (L >= n) return false; u.pm = (int)L; u.pn = 0; u.e = 0; u.row0 = u.pm * BM; u.rows = BM; return true; }
    __device__ __forceinline__ unsigned a_off(const Unit& u, int r) const { return (unsigned)(u.pm * BM + r) * 2048u; }
    __device__ __forceinline__ const char* b_base(const Unit& u) const { return Bt + (size_t)(u.pm >> 4) * (256 * 2048); }
};

template <bool ALIGN_EPI, bool FP8, class Epi, class Sched, int CM = 1>
__device__ __forceinline__ void gemm_phase(LAS unsigned char* lds, const char* Abase, const int Kbytes, const Sched& S, const Epi& E, const int scaleW = 0x7F7F7F7F, const int scaleX = 0x7F7F7F7F) {
    int tid = threadIdx.x; asm volatile("" : "+v"(tid));
    const int wid = __builtin_amdgcn_readfirstlane(tid >> 6), lane = tid & 63, wr = wid >> 2, wc = wid & 3, fr = lane & 15, fq = lane >> 4;
    const int nt = Kbytes / (BK * 2);
    unsigned voffB[2];
#pragma unroll
    for (int i = 0; i < 2; ++i) { int R, C; stage_rc(tid * 16 + i * 8192, R, C); const int Rb = (CM == 2) ? 2 * (R & ~31) + 16 * ((R & 15) >> 2) + 4 * ((R >> 4) & 1) + (R & 3) : (CM ? 2 * (R & ~31) : (R & ~31)) + perm32(R & 31); voffB[i] = (unsigned)(Rb * Kbytes + C * 2); }
    const size_t kstep = (size_t)(BK * 2);
    const size_t hstepB = (size_t)(CM == 2 ? 8 : CM ? 32 : HALF) * Kbytes;
    const unsigned ldsw = (unsigned)wid * 1024u;
    const unsigned lds0 = (unsigned)(uintptr_t)lds;
    const int aoff = lds_byte(wr * 64 + fr, fq * 8), boff = lds_byte(wc * 32 + fr, fq * 8);
#define PG8_SA(b, h) (((b) * 2 + (h)) * HTB)
#define PG8_SB(b, h) ((4 + (b) * 2 + (h)) * HTB)
#define PG8_STAGE(bufoff, gbase, voff) do { _Pragma("unroll") for (int _i = 0; _i < 2; ++_i) \
        glds16s((const void*)(gbase), (voff)[_i], lds0 + (unsigned)((bufoff) + _i * 8192) + ldsw); } while (0)
#define PG8_LD2(p) __builtin_shufflevector(*(const LAS v4i_t*)(p), *(const LAS v4i_t*)((p) + 1024), 0, 1, 2, 3, 4, 5, 6, 7)
#define PG8_LDA(dst, b, h) do { _Pragma("unroll") for (int m = 0; m < 4; ++m) dst[m] = PG8_LD2(lds + PG8_SA(b, h) + aoff + m * 2048); } while (0)
#define PG8_LDB(dst, b, h) do { _Pragma("unroll") for (int n = 0; n < 2; ++n) dst[n] = PG8_LD2(lds + PG8_SB(b, h) + boff + n * 2048); } while (0)
#define PG8_LO(v) __builtin_bit_cast(bf16x8, __builtin_shufflevector(v, v, 0, 1, 2, 3))
#define PG8_HI(v) __builtin_bit_cast(bf16x8, __builtin_shufflevector(v, v, 4, 5, 6, 7))
#define PG8_MMA(ai, bj, At, Bt) do { __builtin_amdgcn_s_setprio(1); _Pragma("unroll") for (int m = 0; m < 4; ++m) _Pragma("unroll") for (int n = 0; n < 2; ++n) { \
        if constexpr (FP8) acc[ai][bj][m][n] = __builtin_amdgcn_mfma_scale_f32_16x16x128_f8f6f4(Bt[n], At[m], acc[ai][bj][m][n], 0, 0, 0, scaleW, 0, scaleX); \
        else { acc[ai][bj][m][n] = __builtin_amdgcn_mfma_f32_16x16x32_bf16(PG8_LO(Bt[n]), PG8_LO(At[m]), acc[ai][bj][m][n], 0, 0, 0); acc[ai][bj][m][n] = __builtin_amdgcn_mfma_f32_16x16x32_bf16(PG8_HI(Bt[n]), PG8_HI(At[m]), acc[ai][bj][m][n], 0, 0, 0); } } __builtin_amdgcn_s_setprio(0); } while (0)
#define PG8_WAIT_V(n) asm volatile("s_waitcnt vmcnt(" #n ")" ::: "memory")
#define PG8_WAIT_L(n) asm volatile("s_waitcnt lgkmcnt(" #n ")" ::: "memory")
#define PG8_BAR __builtin_amdgcn_s_barrier()
#define PG8_SCHED __builtin_amdgcn_sched_barrier(0)
#define PG8_AOFF(u, o0, o1) do { int _t = tid; asm volatile("" : "+v"(_t)); _Pragma("unroll") for (int _i = 0; _i < 2; ++_i) { int _R, _C; stage_rc(_t * 16 + _i * 8192, _R, _C); \
        o0[_i] = S.a_off(u, _R) + (unsigned)_C * 2u; o1[_i] = S.a_off(u, _R + HALF) + (unsigned)_C * 2u; } } while (0)
    Unit cur, nxt; int ui = 0;
    if (!S.next(0, cur)) return;
    f32x4 acc[2][2][4][2];
#pragma unroll
    for (int a = 0; a < 2; ++a)
#pragma unroll
        for (int b = 0; b < 2; ++b)
#pragma unroll
            for (int m = 0; m < 4; ++m)
#pragma unroll
                for (int n = 0; n < 2; ++n) acc[a][b][m][n] = (f32x4){0.f, 0.f, 0.f, 0.f};
    v8i At[4], B0[2], B1[2];
    unsigned cA0[2], cA1[2];
    PG8_AOFF(cur, cA0, cA1);
    const char* cB = S.b_base(cur); const char* nB = cB;
    PG8_STAGE(PG8_SB(0, 0), cB, voffB); PG8_STAGE(PG8_SB(0, 1), cB + hstepB, voffB); PG8_STAGE(PG8_SA(0, 0), Abase, cA0); PG8_STAGE(PG8_SA(0, 1), Abase, cA1);
    if (wr == 1) PG8_BAR;
    PG8_WAIT_V(2); PG8_BAR;
    PG8_STAGE(PG8_SB(1, 0), cB + kstep, voffB); PG8_STAGE(PG8_SA(1, 0), Abase + kstep, cA0); PG8_STAGE(PG8_SB(1, 1), cB + hstepB + kstep, voffB);
    PG8_WAIT_V(6); PG8_BAR;
    for (;;) {
        const bool has_next = S.next(ui + 1, nxt);
#pragma unroll 1
        for (int t = 0; t < nt; t += 2) {
            const bool last = (t == nt - 2);
            if constexpr (Epi::MID_T > 0) { if (t == Epi::MID_T) { PG8_SCHED; E.mid(acc, cur, wr, wc, fr, fq); PG8_SCHED; } }
            if (last && has_next) nB = S.b_base(nxt);
            const char* a1 = Abase + (size_t)(t + 1) * kstep;
            const char* a2 = last ? Abase : Abase + (size_t)(t + 2) * kstep; const char* b2 = last ? nB : cB + (size_t)(t + 2) * kstep;
            const char* a3 = a2 + kstep; const char* b3 = b2 + kstep;
            PG8_LDB(B0, 0, 0); PG8_LDB(B1, 0, 1); PG8_SCHED; PG8_LDA(At, 0, 0); PG8_STAGE(PG8_SA(1, 1), a1, cA1);
            if (last && has_next) { PG8_AOFF(nxt, cA0, cA1); }
            PG8_WAIT_V(8); PG8_WAIT_L(0); PG8_BAR; PG8_MMA(0, 0, At, B0); PG8_MMA(0, 1, At, B1); PG8_BAR; PG8_SCHED;
            PG8_LDA(At, 0, 1); PG8_STAGE(PG8_SB(0, 0), b2, voffB); PG8_STAGE(PG8_SB(0, 1), b2 + hstepB, voffB); PG8_STAGE(PG8_SA(0, 0), a2, cA0);
            PG8_WAIT_V(8); PG8_WAIT_L(0); PG8_BAR; PG8_MMA(1, 0, At, B0); PG8_MMA(1, 1, At, B1); PG8_BAR; PG8_SCHED;
            PG8_LDB(B0, 1, 0); PG8_LDB(B1, 1, 1); PG8_SCHED; PG8_LDA(At, 1, 0); PG8_STAGE(PG8_SA(0, 1), a2, cA1);
            PG8_WAIT_V(8); PG8_WAIT_L(0); PG8_BAR; PG8_MMA(0, 0, At, B0); PG8_MMA(0, 1, At, B1); PG8_BAR; PG8_SCHED;
            PG8_LDA(At, 1, 1); PG8_STAGE(PG8_SB(1, 0), b3, voffB); PG8_STAGE(PG8_SB(1, 1), b3 + hstepB, voffB); PG8_STAGE(PG8_SA(1, 0), a3, cA0);
            PG8_WAIT_V(8); PG8_WAIT_L(0); PG8_BAR; PG8_MMA(1, 0, At, B0); PG8_MMA(1, 1, At, B1); PG8_BAR; PG8_SCHED;
        }
        if constexpr (ALIGN_EPI) { if (wr == 0) PG8_BAR; }
        { Unit eu = cur; int efr = fr, efq = fq; asm volatile("" : "+s"(eu.pm), "+s"(eu.pn), "+s"(eu.e), "+s"(eu.row0), "+s"(eu.rows), "+v"(efr), "+v"(efq)); E(acc, eu, wr, wc, efr, efq); }
        if (!has_next) break;
#pragma unroll
        for (int a = 0; a < 2; ++a)
#pragma unroll
            for (int b = 0; b < 2; ++b)
#pragma unroll
                for (int m = 0; m < 4; ++m)
#pragma unroll
                    for (int n = 0; n < 2; ++n) acc[a][b][m][n] = (f32x4){0.f, 0.f, 0.f, 0.f};
        cur = nxt; cB = nB; ++ui;
        if constexpr (ALIGN_EPI) { if (wr == 1) PG8_BAR; }
    }
    PG8_WAIT_V(0);
    if constexpr (!ALIGN_EPI) { if (wr == 0) PG8_BAR; }
    PG8_BAR;
#undef PG8_SA
#undef PG8_SB
#undef PG8_STAGE
#undef PG8_LDA
#undef PG8_LDB
#undef PG8_MMA
#undef PG8_LO
#undef PG8_HI
#undef PG8_LD2
#undef PG8_WAIT_V
#undef PG8_WAIT_L
#undef PG8_BAR
#undef PG8_SCHED
#undef PG8_AOFF
}

constexpr int WCS = 64, BJS = 32;
#define EPI_ROWS_BEGIN _Pragma("unroll") for (int ai = 0; ai < 2; ++ai) _Pragma("unroll") for (int m = 0; m < 4; ++m) { const int rt = ai * HALF + wr * 64 + m * 16 + fr;
#define EPI_ROWS_END }
__device__ __forceinline__ v4u pack8(const f32x4 a, const f32x4 b) { v4u w; w.x = cvt_pk_bf16(a[0], a[1]); w.y = cvt_pk_bf16(a[2], a[3]); w.z = cvt_pk_bf16(b[0], b[1]); w.w = cvt_pk_bf16(b[2], b[3]); return w; }

__device__ __forceinline__ v2u act8_fp8(const f32x4 a, const f32x4 b, const bool silu) {
    const float sc = (float)(1 << SH_G); float x[8] = {a[0], a[1], a[2], a[3], b[0], b[1], b[2], b[3]};
#pragma unroll
    for (int j = 0; j < 8; ++j) { const float sg = fsigmoid(x[j]); x[j] = (silu ? x[j] * sg : sg) * sc; }
    v2u w; w.x = cvt4_fp8(x[0], x[1], x[2], x[3]); w.y = cvt4_fp8(x[4], x[5], x[6], x[7]); return w;
}
struct EpiWin { static constexpr int MID_T = 0;
    unsigned char *QF8, *AQKV8, *GAB8, *HG8; int dry;
    __device__ __forceinline__ void operator()(const f32x4 (&acc)[2][2][4][2], const Unit& u, int wr, int wc, int fr, int fq) const {
        if (dry) return;
        if (u.pn >= 17 || u.pn == 6 || u.pn == 7) {
            const bool silu = u.pn < 8; unsigned char* base = silu ? HG8 : GAB8; const int ldc = silu ? 512 : 2048, ct = silu ? u.pn - 6 : u.pn - 17;
            const int col0 = ct * BM + wc * 64 + 16 * fq;
            EPI_ROWS_BEGIN { unsigned char* rowp = base + (size_t)(u.pm * BM + rt) * ldc + col0;
                const v2u lo = act8_fp8(acc[ai][0][m][0], acc[ai][0][m][1], silu), hi = act8_fp8(acc[ai][1][m][0], acc[ai][1][m][1], silu);
                *(v4u*)rowp = (v4u){lo.x, lo.y, hi.x, hi.y}; } EPI_ROWS_END
            return;
        }
        unsigned char* base; int ldc, ct;
        if (u.pn < 8) { base = QF8; ldc = 1536; ct = u.pn; } else { base = AQKV8; ldc = 2304; ct = u.pn - 8; }
        const int col0 = ct * BM + wc * 64 + 16 * fq; const float sq = (float)(1 << SH_Q);
        EPI_ROWS_BEGIN { unsigned char* rowp = base + (size_t)(u.pm * BM + rt) * ldc + col0;
            const f32x4 a = acc[ai][0][m][0] * sq, b = acc[ai][0][m][1] * sq, c = acc[ai][1][m][0] * sq, d = acc[ai][1][m][1] * sq;
            *(v4u*)rowp = (v4u){cvt4_fp8(a[0], a[1], a[2], a[3]), cvt4_fp8(b[0], b[1], b[2], b[3]), cvt4_fp8(c[0], c[1], c[2], c[3]), cvt4_fp8(d[0], d[1], d[2], d[3])}; } EPI_ROWS_END
    }
};
template <bool ADD> struct EpiBranch { static constexpr int MID_T = 0;
    const unsigned char* G; int goff; bf16* O;
    __device__ __forceinline__ void operator()(const f32x4 (&acc)[2][2][4][2], const Unit& u, int wr, int wc, int fr, int fq) const {
        const int col0 = u.pn * BM + wc * WCS + 8 * fq;
        EPI_ROWS_BEGIN { const size_t row = (size_t)(u.pm * BM + rt);
#pragma unroll
            for (int bj = 0; bj < 2; ++bj) {
                const v2u g = *(const v2u*)(G + row * 2048 + goff + col0 + bj * BJS); const float gs = 1.0f / (float)(1 << SH_G);
                const f32x2_t g0 = __builtin_amdgcn_cvt_pk_f32_fp8((int)g.x, false), g1 = __builtin_amdgcn_cvt_pk_f32_fp8((int)g.x, true), g2 = __builtin_amdgcn_cvt_pk_f32_fp8((int)g.y, false), g3 = __builtin_amdgcn_cvt_pk_f32_fp8((int)g.y, true);
                f32x4 a = acc[ai][bj][m][0] * (f32x4){g0[0], g0[1], g1[0], g1[1]} * gs, b = acc[ai][bj][m][1] * (f32x4){g2[0], g2[1], g3[0], g3[1]} * gs;
                bf16* op = O + row * 1024 + col0 + bj * BJS;
                if (ADD) { const v4u o = *(const v4u*)op; a[0] += bflo(o.x); a[1] += bfhi(o.x); a[2] += bflo(o.y); a[3] += bfhi(o.y); b[0] += bflo(o.z); b[1] += bfhi(o.z); b[2] += bflo(o.w); b[3] += bfhi(o.w); }
                *(v4u*)op = pack8(a, b); } } EPI_ROWS_END
    }
};
struct EpiMerge {
    static constexpr int MID_T = 4;
    const unsigned char* G; unsigned char* O;
    __device__ __forceinline__ static void dec8(const v2u g, float (&f)[8]) { const f32x2_t a = __builtin_amdgcn_cvt_pk_f32_fp8((int)g.x, false), b = __builtin_amdgcn_cvt_pk_f32_fp8((int)g.x, true), c = __builtin_amdgcn_cvt_pk_f32_fp8((int)g.y, false), d = __builtin_amdgcn_cvt_pk_f32_fp8((int)g.y, true);
        f[0] = a[0]; f[1] = a[1]; f[2] = b[0]; f[3] = b[1]; f[4] = c[0]; f[5] = c[1]; f[6] = d[0]; f[7] = d[1]; }
    __device__ __forceinline__ void mid(f32x4 (&acc)[2][2][4][2], const Unit& u, int wr, int wc, int fr, int fq) const {
        const int col0 = u.pn * BM + wc * 64 + 16 * fq;
        EPI_ROWS_BEGIN { const size_t row = (size_t)(u.pm * BM + rt);
            const v4u ga = *(const v4u*)(G + row * 2048 + col0), gb = *(const v4u*)(G + row * 2048 + 1024 + col0);
#pragma unroll
            for (int bj = 0; bj < 2; ++bj) { float sa[8], sb[8]; dec8(bj ? (v2u){ga.z, ga.w} : (v2u){ga.x, ga.y}, sa); dec8(bj ? (v2u){gb.z, gb.w} : (v2u){gb.x, gb.y}, sb);
#pragma unroll
                for (int j = 0; j < 4; ++j) { acc[ai][bj][m][0][j] *= sa[j] * __builtin_amdgcn_rcpf(fmaxf(sb[j], 0.001953125f)); acc[ai][bj][m][1][j] *= sa[4 + j] * __builtin_amdgcn_rcpf(fmaxf(sb[4 + j], 0.001953125f)); } } } EPI_ROWS_END
    }
    __device__ __forceinline__ void operator()(const f32x4 (&acc)[2][2][4][2], const Unit& u, int wr, int wc, int fr, int fq) const {
        const int col0 = u.pn * BM + wc * 64 + 16 * fq;
        EPI_ROWS_BEGIN { const size_t row = (size_t)(u.pm * BM + rt);
            const v4u gb = *(const v4u*)(G + row * 2048 + 1024 + col0); unsigned ow[4];
#pragma unroll
            for (int bj = 0; bj < 2; ++bj) { float sb[8]; dec8(bj ? (v2u){gb.z, gb.w} : (v2u){gb.x, gb.y}, sb); const float gs = 1.0f / (float)(1 << SH_G);
                f32x4 a = acc[ai][bj][m][0], b = acc[ai][bj][m][1];
#pragma unroll
                for (int j = 0; j < 4; ++j) { a[j] *= fmaxf(sb[j], 0.001953125f) * (gs * (float)(1 << SH_M)); b[j] *= fmaxf(sb[4 + j], 0.001953125f) * (gs * (float)(1 << SH_M)); }
                ow[2 * bj] = cvt4_fp8(a[0], a[1], a[2], a[3]); ow[2 * bj + 1] = cvt4_fp8(b[0], b[1], b[2], b[3]); }
            *(v4u*)(O + row * 1024 + col0) = (v4u){ow[0], ow[1], ow[2], ow[3]}; } EPI_ROWS_END
    }
};
struct EpiOut { static constexpr int MID_T = 0;
    const float* x; bf16* x1; const float* mod;
    __device__ __forceinline__ void operator()(const f32x4 (&acc)[2][2][4][2], const Unit& u, int wr, int wc, int fr, int fq) const {
        const int col0 = u.pn * BM + wc * WCS + 8 * fq; const int b = u.pm >> 4;
        f32x4 gt[2][2];
#pragma unroll
        for (int bj = 0; bj < 2; ++bj)
#pragma unroll
            for (int n = 0; n < 2; ++n) { const int c = 2048 + col0 + bj * BJS + 4 * n; gt[bj][n] = *(const f32x4*)(mod + b * 6144 + c); }
        EPI_ROWS_BEGIN { const size_t off = (size_t)(u.pm * BM + rt) * 1024 + col0;
#pragma unroll
            for (int bj = 0; bj < 2; ++bj) { const size_t o2 = off + bj * BJS;
                *(v4u*)(x1 + o2) = pack8(*(const f32x4*)(x + o2) + gt[bj][0] * acc[ai][bj][m][0], *(const f32x4*)(x + o2 + 4) + gt[bj][1] * acc[ai][bj][m][1]); } } EPI_ROWS_END
    }
};
__device__ __forceinline__ v4u swiglu8(const f32x4 g0, const f32x4 g1, const f32x4 u0, const f32x4 u1) {
    f32x4 a, b;
#pragma unroll
    for (int j = 0; j < 4; ++j) { a[j] = fsilu(g0[j]) * u0[j]; b[j] = fsilu(g1[j]) * u1[j]; }
    return pack8(a, b);
}
__device__ __forceinline__ v2u swiglu8_fp8(const f32x4 g0, const f32x4 g1, const f32x4 u0, const f32x4 u1) {
    const float sc = (float)(1 << SH_HMID); float a[4], b[4];
#pragma unroll
    for (int j = 0; j < 4; ++j) { a[j] = fsilu(g0[j]) * u0[j] * sc; b[j] = fsilu(g1[j]) * u1[j] * sc; }
    v2u w; w.x = cvt4_fp8(a[0], a[1], a[2], a[3]); w.y = cvt4_fp8(b[0], b[1], b[2], b[3]); return w;
}
struct EpiRS { static constexpr int MID_T = 0;
    float* logits; unsigned char* hsh;
    __device__ __forceinline__ void operator()(const f32x4 (&acc)[2][2][4][2], const Unit& u, int wr, int wc, int fr, int fq) const {
        if (u.pn == 0) {
            EPI_ROWS_BEGIN { float* rowp = logits + (size_t)(u.pm * BM + rt) * 256 + wc * WCS + 8 * fq;
#pragma unroll
                for (int bj = 0; bj < 2; ++bj)
#pragma unroll
                    for (int n = 0; n < 2; ++n) *(f32x4*)(rowp + bj * BJS + 4 * n) = acc[ai][bj][m][n]; } EPI_ROWS_END
        } else {
            const int hc = (u.pn - 1) * HALF + wc * WCS + 8 * fq;
            EPI_ROWS_BEGIN { *(v2u*)(hsh + (size_t)(u.pm * BM + rt) * 256 + hc) = swiglu8_fp8(acc[ai][0][m][0], acc[ai][0][m][1], acc[ai][1][m][0], acc[ai][1][m][1]); } EPI_ROWS_END
        }
    }
};
struct EpiRL { static constexpr int MID_T = 0;
    float* logits;
    __device__ __forceinline__ void operator()(const f32x4 (&acc)[2][2][4][2], const Unit& u, int wr, int wc, int fr, int fq) const {
        EPI_ROWS_BEGIN { float* rowp = logits + (size_t)(u.pm * BM + rt) * 256 + wc * WCS + 8 * fq;
#pragma unroll
            for (int bj = 0; bj < 2; ++bj)
#pragma unroll
                for (int n = 0; n < 2; ++n) *(f32x4*)(rowp + bj * BJS + 4 * n) = acc[ai][bj][m][n]; } EPI_ROWS_END
    }
};
struct EpiGU { static constexpr int MID_T = 0;
    unsigned char* hmid;
    __device__ __forceinline__ void operator()(const f32x4 (&acc)[2][2][4][2], const Unit& u, int wr, int wc, int fr, int fq) const {
        const int hc = u.pn * HALF + wc * 32 + 8 * fq;
        EPI_ROWS_BEGIN { if (rt < u.rows) *(v2u*)(hmid + (size_t)(u.row0 + rt) * 256 + hc) = swiglu8_fp8(acc[ai][0][m][0], acc[ai][0][m][1], acc[ai][1][m][0], acc[ai][1][m][1]); } EPI_ROWS_END
    }
};
struct EpiSD { static constexpr int MID_T = 0;
    bf16* ysh;
    __device__ __forceinline__ void operator()(const f32x4 (&acc)[2][2][4][2], const Unit& u, int wr, int wc, int fr, int fq) const {
        const int col0 = u.pn * BM + wc * WCS + 8 * fq;
        EPI_ROWS_BEGIN { bf16* rowp = ysh + (size_t)(u.pm * BM + rt) * 1024 + col0;
#pragma unroll
            for (int bj = 0; bj < 2; ++bj) *(v4u*)(rowp + bj * BJS) = pack8(acc[ai][bj][m][0], acc[ai][bj][m][1]); } EPI_ROWS_END
    }
};
struct EpiRD { static constexpr int MID_T = 0;
    unsigned char* yslot; const float* slot_w;
    __device__ __forceinline__ void operator()(const f32x4 (&acc)[2][2][4][2], const Unit& u, int wr, int wc, int fr, int fq) const {
        const int col0 = u.pn * BM + wc * 64 + 16 * fq;
        EPI_ROWS_BEGIN { if (rt < u.rows) { const float w = (float)(1 << SH_Y); unsigned char* rowp = yslot + (size_t)(u.row0 + rt) * 1024 + col0;
            const f32x4 a = acc[ai][0][m][0] * w, b = acc[ai][0][m][1] * w, c = acc[ai][1][m][0] * w, d = acc[ai][1][m][1] * w;
            *(v4u*)rowp = (v4u){cvt4_fp8(a[0], a[1], a[2], a[3]), cvt4_fp8(b[0], b[1], b[2], b[3]), cvt4_fp8(c[0], c[1], c[2], c[3]), cvt4_fp8(d[0], d[1], d[2], d[3])}; } } EPI_ROWS_END
    }
};
}

struct Args { const float* in[21]; float* out; unsigned char* ws; int ph_lo, ph_hi; };
struct Frame {
    LAS unsigned char* lds; volatile LAS unsigned* MISC; gu32* ctl;
    int tid, lane, wave, vcu, G, gw, NGW;
};

__device__ __forceinline__ void transpose_item(const float* W, int ldn, bf16* WT, int ldk, int k0, int n0, int drow0, LAS float* scr, int lane) {
#pragma unroll 8
    for (int i = 0; i < 32; ++i) { const int kk = 2 * i + (lane >> 5); scr[kk * 33 + (lane & 31)] = W[(size_t)(k0 + kk) * ldn + n0 + (lane & 31)]; }
    LDS_WAIT(); asm volatile("" ::: "memory");
    const int c = lane & 7;
#pragma unroll
    for (int j = 0; j < 4; ++j) { const int n = (lane >> 3) + 8 * j; const LAS float* s = scr + (8 * c) * 33 + n;
        v4u o; o.x = cvt_pk_bf16(s[0 * 33], s[1 * 33]); o.y = cvt_pk_bf16(s[2 * 33], s[3 * 33]); o.z = cvt_pk_bf16(s[4 * 33], s[5 * 33]); o.w = cvt_pk_bf16(s[6 * 33], s[7 * 33]);
        *(GAS v4u*)(WT + (size_t)(drow0 + n) * ldk + k0 + 8 * c) = o; }
    LDS_WAIT(); asm volatile("" ::: "memory");
}
struct ConvDesc { const float* W; unsigned char* WT; int ldn, ldk, k0, n0, drow0; float scale; };
__device__ __forceinline__ void ti_load(const ConvDesc& d, int lane, f32x4 (&r)[16]) {
#pragma unroll
    for (int i = 0; i < 16; ++i) r[i] = *(const f32x4*)(d.W + (size_t)(d.k0 + 8 * i + (lane >> 3)) * d.ldn + d.n0 + (lane & 7) * 4);
}
#ifndef TR8_MAP
#define TR8_MAP 0
#endif
typedef int v2i_t __attribute__((ext_vector_type(2)));
__device__ __forceinline__ void ti_store(const ConvDesc& d, const f32x4 (&r)[16], LAS float* scr, int lane) {
    LAS unsigned char* Tl = (LAS unsigned char*)scr; const float sc = d.scale;
#pragma unroll
    for (int i = 0; i < 16; ++i) *(LAS unsigned*)(Tl + (8 * i + (lane >> 3)) * 32 + (lane & 7) * 4) = cvt4_fp8(r[i][0] * sc, r[i][1] * sc, r[i][2] * sc, r[i][3] * sc);
    LDS_WAIT(); asm volatile("" ::: "memory");
    const int g = lane >> 4, l = lane & 15, nh = g & 1, ch = g >> 1, n = 16 * nh + l;
    const int rr = TR8_MAP ? (l & 7) : (l >> 1), cc = TR8_MAP ? (l >> 3) : (l & 1);
    LAS unsigned char* T2 = Tl + 4096;
#pragma unroll
    for (int j = 0; j < 4; ++j) { const int c = 4 * ch + j;
        const v2i_t lo = __builtin_amdgcn_ds_read_tr8_b64_v2i32((LAS v2i_t*)(Tl + (16 * c + rr) * 32 + 16 * nh + 8 * cc));
        const v2i_t hi = __builtin_amdgcn_ds_read_tr8_b64_v2i32((LAS v2i_t*)(Tl + (16 * c + 8 + rr) * 32 + 16 * nh + 8 * cc));
        *(LAS v4u*)(T2 + n * 144 + 16 * c) = (v4u){(unsigned)lo.x, (unsigned)lo.y, (unsigned)hi.x, (unsigned)hi.y}; }
    LDS_WAIT(); asm volatile("" ::: "memory");
#pragma unroll
    for (int j = 0; j < 4; ++j) { const int n2 = (lane >> 3) + 8 * j, c2 = lane & 7;
        *(GAS v4u*)(d.WT + (size_t)(d.drow0 + n2) * d.ldk + d.k0 + 16 * c2) = *(const LAS v4u*)(T2 + n2 * 144 + 16 * c2); }
    LDS_WAIT(); asm volatile("" ::: "memory");
}
__device__ __forceinline__ ConvDesc conv_desc_fp8(const float* W, int K, int N, unsigned char* WT, int mode, int rowbase, int item, float scale) {
    const int nblk = N / 32, kb = item / nblk, nb = item % nblk, k0 = 128 * kb, n0 = 32 * nb;
    int drow0 = rowbase + n0;
    if (mode) drow0 = rowbase + (n0 >> 5) * 64 + (mode - 1) * 32;
    return ConvDesc{W, WT, N, K, k0, n0, drow0, scale};
}
__device__ __forceinline__ void conv_item(const float* W, int K, int N, bf16* WT, int mode, int rowbase, int item, LAS float* scr, int lane) {
    const int nblk = N / 32, kb = item / nblk, nb = item % nblk, k0 = 64 * kb, n0 = 32 * nb;
    int drow0 = rowbase + n0;
    if (mode) drow0 = rowbase + (n0 >> 7) * 256 + (mode - 1) * 128 + (n0 & 127);
    transpose_item(W, N, WT, K, k0, n0, drow0, scr, lane);
}

__global__ void __launch_bounds__(NWAVES * 64, 2) mk_fwd(Args args) {
    extern __shared__ __attribute__((aligned(16))) unsigned char lds_raw[];
    Frame F;
    F.lds = (LAS unsigned char*)lds_raw;
    F.MISC = (volatile LAS unsigned*)(F.lds + MISC_OFF);
    F.tid = threadIdx.x; F.lane = F.tid & 63; F.wave = __builtin_amdgcn_readfirstlane(F.tid >> 6);
    F.G = gridDim.x; { const int bx = blockIdx.x; F.vcu = (F.G % 8 == 0) ? (bx % 8) * (F.G / 8) + bx / 8 : bx; }
    F.gw = F.vcu * NWAVES + F.wave; F.NGW = F.G * NWAVES;
    unsigned char* ws = args.ws;
    F.ctl = (gu32*)(ws + WS_CTL);
    const int tid = F.tid, lane = F.lane, wave = F.wave;
    LAS unsigned char* lds = F.lds;

#define X_IN (args.in[0])
#define cvec (args.in[1])
#define ada_w (args.in[2])
#define ada_b (args.in[3])
#define norm1_g (args.in[4])
#define w_in (args.in[5])
#define lb_logits (args.in[6])
#define hg_norm_g (args.in[7])
#define w_branch_a (args.in[8])
#define w_branch_b (args.in[9])
#define w_out (args.in[10])
#define norm2_g (args.in[11])
#define w_router (args.in[12])
#define router_bias (args.in[13])
#define w_exp_gate (args.in[14])
#define w_exp_up (args.in[15])
#define w_exp_down (args.in[16])
#define w_sh_gate (args.in[17])
#define w_sh_up (args.in[18])
#define w_sh_down (args.in[19])
#define final_g (args.in[20])
#define out (args.out)
#define WIN_T ((bf16*)(ws + WS_WIN_T))
#define WA_T ((bf16*)(ws + WS_WA_T))
#define WB_T ((bf16*)(ws + WS_WB_T))
#define WO_T ((bf16*)(ws + WS_WO_T))
#define RS_T ((bf16*)(ws + WS_RS_T))
#define WSD_T ((bf16*)(ws + WS_WSD_T))
#define WD ((bf16*)(ws + WS_WD))
#define WGU ((bf16*)(ws + WS_WGU))
#define PE ((int*)(ws + WS_PE))
#define PR ((int*)(ws + WS_PR))
#define PW ((float*)(ws + WS_PW))
#define SLOT_TOK ((int*)(ws + WS_SLOT_TOK))
#define SLOT_W ((float*)(ws + WS_SLOT_W))
#define TOK_SLOT ((int*)(ws + WS_TOK_SLOT))
#define LSE ((float*)(ws + WS_LSE))
#define QF ((bf16*)(ws + WS_QF))
#define OA ((bf16*)(ws + WS_OA))
#define OG ((bf16*)(ws + WS_OG))
#define MERGED ((bf16*)(ws + WS_MERGED))
#define HMID ((bf16*)(ws + WS_HMID))
#define YSH (((unsigned char*)(ws + WS_YSLOT)) + (size_t)NSLOTP * 1024)
#define AQKV ((bf16*)(ws + WS_AQKV))
#define GAB ((bf16*)(ws + WS_GAB))
#define XN ((bf16*)(ws + WS_XN))
#define YA ((bf16*)(ws + WS_YA))
#define YB ((bf16*)(ws + WS_YB))
#define H2 ((bf16*)(ws + WS_H2))
#define LOGITS ((float*)(ws + WS_LOGITS))
#define YSLOT ((bf16*)(ws + WS_YSLOT))
#define MOD ((float*)(ws + WS_MOD))
#define HISTG ((unsigned*)(ws + WS_HISTG))
#define ATTQ (((unsigned*)(ws + WS_CTL)) + CW_ATTQ)
    for (int u = tid; u < 64; u += NWAVES * 64) ((LAS unsigned*)(lds + MISC_OFF))[u] = 0u;
    __syncthreads();
    XcdBarrier bar = xcd_barrier_post((unsigned*)(F.ctl + CW_BAR), F.MISC + 8);
    const int lo = args.ph_lo, hi = args.ph_hi;
#ifndef PHMASK
#define PHMASK 0x3fff
#endif
#define IN(k) (((PHMASK >> (k)) & 1) && lo <= (k) && (k) < hi)
#define SEAM(k) do { if (IN(k) && IN((k) + 1)) xcd_barrier(bar); } while (0)
#ifndef ALIGN_P2
#define ALIGN_P2 true
#endif
#ifndef ALIGN_P12
#define ALIGN_P12 true
#endif
#ifndef ALIGN_DEFAULT
#define ALIGN_DEFAULT true
#endif
#ifndef REPMASK
#define REPMASK 0
#endif
#ifndef CONV2_ITEMS
#define CONV2_ITEMS 42000
#endif
#ifndef DBG_H1_ST
#define DBG_H1_ST 1
#endif
#ifndef DBG_ATT_NOLOAD
#define DBG_ATT_NOLOAD 0
#endif
#ifndef TKI
#define TKI 8
#endif
#ifndef CONV11_ITEMS
#define CONV11_ITEMS 7000
#endif
#ifndef CONV11_MINWG
#define CONV11_MINWG 16
#endif
#ifndef P2_GEMM_WGS
#define P2_GEMM_WGS 178
#endif
#define REPS(k) (((REPMASK >> (k)) & 1) ? 2 : 1)
#define REP_BEGIN(k) _Pragma("unroll") for (int rep = 0; rep < REPS(k); ++rep) {
#define REP_END(k) if (rep + 1 < REPS(k)) xcd_barrier(bar); }

        constexpr int I_IN = 8 * 200, I_A = 4 * 32, I_B = 2 * 32, I_O = 8 * 32, I_SD = 2 * 32, I_E = 8 * 8, I_ED = 2 * 32;
        constexpr int NSMALL = I_IN + I_A + I_B + I_O + I_SD;
        constexpr int NITEMS = NSMALL + 2 * (NEXP + 1) * I_E + NEXP * I_ED;
    constexpr int NCONV2 = CONV2_ITEMS;
    const int NGB = (F.G == 256 && NCONV2 > 0) ? P2_GEMM_WGS : F.G;
    constexpr int NCONV11 = CONV11_ITEMS;
    static_assert(NITEMS - NCONV2 - NCONV11 >= I_IN, "the input-projection weights must be converted in P0");
    const int nitems0 = (NGB < F.G) ? NITEMS - NCONV2 - NCONV11 : NITEMS;
    auto conv_desc = [&](int it) __attribute__((always_inline)) -> ConvDesc {
            int r = it;
            if (r < I_IN) return conv_desc_fp8(w_in, 1024, NIN, (unsigned char*)WIN_T, 0, 0, r, (float)(1 << SH_WGU)); r -= I_IN;
            if (r < I_A) { const int kb = r / 32, nb = r % 32; return ConvDesc{w_branch_a, (unsigned char*)WA_T, 1024, 768, 128 * kb, 32 * nb, 32 * nb, (float)(1 << SH_WAB)}; } r -= I_A;
            if (r < I_B) { const int kb = r / 32, nb = r % 32; return ConvDesc{w_branch_b, (unsigned char*)WA_T + 512, 1024, 768, 128 * kb, 32 * nb, 32 * nb, (float)(1 << SH_WAB)}; } r -= I_B;
            if (r < I_O) return conv_desc_fp8(w_out, 1024, 1024, (unsigned char*)WO_T, 0, 0, r, (float)(1 << SH_WGU)); r -= I_O;
            if (r < I_SD) return conv_desc_fp8(w_sh_down, 256, 1024, (unsigned char*)WD, 0, NEXP * 1024, r, (float)(1 << SH_WD)); r -= I_SD;
            if (r < 2 * (NEXP + 1) * I_E) { const int seg = r / ((NEXP + 1) * I_E), rr = r % ((NEXP + 1) * I_E), e = rr / I_E, ii = rr % I_E;
                const float* src = (seg == 0) ? (e < NEXP ? w_exp_gate + (size_t)e * 1024 * 256 : w_sh_gate) : (e < NEXP ? w_exp_up + (size_t)e * 1024 * 256 : w_sh_up);
                return conv_desc_fp8(src, 1024, 256, (unsigned char*)WGU, seg + 1, e * 512, ii, (float)(1 << SH_WGU)); }
            r -= 2 * (NEXP + 1) * I_E; const int e = r / I_ED, ii = r % I_ED;
            return conv_desc_fp8(w_exp_down + (size_t)e * 256 * 1024, 256, 1024, (unsigned char*)WD, 0, e * 1024, ii, (float)(1 << SH_WD));
    };
    auto conv_run = [&](int first, int end, int stride, LAS float* scr) __attribute__((always_inline)) {
        int it = first; if (it >= end) return;
        ConvDesc d = conv_desc(it); f32x4 r[16]; ti_load(d, lane, r);
        for (;;) {
            const int nx = it + stride; const bool more = nx < end;
            ConvDesc dn = d; f32x4 rn[16];
            if (more) { dn = conv_desc(nx); ti_load(dn, lane, rn); }
            ti_store(d, r, scr, lane);
            if (!more) break;
            d = dn; it = nx;
#pragma unroll
            for (int i = 0; i < 16; ++i) r[i] = rn[i];
        }
    };

    if (IN(0)) { REP_BEGIN(0)
        {
            LAS float* sc = (LAS float*)lds; LAS float* red = (LAS float*)(lds + 32768);
            for (int i = tid; i < NB * D; i += NWAVES * 64) sc[i] = fsilu(cvec[i]);
            __syncthreads();
            _Pragma("unroll") for (int sr = 0; sr < (((REPMASK >> 19) & 1) ? 2 : 1); ++sr)
            for (int cbk = blockIdx.x; cbk < 256; cbk += F.G) {
                const int j0 = cbk * 24, kg = tid >> 3, cc = tid & 7;
                float a8[8][3];
#pragma unroll
                for (int b = 0; b < 8; ++b) { a8[b][0] = 0.f; a8[b][1] = 0.f; a8[b][2] = 0.f; }
                for (int r = 0; r < 16; ++r) { const int i = kg * 16 + r; const float* wp = ada_w + (size_t)i * 6144 + j0 + 3 * cc; const float w0 = wp[0], w1 = wp[1], w2 = wp[2];
#pragma unroll
                    for (int b = 0; b < 8; ++b) { const float sv = sc[b * 1024 + i]; a8[b][0] += sv * w0; a8[b][1] += sv * w1; a8[b][2] += sv * w2; } }
#pragma unroll
                for (int b = 0; b < 8; ++b) { red[(kg * 8 + b) * 24 + 3 * cc + 0] = a8[b][0]; red[(kg * 8 + b) * 24 + 3 * cc + 1] = a8[b][1]; red[(kg * 8 + b) * 24 + 3 * cc + 2] = a8[b][2]; }
                __syncthreads();
                if (tid < 192) { const int b = tid / 24, col = tid % 24; float sum = ada_b[j0 + col];
                    for (int g = 0; g < 64; ++g) sum += red[(g * 8 + b) * 24 + col];
                    MOD[b * 6144 + j0 + col] = sum; }
                __syncthreads();
            }
        }
        LAS float* scr = (LAS float*)(lds + wave * 16384);
        conv_run(F.gw, nitems0, F.NGW, scr);
    REP_END(0) }
    SEAM(0);

    if (IN(1)) { REP_BEGIN(1)
        for (int m0 = F.gw * 16; m0 < T; m0 += F.NGW * 16) {
            const int b = m0 >> 12;
            f32x4 mul[4], add[4];
#pragma unroll
            for (int j = 0; j < 4; ++j) { const int c = 4 * lane + 256 * j;
                const f32x4 s1 = *(const f32x4*)(MOD + b * 6144 + 1024 + c);
                mul[j] = *(const f32x4*)(norm1_g + c) * (s1 + 1.0f);
                add[j] = *(const f32x4*)(MOD + b * 6144 + c); }
            for (int m = m0; m < m0 + 16; ++m) {
                const GAS f32x4* xr = (const GAS f32x4*)(X_IN + (size_t)m * D) + lane;
                f32x4 v[4]; float s = 0.f;
#pragma unroll
                for (int j = 0; j < 4; ++j) { v[j] = xr[64 * j]; s += (v[j].x * v[j].x + v[j].y * v[j].y) + (v[j].z * v[j].z + v[j].w * v[j].w); }
                const float rstd = 1.0f / sqrtf(wave_sum(s) * (1.f / D) + RMS_EPS);
                GAS unsigned* o4 = (GAS unsigned*)((unsigned char*)XN + (size_t)m * D) + lane;
#pragma unroll
                for (int j = 0; j < 4; ++j) { const f32x4 y = v[j] * rstd * mul[j] + add[j]; const float sx = (float)(1 << SH_X); o4[64 * j] = cvt4_fp8(y.x * sx, y.y * sx, y.z * sx, y.w * sx); }
            }
        }
        for (int it = blockIdx.x; it < 256; it += F.G) {
            const int b = it >> 5, e = tid & 255, dh = tid >> 8, d0 = 32 * (it & 31) + 16 * dh;
            float wv[16];
#pragma unroll
            for (int j = 0; j < 16; ++j) wv[j] = w_router[(size_t)(d0 + j) * 256 + e];
            float part = 0.f; unsigned pk[8];
#pragma unroll
            for (int j = 0; j < 16; j += 2) {
                const float a0 = norm2_g[d0 + j] * (1.0f + MOD[b * 6144 + 4096 + d0 + j]), a1 = norm2_g[d0 + j + 1] * (1.0f + MOD[b * 6144 + 4096 + d0 + j + 1]);
                part += MOD[b * 6144 + 3072 + d0 + j] * wv[j]; part += MOD[b * 6144 + 3072 + d0 + j + 1] * wv[j + 1];
                pk[j >> 1] = cvt_pk_bf16(wv[j] * a0, wv[j + 1] * a1); }
            GAS v4u* wp = (GAS v4u*)((bf16*)(ws + WS_WRB) + ((size_t)(b * 256 + e) * 1024 + d0));
            v4u o0, o1; o0.x = pk[0]; o0.y = pk[1]; o0.z = pk[2]; o0.w = pk[3]; o1.x = pk[4]; o1.y = pk[5]; o1.z = pk[6]; o1.w = pk[7]; wp[0] = o0; wp[1] = o1;
            ((float*)(ws + WS_PART))[(size_t)(b * 64 + (it & 31) * 2 + dh) * 256 + e] = part;
        }
    REP_END(1) }
    SEAM(1);

    if (IN(2)) { REP_BEGIN(2)
        if ((int)blockIdx.x < NGB) {
            pg8::DenseSched S; S.init(T, NIN, 1024, NGB, (int)blockIdx.x, WIN_T);
            pg8::EpiWin E{(unsigned char*)QF, (unsigned char*)AQKV, (unsigned char*)GAB, (unsigned char*)GAB + (size_t)T * 2048, 0};
            pg8::gemm_phase<ALIGN_P2, true, pg8::EpiWin, pg8::DenseSched, 2>(lds, (const char*)XN, 1024, S, E, SC_WGU, SC_X);
        } else {
            LAS float* scr2 = (LAS float*)(lds + wave * 16384);
            conv_run(nitems0 + ((int)blockIdx.x - NGB) * NWAVES + wave, NITEMS - NCONV11, (F.G - NGB) * NWAVES, scr2);
        }
    REP_END(2) }
    SEAM(2);

    if (IN(3)) { REP_BEGIN(3)
        const int fr = lane & 15, fq = lane >> 4;
        bf16* QTB = (bf16*)(ws + WS_QTB); unsigned char* UT = (unsigned char*)(ws + WS_UT); float* DKB = (float*)(ws + WS_DK);
        {
            constexpr int NH1 = NB * 4 * 64, NATT = NB * 3 * 4 * 32;
            {
                const int kq = tid & 31, rg = tid >> 5, vrow = tid >> 3, v16 = (tid & 7) * 16;
                unsigned rq[4], rf[4]; v4u rv0;
                const unsigned char* QF8 = (const unsigned char*)QF;
#define H1_LOAD(w) do { const int b_ = (w) >> 8, h_ = ((w) >> 6) & 3, c_ = (w) & 63; const size_t r0_ = (size_t)(b_ * SEQ + c_ * 64); \
                _Pragma("unroll") for (int rr = 0; rr < 4; ++rr) { const size_t ro = (r0_ + rg * 4 + rr) * 1536 + h_ * 128 + 4 * kq; rq[rr] = *(const unsigned*)(QF8 + ro); rf[rr] = *(const unsigned*)(QF8 + ro + 512); } \
                rv0 = *(const v4u*)(QF8 + (r0_ + vrow) * 1536 + 1024 + h_ * 128 + v16); } while (0)
                if ((int)blockIdx.x < NH1) { H1_LOAD((int)blockIdx.x); }
                _Pragma("unroll") for (int sr = 0; sr < (((REPMASK >> 16) & 1) ? 2 : 1); ++sr) { if (sr) { H1_LOAD((int)blockIdx.x); }
                int hprev = -1; float lbv[4] = {0.f, 0.f, 0.f, 0.f};
                for (int wi = blockIdx.x, j1 = 0; wi < NH1; wi += F.G, ++j1) {
                    const int b = wi >> 8, h = (wi >> 6) & 3, c = wi & 63;
                    constexpr int QT_S = 272, KH_S = 144, VR_S = 288;
                    LAS unsigned char* Qt = lds;
                    LAS unsigned char* Kt = lds + 17408;
                    LAS unsigned char* Kh = lds + 34816;
                    LAS unsigned char* Vr = lds + 53248;
                    LAS unsigned char* Asc = lds + 71680;
                    LAS float* btot = (LAS float*)(lds + 80896);
                    if (h != hprev) { hprev = h;
                        const f32x4 l0 = *(const f32x4*)(lb_logits + h * 128 + 4 * kq), l1 = *(const f32x4*)(lb_logits + 512 + h * 128 + 4 * kq);
#pragma unroll
                        for (int ch = 0; ch < 4; ++ch) lbv[ch] = 1.0f / (1.0f + __expf(l1[ch] - l0[ch])); }
                    const size_t row0 = (size_t)(b * SEQ + c * 64);
                    const float rq_ = 1.0f / (float)(1 << SH_Q);
                    LBAR();
                    for (int i = tid; i < 9216 / 4; i += NWAVES * 64) ((LAS unsigned*)Asc)[i] = 0u;
                    float kk[4][4], bl[4][4]; float run[4] = {0.f, 0.f, 0.f, 0.f};
#pragma unroll
                    for (int rr = 0; rr < 4; ++rr) { const f32x2_t lo = __builtin_amdgcn_cvt_pk_f32_fp8((int)rf[rr], false), hi = __builtin_amdgcn_cvt_pk_f32_fp8((int)rf[rr], true); const float fv[4] = {lo[0], lo[1], hi[0], hi[1]};
#pragma unroll
                        for (int ch = 0; ch < 4; ++ch) { const float sg = fsigmoid(fv[ch] * rq_); const float f = lbv[ch] + (1.0f - lbv[ch]) * sg; run[ch] += __logf(f); bl[rr][ch] = run[ch]; kk[rr][ch] = (1.0f - lbv[ch]) * (1.0f - sg); } }
                    *(LAS f32x4*)(btot + rg * 128 + 4 * kq) = (f32x4){run[0], run[1], run[2], run[3]};
                    {   const unsigned vw[4] = {rv0.x, rv0.y, rv0.z, rv0.w}; unsigned w8[8];
#pragma unroll
                        for (int j = 0; j < 4; ++j) { const f32x2_t lo = __builtin_amdgcn_cvt_pk_f32_fp8((int)vw[j], false), hi = __builtin_amdgcn_cvt_pk_f32_fp8((int)vw[j], true); w8[2 * j] = cvt_pk_bf16(lo[0] * rq_, lo[1] * rq_); w8[2 * j + 1] = cvt_pk_bf16(hi[0] * rq_, hi[1] * rq_); }
                        *(LAS v4u*)(Vr + vrow * VR_S + v16 * 2) = (v4u){w8[0], w8[1], w8[2], w8[3]}; *(LAS v4u*)(Vr + vrow * VR_S + v16 * 2 + 16) = (v4u){w8[4], w8[5], w8[6], w8[7]}; }
                    LBAR();
                    float pre[4] = {0.f, 0.f, 0.f, 0.f}, bend[4] = {0.f, 0.f, 0.f, 0.f};
#pragma unroll
                    for (int g = 0; g < 16; ++g) { const f32x4 tg = *(const LAS f32x4*)(btot + g * 128 + 4 * kq);
#pragma unroll
                        for (int ch = 0; ch < 4; ++ch) { if (g < rg) pre[ch] += tg[ch]; bend[ch] += tg[ch]; } }
#pragma unroll
                    for (int rr = 0; rr < 4; ++rr) { const f32x2_t lo = __builtin_amdgcn_cvt_pk_f32_fp8((int)rq[rr], false), hi = __builtin_amdgcn_cvt_pk_f32_fp8((int)rq[rr], true); const float qf4[4] = {lo[0], lo[1], hi[0], hi[1]};
                        float qv[4], kv[4], kh[4];
#pragma unroll
                        for (int ch = 0; ch < 4; ++ch) { const float bb = pre[ch] + bl[rr][ch]; qv[ch] = qf4[ch] * rq_ * __expf(bb); kv[ch] = kk[rr][ch] * __expf(fminf(-bb, 80.f)); kh[ch] = kk[rr][ch] * __expf(bend[ch] - bb); }
                        *(LAS v2u*)(Qt + (rg * 4 + rr) * QT_S + kq * 8) = (v2u){cvt_pk_bf16(qv[0], qv[1]), cvt_pk_bf16(qv[2], qv[3])};
                        *(LAS v2u*)(Kt + (rg * 4 + rr) * QT_S + kq * 8) = (v2u){cvt_pk_bf16(kv[0], kv[1]), cvt_pk_bf16(kv[2], kv[3])};
                        *(LAS v2u*)(Kh + (rg * 4 + rr) * VR_S + kq * 8) = (v2u){cvt_pk_bf16(kh[0], kh[1]), cvt_pk_bf16(kh[2], kh[3])}; }
                    if (rg == 0) *(f32x4*)(DKB + (size_t)wi * 128 + 4 * kq) = (f32x4){__expf(bend[0]), __expf(bend[1]), __expf(bend[2]), __expf(bend[3])};
                    { const int wn = wi + (int)F.G; if (wn < NH1) { H1_LOAD(wn); } }
                    LBAR();
                    for (int idx = wave; idx < 10; idx += 8) {
                        const int ti = idx < 1 ? 0 : idx < 3 ? 1 : idx < 6 ? 2 : 3; const int si = idx - (ti * (ti + 1)) / 2;
                        f32x4 a4 = (f32x4){0.f, 0.f, 0.f, 0.f};
#pragma unroll
                        for (int ks = 0; ks < 4; ++ks) { const bf16x8 af = *(const LAS bf16x8*)(Qt + (16 * ti + fr) * QT_S + (32 * ks + 8 * fq) * 2); const bf16x8 bfr = *(const LAS bf16x8*)(Kt + (16 * si + fr) * QT_S + (32 * ks + 8 * fq) * 2);
                            a4 = __builtin_amdgcn_mfma_f32_16x16x32_bf16(af, bfr, a4, 0, 0, 0); }
#pragma unroll
                        for (int i = 0; i < 4; ++i) { const int tt = 16 * ti + 4 * fq + i, ss = 16 * si + fr; const float v = (ss <= tt) ? a4[i] : 0.f;
                            *(LAS unsigned short*)(Asc + tt * KH_S + ss * 2) = (unsigned short)(cvt_pk_bf16(v, 0.f) & 0xffff); }
                    }
#pragma unroll
                    for (int j = 0; j < 2; ++j) { const int p = tid + 512 * j, prow = p >> 4, c16 = p & 15; if (DBG_H1_ST || sr) *(v4u*)(QTB + (row0 + prow) * 512 + h * 128 + c16 * 8) = *(const LAS v4u*)(Qt + prow * QT_S + c16 * 16); }
                    bf16x8 vf[2];
#pragma unroll
                    for (int ks = 0; ks < 2; ++ks) {
                        const v2u a0 = __builtin_bit_cast(v2u, __builtin_amdgcn_ds_read_tr16_b64_v4i16((LAS v4i16_t*)(Vr + (32 * ks + 8 * fq + (fr >> 2)) * VR_S + (16 * wave + 4 * (fr & 3)) * 2)));
                        const v2u a1 = __builtin_bit_cast(v2u, __builtin_amdgcn_ds_read_tr16_b64_v4i16((LAS v4i16_t*)(Vr + (32 * ks + 8 * fq + 4 + (fr >> 2)) * VR_S + (16 * wave + 4 * (fr & 3)) * 2)));
                        vf[ks] = __builtin_bit_cast(bf16x8, (v4u){a0.x, a0.y, a1.x, a1.y}); }
                    {   unsigned uw[8];
#pragma unroll
                        for (int kt = 0; kt < 8; ++kt) { f32x4 u4 = (f32x4){0.f, 0.f, 0.f, 0.f};
#pragma unroll
                            for (int ks = 0; ks < 2; ++ks) {
                                const v2u a0 = __builtin_bit_cast(v2u, __builtin_amdgcn_ds_read_tr16_b64_v4i16((LAS v4i16_t*)(Kh + (32 * ks + 8 * fq + (fr >> 2)) * VR_S + (32 * (fr & 3) + 4 * kt) * 2)));
                                const v2u a1 = __builtin_bit_cast(v2u, __builtin_amdgcn_ds_read_tr16_b64_v4i16((LAS v4i16_t*)(Kh + (32 * ks + 8 * fq + 4 + (fr >> 2)) * VR_S + (32 * (fr & 3) + 4 * kt) * 2)));
                                u4 = __builtin_amdgcn_mfma_f32_16x16x32_bf16(__builtin_bit_cast(bf16x8, (v4u){a0.x, a0.y, a1.x, a1.y}), vf[ks], u4, 0, 0, 0); }
                            const float su = (float)(1 << SH_U); uw[kt] = cvt4_fp8(u4[0] * su, u4[1] * su, u4[2] * su, u4[3] * su); }
                        unsigned char* up = UT + ((size_t)wi * 128 + 16 * wave + fr) * 128 + 32 * fq;
                        if (DBG_H1_ST || sr) { *(v4u*)up = (v4u){uw[0], uw[1], uw[2], uw[3]}; *(v4u*)(up + 16) = (v4u){uw[4], uw[5], uw[6], uw[7]}; } }
                    LBAR();
                    {   const int tt = wave & 3, vh = wave >> 2; bf16x8 af[2]; unsigned ow[8];
#pragma unroll
                        for (int ks = 0; ks < 2; ++ks) af[ks] = *(const LAS bf16x8*)(Asc + (16 * tt + fr) * KH_S + (32 * ks + 8 * fq) * 2);
#pragma unroll
                        for (int vt = 0; vt < 4; ++vt) { f32x4 o4 = (f32x4){0.f, 0.f, 0.f, 0.f};
#pragma unroll
                            for (int ks = 0; ks < 2; ++ks) {
                                const v2u a0 = __builtin_bit_cast(v2u, __builtin_amdgcn_ds_read_tr16_b64_v4i16((LAS v4i16_t*)(Vr + (32 * ks + 8 * fq + (fr >> 2)) * VR_S + (64 * vh + 16 * (fr & 3) + 4 * vt) * 2)));
                                const v2u a1 = __builtin_bit_cast(v2u, __builtin_amdgcn_ds_read_tr16_b64_v4i16((LAS v4i16_t*)(Vr + (32 * ks + 8 * fq + 4 + (fr >> 2)) * VR_S + (64 * vh + 16 * (fr & 3) + 4 * vt) * 2)));
                                o4 = __builtin_amdgcn_mfma_f32_16x16x32_bf16(__builtin_bit_cast(bf16x8, (v4u){a0.x, a0.y, a1.x, a1.y}), af[ks], o4, 0, 0, 0); }
                            ow[2 * vt] = cvt_pk_bf16(o4[0], o4[1]); ow[2 * vt + 1] = cvt_pk_bf16(o4[2], o4[3]); }
                        bf16* op = OA + (row0 + 16 * tt + fr) * 512 + h * 128 + 64 * vh + 16 * fq;
                        if (DBG_H1_ST || sr) { *(v4u*)op = (v4u){ow[0], ow[1], ow[2], ow[3]}; *(v4u*)(op + 8) = (v4u){ow[4], ow[5], ow[6], ow[7]}; } }
                } }
#undef H1_LOAD
            }
            {
                constexpr int K_S = 144, VT_S = 528;
                LAS unsigned char* Kl = lds;
                LAS unsigned char* Vt = lds + 36864;
                v4u kx[2], vx[2]; v2u qn[2];
#define ATT_DECODE(un) const int rn = (un) & 31, hh = ((un) >> 5) & 3, g = ((un) >> 7) % 3, b = (un) / 384; \
                const int dl = g == 0 ? 0 : g == 1 ? 2 : 4, d = 1 << dl, nbk = 32 >> dl, r = rn / nbk, n = rn % nbk; \
                const unsigned char* base = (const unsigned char*)AQKV + (size_t)(b * SEQ) * 2304 + (g * 4 + hh) * 64; const int qi = 16 * wave + fr; const int tq = (n * 128 + qi) * d + r;
#define ATT_LOAD(un) do { ATT_DECODE(un)       \
                _Pragma("unroll") for (int j = 0; j < 2; ++j) { const int p = tid + 512 * j, key = p >> 2, c16 = p & 3; const int l = (n - 1) * 128 + key; \
                    kx[j] = (v4u){0u, 0u, 0u, 0u}; vx[j] = kx[j]; \
                    if (l >= 0) { const unsigned char* rowp = base + (size_t)(l * d + r) * 2304 + c16 * 16; kx[j] = *(const v4u*)(rowp + 768); vx[j] = *(const v4u*)(rowp + 1536); } } \
                _Pragma("unroll") for (int ks = 0; ks < 2; ++ks) qn[ks] = *(const v2u*)(base + (size_t)tq * 2304 + 32 * ks + 8 * fq); } while (0)
                if (F.vcu < NATT) { ATT_LOAD(F.vcu); }
                _Pragma("unroll") for (int sr = 0; sr < (((REPMASK >> 17) & 1) ? 2 : 1); ++sr) { if (sr) { ATT_LOAD(F.vcu); }
                for (int un = F.vcu; un < NATT; un += F.G) {
                    ATT_DECODE(un)
                    LBAR();
#pragma unroll
                    for (int j = 0; j < 2; ++j) { const int p = tid + 512 * j, key = p >> 2, c16 = p & 3;
                        *(LAS v4u*)(Kl + key * K_S + c16 * 32) = f8x8_to_bf16(kx[j].x, kx[j].y); *(LAS v4u*)(Kl + key * K_S + c16 * 32 + 16) = f8x8_to_bf16(kx[j].z, kx[j].w);
                        *(LAS v4u*)(Vt + key * K_S + c16 * 32) = f8x8_to_bf16(vx[j].x, vx[j].y); *(LAS v4u*)(Vt + key * K_S + c16 * 32 + 16) = f8x8_to_bf16(vx[j].z, vx[j].w); }
                    bf16x8 qf[2]; qf[0] = __builtin_bit_cast(bf16x8, f8x8_to_bf16(qn[0].x, qn[0].y)); qf[1] = __builtin_bit_cast(bf16x8, f8x8_to_bf16(qn[1].x, qn[1].y));
                    if (un + (int)F.G < NATT && !(DBG_ATT_NOLOAD && sr)) { ATT_LOAD(un + (int)F.G); }
                    LBAR();
                    float p[10][4]; float mx = -INFINITY;
#pragma unroll
                    for (int jt = 0; jt < 10; ++jt) { const int kt = (wave + jt) < 15 ? (wave + jt) : 15; f32x4 s4 = (f32x4){0.f, 0.f, 0.f, 0.f};
#pragma unroll
                        for (int ks = 0; ks < 2; ++ks) { const bf16x8 af = *(const LAS bf16x8*)(Kl + (16 * kt + fr) * K_S + (32 * ks + 8 * fq) * 2); s4 = __builtin_amdgcn_mfma_f32_16x16x32_bf16(af, qf[ks], s4, 0, 0, 0); }
#pragma unroll
                        for (int i = 0; i < 4; ++i) { const int kj = 16 * (wave + jt) + 4 * fq + i; const bool ok = (kj >= qi) && (kj <= qi + 128) && (n > 0 || kj >= 128);
                            const float sv = ok ? s4[i] * (0.125f / (float)(1 << (2 * SH_Q))) : -INFINITY; p[jt][i] = sv; mx = fmaxf(mx, sv); } }
                    mx = fmaxf(mx, __shfl_xor(mx, 16)); mx = fmaxf(mx, __shfl_xor(mx, 32));
                    float ls = 0.f;
#pragma unroll
                    for (int jt = 0; jt < 10; ++jt)
#pragma unroll
                        for (int i = 0; i < 4; ++i) { const float e = __expf(p[jt][i] - mx); p[jt][i] = e; ls += e; }
                    ls += __shfl_xor(ls, 16); ls += __shfl_xor(ls, 32);
                    f32x4 o4[4];
#pragma unroll
                    for (int dt = 0; dt < 4; ++dt) o4[dt] = (f32x4){0.f, 0.f, 0.f, 0.f};
#pragma unroll
                    for (int pp = 0; pp < 5; ++pp) { const int k0 = (wave + 2 * pp) < 15 ? (wave + 2 * pp) : 15, k1 = (wave + 2 * pp + 1) < 15 ? (wave + 2 * pp + 1) : 15;
                        v4u pb; pb.x = cvt_pk_bf16(p[2 * pp][0], p[2 * pp][1]); pb.y = cvt_pk_bf16(p[2 * pp][2], p[2 * pp][3]); pb.z = cvt_pk_bf16(p[2 * pp + 1][0], p[2 * pp + 1][1]); pb.w = cvt_pk_bf16(p[2 * pp + 1][2], p[2 * pp + 1][3]);
                        const bf16x8 pf = __builtin_bit_cast(bf16x8, pb);
#pragma unroll
                        for (int dt = 0; dt < 4; ++dt) {
                            const v2u a0 = __builtin_bit_cast(v2u, __builtin_amdgcn_ds_read_tr16_b64_v4i16((LAS v4i16_t*)(Vt + (16 * k0 + 4 * fq + (fr >> 2)) * K_S + (16 * (fr & 3) + 4 * dt) * 2)));
                            const v2u a1 = __builtin_bit_cast(v2u, __builtin_amdgcn_ds_read_tr16_b64_v4i16((LAS v4i16_t*)(Vt + (16 * k1 + 4 * fq + (fr >> 2)) * K_S + (16 * (fr & 3) + 4 * dt) * 2)));
                            const v4u av = (v4u){a0.x, a0.y, a1.x, a1.y};
                            o4[dt] = __builtin_amdgcn_mfma_f32_16x16x32_bf16(__builtin_bit_cast(bf16x8, av), pf, o4[dt], 0, 0, 0); } }
                    const float inv = 1.0f / (ls * (float)(1 << SH_Q)); const size_t trow = (size_t)(b * SEQ + tq);
                    bf16* og = OG + ((size_t)g * T + trow) * 256 + hh * 64 + 16 * fq;
                    { unsigned ow[8];
#pragma unroll
                      for (int dt = 0; dt < 4; ++dt) { ow[2 * dt] = cvt_pk_bf16(o4[dt][0] * inv, o4[dt][1] * inv); ow[2 * dt + 1] = cvt_pk_bf16(o4[dt][2] * inv, o4[dt][3] * inv); }
                      *(v4u*)og = (v4u){ow[0], ow[1], ow[2], ow[3]}; *(v4u*)(og + 8) = (v4u){ow[4], ow[5], ow[6], ow[7]}; }
                    if (fq == 0) LSE[((size_t)(g * 4 + hh) * NB + b) * SEQ + r * (SEQ >> dl) + n * 128 + qi] = mx + __logf(ls);
                } }
#undef ATT_LOAD
#undef ATT_DECODE
            }
        }
        xcd_barrier(bar);
        for (int vb = blockIdx.x; vb < 256; vb += F.G) {
            const int bh = vb >> 3, eg = (vb & 7) * 512 + tid, v = eg >> 5, kq = eg & 31;
            LAS float* Dl = (LAS float*)lds;
            __syncthreads();
            for (int i = tid; i < 64 * 128; i += NWAVES * 64) Dl[i] = DKB[(size_t)bh * 64 * 128 + i];
            unsigned char* up = UT + ((size_t)bh * 64 * 128 + v) * 128 + kq * 4;
            __syncthreads();
            float S0 = 0.f, S1 = 0.f, S2 = 0.f, S3 = 0.f; const float su = (float)(1 << SH_U), ru = 1.0f / su;
            for (int c0 = 0; c0 < 64; c0 += 32) {
                unsigned u[32];
                { const unsigned char* lp = up + (size_t)c0 * 128 * 128;
#pragma unroll
                  for (int c = 0; c < 32; ++c) { u[c] = *(const unsigned*)lp; lp += 128 * 128; asm volatile("" : "+v"(lp)); } }
                unsigned char* sp = up + (size_t)c0 * 128 * 128;
#pragma unroll
                for (int c = 0; c < 32; ++c) { const f32x4 d = *(const LAS f32x4*)(Dl + (c0 + c) * 128 + kq * 4);
                    *(unsigned*)sp = cvt4_fp8(S0 * su, S1 * su, S2 * su, S3 * su); sp += 128 * 128; asm volatile("" : "+v"(sp));
                    const f32x2_t ua = __builtin_amdgcn_cvt_pk_f32_fp8((int)u[c], false), ub = __builtin_amdgcn_cvt_pk_f32_fp8((int)u[c], true);
                    S0 = d[0] * S0 + ua[0] * ru; S1 = d[1] * S1 + ua[1] * ru; S2 = d[2] * S2 + ub[0] * ru; S3 = d[3] * S3 + ub[1] * ru; }
            }
        }
        for (int m0 = F.gw * 16; m0 < T; m0 += F.NGW * 16)
            for (int m = m0; m < m0 + 16; ++m) {
                const int hh = lane >> 4;
                const int bb = m >> 12, tt = m & 4095;
                const float l0 = LSE[((size_t)(0 + hh) * NB + bb) * SEQ + tt], l1 = LSE[((size_t)(4 + hh) * NB + bb) * SEQ + (tt & 3) * 1024 + (tt >> 2)], l2 = LSE[((size_t)(8 + hh) * NB + bb) * SEQ + (tt & 15) * 256 + (tt >> 4)];
                const float mxl = fmaxf(l0, fmaxf(l1, l2)); const float e0 = __expf(l0 - mxl), e1 = __expf(l1 - mxl), e2 = __expf(l2 - mxl); const float inv = 1.0f / (e0 + e1 + e2);
                const v2u a0 = *(const v2u*)(OG + ((size_t)0 * T + m) * 256 + 4 * lane), a1 = *(const v2u*)(OG + ((size_t)1 * T + m) * 256 + 4 * lane), a2 = *(const v2u*)(OG + ((size_t)2 * T + m) * 256 + 4 * lane);
                const float w0 = e0 * inv, w1 = e1 * inv, w2 = e2 * inv;
                const float sy = (float)(1 << SH_YAB);
                *(unsigned*)((unsigned char*)YA + (size_t)m * 768 + 512 + 4 * lane) = cvt4_fp8(sy * (w0 * bflo(a0.x) + w1 * bflo(a1.x) + w2 * bflo(a2.x)), sy * (w0 * bfhi(a0.x) + w1 * bfhi(a1.x) + w2 * bfhi(a2.x)),
                                                                                                     sy * (w0 * bflo(a0.y) + w1 * bflo(a1.y) + w2 * bflo(a2.y)), sy * (w0 * bfhi(a0.y) + w1 * bfhi(a1.y) + w2 * bfhi(a2.y)));
            }
        xcd_barrier(bar);
        {
            LAS float* Ot = (LAS float*)lds;
            const int t = tid >> 3, seg = (tid & 7) * 16;
            v2u sfN[4]; bf16x8 afN[4][4]; v4u oiN0, oiN1, hzN;
#define P3C_LOAD(un_) do { const int b_ = (un_) >> 8, h_ = ((un_) >> 6) & 3, c_ = (un_) & 63; const size_t r0_ = (size_t)(b_ * SEQ + c_ * 64); \
                _Pragma("unroll") for (int ks = 0; ks < 4; ++ks) sfN[ks] = *(const v2u*)(UT + ((size_t)(un_) * 128 + 16 * wave + fr) * 128 + 32 * ks + 8 * fq); \
                _Pragma("unroll") for (int tt = 0; tt < 4; ++tt) _Pragma("unroll") for (int ks = 0; ks < 4; ++ks) afN[tt][ks] = *(const bf16x8*)(QTB + (r0_ + 16 * tt + fr) * 512 + h_ * 128 + 32 * ks + 8 * fq); \
                oiN0 = *(const v4u*)(OA + (r0_ + t) * 512 + h_ * 128 + seg); oiN1 = *(const v4u*)(OA + (r0_ + t) * 512 + h_ * 128 + seg + 8); \
                hzN = *(const v4u*)((const unsigned char*)GAB + (size_t)T * 2048 + (r0_ + t) * 512 + h_ * 128 + seg); } while (0)
            if (F.vcu < NB * 4 * 64) { P3C_LOAD(F.vcu); }
            int hprev3 = -1; f32x4 ggv[4];
#pragma unroll
            for (int j = 0; j < 4; ++j) ggv[j] = (f32x4){0.f, 0.f, 0.f, 0.f};
            for (int unit = F.vcu; unit < NB * 4 * 64; unit += F.G) {
                const int b = unit >> 8, h = (unit >> 6) & 3, c = unit & 63; const size_t row0 = (size_t)(b * SEQ + c * 64);
                if (h != hprev3) { hprev3 = h;
#pragma unroll
                    for (int j = 0; j < 4; ++j) ggv[j] = *(const f32x4*)(hg_norm_g + h * 128 + seg + 4 * j); }
                bf16x8 sf[4], af[4][4]; f32x4 o4[4];
#pragma unroll
                for (int ks = 0; ks < 4; ++ks) { const f32x2_t s0 = __builtin_amdgcn_cvt_pk_f32_fp8((int)sfN[ks].x, false), s1 = __builtin_amdgcn_cvt_pk_f32_fp8((int)sfN[ks].x, true), s2 = __builtin_amdgcn_cvt_pk_f32_fp8((int)sfN[ks].y, false), s3 = __builtin_amdgcn_cvt_pk_f32_fp8((int)sfN[ks].y, true);
                    const float ru = 1.0f / (float)(1 << SH_U); v4u sw; sw.x = cvt_pk_bf16(s0[0] * ru, s0[1] * ru); sw.y = cvt_pk_bf16(s1[0] * ru, s1[1] * ru); sw.z = cvt_pk_bf16(s2[0] * ru, s2[1] * ru); sw.w = cvt_pk_bf16(s3[0] * ru, s3[1] * ru);
                    sf[ks] = __builtin_bit_cast(bf16x8, sw);
#pragma unroll
                    for (int tt = 0; tt < 4; ++tt) af[tt][ks] = afN[tt][ks]; }
                const v4u oi0 = oiN0, oi1 = oiN1, hz = hzN;
                if (unit + (int)F.G < NB * 4 * 64) { P3C_LOAD(unit + (int)F.G); }
#pragma unroll
                for (int tt = 0; tt < 4; ++tt) { o4[tt] = (f32x4){0.f, 0.f, 0.f, 0.f};
#pragma unroll
                    for (int ks = 0; ks < 4; ++ks) o4[tt] = __builtin_amdgcn_mfma_f32_16x16x32_bf16(af[tt][ks], sf[ks], o4[tt], 0, 0, 0); }
                LBAR();
#pragma unroll
                for (int tt = 0; tt < 4; ++tt)
#pragma unroll
                    for (int i = 0; i < 4; ++i) Ot[(16 * tt + 4 * fq + i) * 132 + 16 * wave + fr] = o4[tt][i];
                LBAR();
                float o[16];
                { const unsigned ow[8] = {oi0.x, oi0.y, oi0.z, oi0.w, oi1.x, oi1.y, oi1.z, oi1.w};
#pragma unroll
                  for (int j = 0; j < 4; ++j) { const f32x4 q4 = *(const LAS f32x4*)(Ot + t * 132 + seg + 4 * j); o[4 * j] = q4[0] + bflo(ow[2 * j]); o[4 * j + 1] = q4[1] + bfhi(ow[2 * j]); o[4 * j + 2] = q4[2] + bflo(ow[2 * j + 1]); o[4 * j + 3] = q4[3] + bfhi(ow[2 * j + 1]); } }
                float ss = 0.f;
#pragma unroll
                for (int j = 0; j < 16; ++j) ss += o[j] * o[j];
                ss += __shfl_xor(ss, 1); ss += __shfl_xor(ss, 2); ss += __shfl_xor(ss, 4);
                const float rstd = 1.0f / sqrtf(ss * (1.f / 128.f) + RMS_EPS);
                const unsigned hw[4] = {hz.x, hz.y, hz.z, hz.w}; const float rs = rstd * (1.0f / (float)(1 << SH_G));
                unsigned yw[4]; const float rsy = rs * (float)(1 << SH_YAB);
#pragma unroll
                for (int j = 0; j < 4; ++j) { const f32x2_t s0 = __builtin_amdgcn_cvt_pk_f32_fp8((int)hw[j], false), s1 = __builtin_amdgcn_cvt_pk_f32_fp8((int)hw[j], true); const f32x4 gg = ggv[j];
                    yw[j] = cvt4_fp8(o[4 * j] * rsy * gg[0] * s0[0], o[4 * j + 1] * rsy * gg[1] * s0[1], o[4 * j + 2] * rsy * gg[2] * s1[0], o[4 * j + 3] * rsy * gg[3] * s1[1]); }
                *(v4u*)((unsigned char*)YA + (row0 + t) * 768 + h * 128 + seg) = (v4u){yw[0], yw[1], yw[2], yw[3]};
            }
#undef P3C_LOAD
        }
    REP_END(3) }

    SEAM(4);

    if (IN(5)) { REP_BEGIN(5)
        { pg8::DenseSched S; S.init(T, 1024, 768, F.G, (int)blockIdx.x, WA_T); pg8::EpiMerge E{(const unsigned char*)GAB, (unsigned char*)MERGED}; pg8::gemm_phase<ALIGN_DEFAULT, true, pg8::EpiMerge, pg8::DenseSched, 2>(lds, (const char*)YA, 768, S, E, SC_WAB, SC_YAB); }
    REP_END(5) }
    SEAM(5);

    if (IN(6)) { REP_BEGIN(6)
        pg8::DenseSched S; S.init(T, 1024, 1024, F.G, (int)blockIdx.x, WO_T); pg8::EpiOut E{X_IN, (bf16*)(ws + WS_X1B), MOD};
        pg8::gemm_phase<ALIGN_DEFAULT, true>(lds, (const char*)MERGED, 1024, S, E, SC_WGU, SC_M);
    REP_END(6) }
    SEAM(6);

    if (IN(7)) { REP_BEGIN(7)
        const int NRB = (F.G >= 256) ? 128 : F.G / 2;
        if ((int)blockIdx.x < NRB) {
            pg8::RouterSched S{T / 256, NRB, (int)blockIdx.x, (const char*)(ws + WS_WRB)}; pg8::EpiRL E{LOGITS};
            pg8::gemm_phase<ALIGN_DEFAULT, false>(lds, (const char*)(ws + WS_X1B), 2048, S, E);
        } else {
            const int rb = (int)blockIdx.x - NRB, nrow = F.G - NRB;
            for (int b = rb; b < NB; b += nrow) if (tid < 256) { float sum = 0.f;
                for (int p0 = 0; p0 < 64; p0 += 16) { float v[16];
#pragma unroll
                    for (int j = 0; j < 16; ++j) v[j] = ((const float*)(ws + WS_PART))[(size_t)(b * 64 + p0 + j) * 256 + tid];
#pragma unroll
                    for (int j = 0; j < 16; ++j) sum += v[j]; }
                ((float*)(ws + WS_CB))[b * 256 + tid] = sum; }
            for (int m0 = (rb * NWAVES + wave) * 16; m0 < T; m0 += nrow * NWAVES * 16) {
                const int b = m0 >> 12;
                f32x4 mul[4], add[4];
#pragma unroll
                for (int j = 0; j < 4; ++j) { const int c = 4 * lane + 256 * j;
                    const f32x4 s2 = *(const f32x4*)(MOD + b * 6144 + 4096 + c);
                    mul[j] = *(const f32x4*)(norm2_g + c) * (s2 + 1.0f);
                    add[j] = *(const f32x4*)(MOD + b * 6144 + 3072 + c); }
                for (int m = m0; m < m0 + 16; ++m) {
                    const GAS v2u* xr = (const GAS v2u*)((const bf16*)(ws + WS_X1B) + (size_t)m * D) + lane;
                    f32x4 v[4]; float s = 0.f;
#pragma unroll
                    for (int j = 0; j < 4; ++j) { const v2u xw = xr[64 * j]; v[j] = (f32x4){bflo(xw.x), bfhi(xw.x), bflo(xw.y), bfhi(xw.y)}; s += (v[j].x * v[j].x + v[j].y * v[j].y) + (v[j].z * v[j].z + v[j].w * v[j].w); }
                    const float rstd = 1.0f / sqrtf(wave_sum(s) * (1.f / D) + RMS_EPS);
                    if (lane == 0) ((float*)(ws + WS_RSTD))[m] = rstd;
                    GAS unsigned* o4 = (GAS unsigned*)((unsigned char*)(ws + WS_H2F8) + (size_t)m * D) + lane;
#pragma unroll
                    for (int j = 0; j < 4; ++j) { const f32x4 y = v[j] * rstd * mul[j] + add[j]; const float sx = (float)(1 << SH_X); o4[64 * j] = cvt4_fp8(y.x * sx, y.y * sx, y.z * sx, y.w * sx); }
                }
            }
        }
    REP_END(7) }
    SEAM(7);

    if (IN(9)) { REP_BEGIN(9)
        LAS unsigned* whist = (LAS unsigned*)lds;
        LAS unsigned* wbase = whist + 2048;
        LAS int* pe_l = (LAS int*)(lds + 16384); LAS int* pr_l = pe_l + 1024; LAS float* pw_l = (LAS float*)(pr_l + 1024);
        for (int cid = F.vcu; cid < T / 128; cid += F.G) {
            const int m0w = cid * 128;
            __syncthreads();
            for (int i = tid; i < 2048; i += NWAVES * 64) whist[i] = 0u;
            __syncthreads();
            float cb4[4], rb4[4];
#pragma unroll
            for (int i = 0; i < 4; ++i) { cb4[i] = ((const float*)(ws + WS_CB))[(cid >> 5) * 256 + lane + 64 * i]; rb4[i] = router_bias[lane + 64 * i]; }
            for (int jg = 0; jg < 16 / TKI; ++jg) {
                float sc[TKI][4]; unsigned key[TKI][4];
#pragma unroll
                for (int tt = 0; tt < TKI; ++tt) { const int t = m0w + wave * 16 + jg * TKI + tt; const float rs = ((const float*)(ws + WS_RSTD))[t];
#pragma unroll
                    for (int i = 0; i < 4; ++i) { sc[tt][i] = fsigmoid(rs * LOGITS[(size_t)t * 256 + lane + 64 * i] + cb4[i]); const float sl = fmaxf(sc[tt][i] + rb4[i], 0.f);
                        key[tt][i] = (__float_as_uint(sl) & 0xFFFFFF00u) | (unsigned)(255 - (lane + 64 * i)); } }
                float myw[TKI], ssum[TKI]; int mye[TKI];
#pragma unroll
                for (int tt = 0; tt < TKI; ++tt) { myw[tt] = 0.f; ssum[tt] = 0.f; mye[tt] = 0; }
                for (int k = 0; k < 8; ++k) {
#pragma unroll
                    for (int tt = 0; tt < TKI; ++tt) {
                        unsigned bk = max(max(key[tt][0], key[tt][1]), max(key[tt][2], key[tt][3]));
                        bk = max(bk, (unsigned)__builtin_amdgcn_update_dpp(0, (int)bk, 0xB1, 0xF, 0xF, false));
                        bk = max(bk, (unsigned)__builtin_amdgcn_update_dpp(0, (int)bk, 0x4E, 0xF, 0xF, false));
                        bk = max(bk, (unsigned)__builtin_amdgcn_update_dpp(0, (int)bk, 0x141, 0xF, 0xF, false));
                        bk = max(bk, (unsigned)__builtin_amdgcn_update_dpp(0, (int)bk, 0x140, 0xF, 0xF, false));
                        bk = max(bk, (unsigned)__builtin_amdgcn_update_dpp(0, (int)bk, 0x142, 0xA, 0xF, false));
                        bk = max(bk, (unsigned)__builtin_amdgcn_update_dpp(0, (int)bk, 0x143, 0xC, 0xF, false));
                        bk = (unsigned)__builtin_amdgcn_readlane((int)bk, 63);
                        const int idx = 255 - (int)(bk & 0xFFu), own = idx & 63, ii = idx >> 6;
                        float sv = ii == 0 ? sc[tt][0] : ii == 1 ? sc[tt][1] : ii == 2 ? sc[tt][2] : sc[tt][3];
                        sv = __int_as_float(__builtin_amdgcn_readlane(__float_as_int(sv), own));
#pragma unroll
                        for (int i = 0; i < 4; ++i) if (lane == own && ii == i) key[tt][i] = 0u;
                        ssum[tt] += sv;
                        if (lane == k) { mye[tt] = idx; myw[tt] = sv; }
                    }
                }
#pragma unroll
                for (int tt = 0; tt < TKI; ++tt) {
                    const float w = myw[tt] / ssum[tt] * 2.5f; const int j = jg * TKI + tt;
                    if (lane < 8) { LAS unsigned* hp = whist + wave * 256 + mye[tt]; const unsigned lr = *hp; *hp = lr + 1u;
                        const int ix = (wave * 16 + j) * 8 + lane; pe_l[ix] = mye[tt]; pr_l[ix] = (int)lr; pw_l[ix] = w; }
                    LDS_WAIT();
                }
            }
            __syncthreads();
            if (tid < 256) { unsigned run = 0u;
#pragma unroll
                for (int w = 0; w < 8; ++w) { wbase[w * 256 + tid] = run; run += whist[w * 256 + tid]; }
                HISTG[cid * 256 + tid] = run; }
            __syncthreads();
            for (int i = tid; i < 1024; i += NWAVES * 64) { const int e = pe_l[i]; const size_t gi = (size_t)m0w * 8 + i; PE[gi] = e; PR[gi] = pr_l[i] + (int)wbase[(i >> 7) * 256 + e]; PW[gi] = pw_l[i]; }
        }
    REP_END(9) }
    SEAM(9);

    if (IN(10) || IN(11) || IN(12)) {
        LAS int* tab = (LAS int*)(lds + TAB_OFF);
        LAS int* est = (LAS int*)lds; LAS int* tst = est + 256; LAS int* cntl = tst + 256; LAS int* ntl = cntl + 256; LAS int* cbl = ntl + 64;
        REP_BEGIN(10)
        for (int cid = F.vcu; cid < T / 128; cid += F.G) {
            __syncthreads();
            {
                const int e = tid & 255, hf = tid >> 8; int tot = 0, cb = 0;
                for (int c0 = hf * 128; c0 < hf * 128 + 128; c0 += 16) { int v[16];
#pragma unroll
                    for (int j = 0; j < 16; ++j) v[j] = (int)HISTG[(c0 + j) * 256 + e];
#pragma unroll
                    for (int j = 0; j < 16; ++j) { tot += v[j]; cb += (c0 + j < cid) ? v[j] : 0; } }
                if (hf) { cntl[e] = tot; cbl[e] = cb; }
                __syncthreads();
                if (!hf) { cntl[e] += tot; cbl[e] += cb; }
            }
            __syncthreads();
            if (wave == 0) {
                int c4[4], loc = 0, locT = 0;
#pragma unroll
                for (int i = 0; i < 4; ++i) { c4[i] = cntl[4 * lane + i]; loc += c4[i]; locT += (c4[i] + 255) >> 8; }
                int inc = loc, incT = locT;
#pragma unroll
                for (int o = 1; o < 64; o <<= 1) { const int a = __shfl_up(inc, o), bt = __shfl_up(incT, o); if (lane >= o) { inc += a; incT += bt; } }
                int ex = inc - loc, exT = incT - locT;
#pragma unroll
                for (int i = 0; i < 4; ++i) { est[4 * lane + i] = exT * 256; tst[4 * lane + i] = exT; ex += c4[i]; exT += (c4[i] + 255) >> 8; }
                if (lane == 63) ntl[0] = incT;
            }
            __syncthreads();
            if (tid < 256) { const int cn = cntl[tid], t0 = tst[tid], e0 = est[tid]; for (int j = 0; j * 256 < cn; ++j) { const int rem = cn - j * 256; tab[(t0 + j) * 4 + 0] = tid; tab[(t0 + j) * 4 + 1] = e0 + j * 256; tab[(t0 + j) * 4 + 2] = rem < 256 ? rem : 256; tab[(t0 + j) * 4 + 3] = 0; } }
            if (tid < T / 256) { const int ti = ntl[0] + tid; tab[ti * 4 + 0] = NEXP; tab[ti * 4 + 1] = NSLOTP + 256 * tid; tab[ti * 4 + 2] = 256; tab[ti * 4 + 3] = 0; }
            if (tid == 0) { F.MISC[16] = (unsigned)ntl[0]; F.MISC[17] = (unsigned)(ntl[0] + T / 256); }
            __syncthreads();
            if (IN(10)) {
                for (int i = cid * 128 + tid; i < cid * 128 + 128; i += NWAVES * 64) SLOT_TOK[NSLOTP + i] = i;
                for (int e = blockIdx.x; e < NEXP; e += F.G) { const int cn = cntl[e], e0 = est[e], pend = e0 + (((cn + 255) >> 8) << 8); for (int i = e0 + cn + tid; i < pend; i += NWAVES * 64) __hip_atomic_store(SLOT_TOK + i, 0, RLX_AGENT); }
                for (int i = tid; i < 1024; i += NWAVES * 64) { const size_t gi = (size_t)cid * 1024 + i; const int e = PE[gi]; const int slot = est[e] + cbl[e] + PR[gi]; __hip_atomic_store(SLOT_TOK + slot, (int)(gi >> 3), RLX_AGENT); TOK_SLOT[gi] = slot; }
            }
        }
        REP_END(10)
        __syncthreads();
    }
    SEAM(10);

    if (IN(11)) { REP_BEGIN(11)
        int Gp = F.G, c11 = F.vcu, cid = -1;
        if (NGB < F.G && NCONV11 > 0) {
            const int units = (int)F.MISC[17] * 2, gmax = F.G - CONV11_MINWG, R = (units + gmax - 1) / gmax; Gp = (units + R - 1) / R;
            const int x = (int)blockIdx.x & 7, j = (int)blockIdx.x >> 3, qb = Gp >> 3, qr = Gp & 7, qx = qb + (x < qr ? 1 : 0), mn = x < qr ? x : qr;
            if (j < qx) c11 = x * qb + mn + j; else cid = x * (32 - qb) - mn + (j - qx);
        }
        Gp = __builtin_amdgcn_readfirstlane(Gp); c11 = __builtin_amdgcn_readfirstlane(c11); cid = __builtin_amdgcn_readfirstlane(cid);
        if (cid < 0) { pg8::RoutedSched<2, true> S{(const LAS int*)(lds + TAB_OFF), (int)F.MISC[17], Gp, c11, 1024u, (const char*)WGU, (size_t)512 * 1024, SLOT_TOK};
          pg8::EpiGU E{(unsigned char*)HMID}; pg8::gemm_phase<ALIGN_DEFAULT, true>(lds, (const char*)(ws + WS_H2F8), 1024, S, E, SC_WGU, SC_X); }
        else conv_run(NITEMS - NCONV11 + cid * NWAVES + wave, NITEMS, (F.G - Gp) * NWAVES, (LAS float*)(lds + wave * 16384));
    REP_END(11) }
    SEAM(11);

    if (IN(12)) { REP_BEGIN(12)
        { pg8::RoutedSched<4, false> S{(const LAS int*)(lds + TAB_OFF), (int)F.MISC[17], F.G, F.vcu, 256u, (const char*)WD, (size_t)1024 * 256, nullptr};
          pg8::EpiRD E{(unsigned char*)YSLOT, SLOT_W}; pg8::gemm_phase<ALIGN_P12, true, pg8::EpiRD, pg8::RoutedSched<4, false>, 2>(lds, (const char*)HMID, 256, S, E, SC_WD, SC_HMID); }

    REP_END(12) }
    SEAM(12);

    if (IN(13)) { REP_BEGIN(13)
        float* dst13 = (rep + 1 < REPS(13)) ? (float*)(ws + WS_QF) : out;
        for (int m0 = F.gw * 16; m0 < T; m0 += F.NGW * 16) {
            const int b = m0 >> 12;
            f32x4 g2[4], fg[4];
#pragma unroll
            for (int j = 0; j < 4; ++j) { const int c = 256 * j + 4 * lane; g2[j] = *(const f32x4*)(MOD + b * 6144 + 5120 + c) * (1.0f / (float)(1 << SH_Y)); fg[j] = *(const f32x4*)(final_g + c); }
            const int ts0 = TOK_SLOT[m0 * 8 + lane], ts1 = TOK_SLOT[m0 * 8 + 64 + lane]; const float pw0 = PW[m0 * 8 + lane], pw1 = PW[m0 * 8 + 64 + lane];
            for (int m = m0; m < m0 + 16; ++m) {
                const int i8 = (m - m0) * 8; const int tsv = i8 < 64 ? ts0 : ts1; const float pwv = i8 < 64 ? pw0 : pw1;
                unsigned yr[9][4];
#pragma unroll
                for (int j = 0; j < 4; ++j) yr[0][j] = *(const unsigned*)(YSH + (size_t)m * 1024 + 256 * j + 4 * lane);
#pragma unroll
                for (int k = 0; k < 8; ++k) { const int slot = __builtin_amdgcn_readlane(tsv, (i8 + k) & 63); const unsigned char* sp = (const unsigned char*)YSLOT + (size_t)slot * 1024 + 4 * lane;
#pragma unroll
                    for (int j = 0; j < 4; ++j) yr[k + 1][j] = *(const unsigned*)(sp + 256 * j); }
                f32x4 v[4];
#pragma unroll
                for (int j = 0; j < 4; ++j) { const v2u xw = *(const v2u*)((const bf16*)(ws + WS_X1B) + (size_t)m * D + 256 * j + 4 * lane); v[j] = (f32x4){bflo(xw.x), bfhi(xw.x), bflo(xw.y), bfhi(xw.y)}; }
                f32x4 a[4];
#pragma unroll
                for (int j = 0; j < 4; ++j) a[j] = (f32x4){0.f, 0.f, 0.f, 0.f};
#pragma unroll
                for (int k = (DBG_MOE >= 1 ? 0 : 9); k < (DBG_MOE >= 2 ? 9 : 1); ++k) {
                    const float wk = k == 0 ? 1.0f : __int_as_float(__builtin_amdgcn_readlane(__float_as_int(pwv), (i8 + (k > 0 ? k - 1 : 0)) & 63));
#pragma unroll
                    for (int j = 0; j < 4; ++j) { const f32x2_t lo = __builtin_amdgcn_cvt_pk_f32_fp8((int)yr[k][j], false), hi = __builtin_amdgcn_cvt_pk_f32_fp8((int)yr[k][j], true); a[j] += (f32x4){lo[0], lo[1], hi[0], hi[1]} * wk; } }
                float s = 0.f;
#pragma unroll
                for (int j = 0; j < 4; ++j) { v[j] = v[j] + g2[j] * a[j]; s += (v[j].x * v[j].x + v[j].y * v[j].y) + (v[j].z * v[j].z + v[j].w * v[j].w); }
                const float rstd = 1.0f / sqrtf(wave_sum(s) * (1.f / D) + RMS_EPS);
                GAS f32x4* dr = (GAS f32x4*)(dst13 + (size_t)m * D + 4 * lane);
#pragma unroll
                for (int j = 0; j < 4; ++j) dr[64 * j] = v[j] * rstd * fg[j];
            }
        }
    REP_END(13) }
#if defined(DBG_DUMP)
    {
        xcd_barrier(bar);
        const bf16* SRC = DBG_DUMP_SRC; const int ld = DBG_DUMP_LD, off = DBG_DUMP_OFF;
        for (int m = F.gw; m < T; m += F.NGW) {
#pragma unroll
            for (int j = 0; j < 4; ++j) { const int c = 4 * lane + 256 * j; const int cc = c % DBG_DUMP_W; const v2u y = *(const v2u*)(SRC + (size_t)m * ld + off + cc); *(f32x4*)(out + (size_t)m * 1024 + c) = (f32x4){bflo(y.x), bfhi(y.x), bflo(y.y), bfhi(y.y)}; }
        }
    }
#endif
#undef IN
#undef SEAM
}

#undef X_IN
#undef cvec
#undef ada_w
#undef ada_b
#undef norm1_g
#undef w_in
#undef lb_logits
#undef hg_norm_g
#undef w_branch_a
#undef w_branch_b
#undef w_out
#undef norm2_g
#undef w_router
#undef router_bias
#undef w_exp_gate
#undef w_exp_up
#undef w_exp_down
#undef w_sh_gate
#undef w_sh_up
#undef w_sh_down
#undef final_g
#undef out
#undef WIN_T
#undef WA_T
#undef WB_T
#undef WO_T
#undef RS_T
#undef WSD_T
#undef WD
#undef WGU
#undef PE
#undef PR
#undef PW
#undef SLOT_TOK
#undef SLOT_W
#undef TOK_SLOT
#undef LSE
#undef QF
#undef OA
#undef OG
#undef MERGED
#undef HMID
#undef YSH
#undef AQKV
#undef GAB
#undef XN
#undef YA
#undef YB
#undef H2
#undef LOGITS
#undef YSLOT
#undef MOD
#undef HISTG
#undef ATTQ
#ifndef DBG_MOE
#define DBG_MOE 2
#endif
#ifndef MK_CUTS
#define MK_CUTS 1
#endif
extern "C" void kernel_launch(void* const* d_in, const int* in_sizes, int n_in, void* d_out, int out_size, void* d_ws, size_t ws_size, hipStream_t stream) {
    static int grid = 0;
    if (grid == 0) {
        if (n_in != 21 || out_size != T * D || ws_size < WS_END) { fprintf(stderr, "kernel_launch: unexpected shapes (n_in %d out %d ws %zu)\n", n_in, out_size, ws_size); grid = -1; return; }
        int dev = 0, cus = 0, per_cu = 0;
        if (hipGetDevice(&dev) != hipSuccess || hipDeviceGetAttribute(&cus, hipDeviceAttributeMultiprocessorCount, dev) != hipSuccess) { grid = -1; return; }
        if (hipFuncSetAttribute((const void*)mk_fwd, hipFuncAttributeMaxDynamicSharedMemorySize, LDS_BYTES) != hipSuccess) { fprintf(stderr, "kernel_launch: hipFuncSetAttribute failed\n"); grid = -1; return; }
        if (hipOccupancyMaxActiveBlocksPerMultiprocessor(&per_cu, (const void*)mk_fwd, NWAVES * 64, LDS_BYTES) != hipSuccess || per_cu < 1) fprintf(stderr, "kernel_launch: occupancy query reports %d\n", per_cu);
        (void)hipGetLastError();
        grid = cus;
    }
    if (grid < 0) return;
    if (hipMemsetAsync((char*)d_ws + WS_CTL, 0, CTL_ZERO_BYTES, stream) != hipSuccess) return;
    Args a{};
    for (int i = 0; i < 21; ++i) a.in[i] = (const float*)d_in[i];
    a.out = (float*)d_out; a.ws = (unsigned char*)d_ws;
#if MK_CUTS == 1
    a.ph_lo = 0; a.ph_hi = 14;
    hipLaunchKernelGGL(mk_fwd, dim3(grid), dim3(NWAVES * 64), LDS_BYTES, stream, a);
#else
    for (int p = 0; p < 14; ++p) { a.ph_lo = p; a.ph_hi = p + 1; hipLaunchKernelGGL(mk_fwd, dim3(grid), dim3(NWAVES * 64), LDS_BYTES, stream, a); }
#endif
}
```

```cpp
#include <hip/hip_runtime.h>
#include <cstdio>
#include <cstdint>
#ifndef DBG_MOE
#define DBG_MOE 2
#endif

#ifndef STAGGER12
#define STAGGER12 1
#endif
#ifndef RELAX_ST
#define RELAX_ST 0
#endif
#define GAS __attribute__((address_space(1)))
#define LAS __attribute__((address_space(3)))
typedef unsigned short bf16;
typedef unsigned v4u __attribute__((ext_vector_type(4)));
typedef unsigned v2u __attribute__((ext_vector_type(2)));
typedef float f32x4 __attribute__((ext_vector_type(4)));
typedef short bf16x8 __attribute__((ext_vector_type(8)));
typedef short bf16x4 __attribute__((ext_vector_type(4)));
typedef short v4i16_t __attribute__((ext_vector_type(4)));
typedef GAS unsigned gu32;

constexpr int NB = 8, SEQ = 4096, D = 1024, T = NB * SEQ;
constexpr int NIN = 6400;
constexpr int NEXP = 256, TOPK = 8, DEXP = 256;
constexpr int NSLOT = T * TOPK;
constexpr int MAXRT = NSLOT / 256 + NEXP;
constexpr int NSLOTP = MAXRT * 256;
constexpr int MAXTILES = MAXRT + T / 256;
constexpr float RMS_EPS = 1e-6f;
constexpr int NWAVES = 8;
constexpr int SH_WD = 5, SH_HMID = 2, SH_WGU = 6, SH_X = 2, SH_Y = 3, SH_G = 2, SH_U = 2, SH_M = 3, SH_YAB = 2, SH_WAB = 5, SH_Q = 2;
constexpr int SC_WD = 0x01010101 * (127 - SH_WD), SC_HMID = 0x01010101 * (127 - SH_HMID), SC_WGU = 0x01010101 * (127 - SH_WGU), SC_X = 0x01010101 * (127 - SH_X), SC_M = 0x01010101 * (127 - SH_M), SC_YAB = 0x01010101 * (127 - SH_YAB), SC_WAB = 0x01010101 * (127 - SH_WAB);

constexpr size_t MiB = 1u << 20;
constexpr size_t WS_CTL = 0, CTL_ZERO_BYTES = 1 * MiB;
constexpr size_t WS_WIN_T = 1 * MiB;
constexpr size_t WS_WA_T = 14 * MiB;
constexpr size_t WS_WB_T = 15 * MiB;
constexpr size_t WS_WO_T = 16 * MiB;
constexpr size_t WS_RS_T = 18 * MiB;
constexpr size_t WS_WSD_T = 20 * MiB;
constexpr size_t WS_PE = 21 * MiB, WS_PR = 22 * MiB, WS_PW = 23 * MiB;
constexpr size_t WS_SLOT_TOK = 24 * MiB, WS_SLOT_W = 25 * MiB, WS_TOK_SLOT = 27 * MiB;
constexpr size_t WS_LSE = 28 * MiB;
constexpr size_t WS_HISTG = 31 * MiB;
constexpr size_t WS_MOD = 30 * MiB;
constexpr size_t WS_WD = 32 * MiB;
constexpr size_t WS_QF = 160 * MiB;
constexpr size_t WS_OA = 288 * MiB;
constexpr size_t WS_OG = 320 * MiB;
constexpr size_t WS_MERGED = 288 * MiB;
constexpr size_t WS_HMID = 160 * MiB;
constexpr size_t WS_YSH = 304 * MiB;
constexpr size_t WS_WGU = 384 * MiB;
constexpr size_t WS_AQKV = 640 * MiB;
constexpr size_t WS_GAB = 784 * MiB;
constexpr size_t WS_XN = 912 * MiB;
constexpr size_t WS_YA = 640 * MiB;
constexpr size_t WS_YB = 368 * MiB;
constexpr size_t WS_H2 = 640 * MiB;
constexpr size_t WS_H2F8 = 912 * MiB;
constexpr size_t WS_X1B = 736 * MiB;
constexpr size_t WS_LOGITS = 704 * MiB;
constexpr size_t WS_YSLOT = 384 * MiB;
constexpr size_t WS_UT = 912 * MiB;
constexpr size_t WS_QTB = 976 * MiB;
constexpr size_t WS_DK = 1008 * MiB;
constexpr size_t WS_PART = 18 * MiB;
constexpr size_t WS_CB = 19 * MiB;
constexpr size_t WS_RSTD = 19 * MiB + 65536;
constexpr size_t WS_WRB = 1009 * MiB;
constexpr size_t WS_END = 1013 * MiB;
constexpr int CW_TMO = 0, CW_CODE = 1, CW_BAR = 4096, CW_GCNT = 16384, CW_ATTQ = 20480, CW_MOD = 65536;

constexpr int RING_BYTES = 131072;
constexpr int TAB_OFF = RING_BYTES;
constexpr int MISC_OFF = TAB_OFF + MAXTILES * 16;
constexpr int RL_OFF = MISC_OFF + 256;
constexpr int RL_MAXU = 12;
constexpr int LDS_BYTES = RL_OFF + RL_MAXU * 512;

#define RLX_AGENT __ATOMIC_RELAXED, __HIP_MEMORY_SCOPE_AGENT
#define LDS_WAIT() asm volatile("s_waitcnt lgkmcnt(0)" ::: "memory")
#define VM_WAIT() asm volatile("s_waitcnt vmcnt(0)" ::: "memory")
#define LBAR() do { asm volatile("s_waitcnt lgkmcnt(0)" ::: "memory"); __builtin_amdgcn_s_barrier(); asm volatile("" ::: "memory"); } while (0)
typedef float f32x2_t __attribute__((ext_vector_type(2))); typedef __bf16 bf16x2_t __attribute__((ext_vector_type(2)));
__device__ __forceinline__ unsigned cvt_pk_bf16(float lo, float hi) { f32x2_t v = {lo, hi}; bf16x2_t b = __builtin_convertvector(v, bf16x2_t); return __builtin_bit_cast(unsigned, b); }
typedef int v8i __attribute__((ext_vector_type(8))); typedef int v4i_t __attribute__((ext_vector_type(4)));
__device__ __forceinline__ unsigned cvt4_fp8(float a, float b, float c, float d) {
    a = __builtin_amdgcn_fmed3f(a, -448.f, 448.f); b = __builtin_amdgcn_fmed3f(b, -448.f, 448.f); c = __builtin_amdgcn_fmed3f(c, -448.f, 448.f); d = __builtin_amdgcn_fmed3f(d, -448.f, 448.f);
    int w = 0; w = __builtin_amdgcn_cvt_pk_fp8_f32(a, b, w, false); w = __builtin_amdgcn_cvt_pk_fp8_f32(c, d, w, true); return (unsigned)w; }
__device__ __forceinline__ v4u f8x8_to_bf16(unsigned w0, unsigned w1) {
    const f32x2_t a = __builtin_amdgcn_cvt_pk_f32_fp8((int)w0, false), b = __builtin_amdgcn_cvt_pk_f32_fp8((int)w0, true), c = __builtin_amdgcn_cvt_pk_f32_fp8((int)w1, false), d = __builtin_amdgcn_cvt_pk_f32_fp8((int)w1, true);
    v4u o; o.x = cvt_pk_bf16(a[0], a[1]); o.y = cvt_pk_bf16(b[0], b[1]); o.z = cvt_pk_bf16(c[0], c[1]); o.w = cvt_pk_bf16(d[0], d[1]); return o; }
__device__ __forceinline__ float bf2f(unsigned h) { return __uint_as_float(h << 16); }
__device__ __forceinline__ float bflo(unsigned w) { return __uint_as_float(w << 16); }
__device__ __forceinline__ float bfhi(unsigned w) { return __uint_as_float(w & 0xffff0000u); }
__device__ __forceinline__ float fsigmoid(float x) { return __builtin_amdgcn_rcpf(1.0f + __expf(-x)); }
__device__ __forceinline__ float fsilu(float x) { return x * fsigmoid(x); }
__device__ __forceinline__ float wave_sum(float v) {
#pragma unroll
    for (int o = 1; o < 64; o <<= 1) v += __shfl_xor(v, o);
    return v;
}

#define XB_TMO      128
#define XB_XCNT(j)  (256  + 64 * (j))
#define XB_XSUB(j)  (1280 + 64 * (j))
#define XB_XGEN(j)  (2304 + 64 * (j))
#define XB_TOP      3328
#define XB_TOPGEN   3392
#define XCD_BAR_WORDS 3456
#define XB_SPIN_CAP (1u << 18)
__device__ __forceinline__ unsigned xb_ld(unsigned* p)              { return __hip_atomic_load(p, __ATOMIC_RELAXED, __HIP_MEMORY_SCOPE_AGENT); }
__device__ __forceinline__ unsigned xb_add(unsigned* p, unsigned v) { return __hip_atomic_fetch_add(p, v, __ATOMIC_RELAXED, __HIP_MEMORY_SCOPE_AGENT); }
__device__ __forceinline__ unsigned xb_xcc_id() { return (unsigned)__builtin_amdgcn_s_getreg((3 << 11) | 20) & 0xFu; }
#define XB_SPIN(cond, bar) do { unsigned _sp = 0; while (cond) { __builtin_amdgcn_s_sleep(1); \
    if ((++_sp & 255u) == 0u) { if (xb_ld(&(bar)[XB_TMO])) break; if (_sp > XB_SPIN_CAP) { atomicAdd(&(bar)[XB_TMO], 1u); break; } } } } while (0)
struct XcdBarrier { unsigned* bar; unsigned x; volatile LAS unsigned* st; };
__device__ __forceinline__ XcdBarrier xcd_barrier_post(unsigned* bar, volatile LAS unsigned* st) {
    XcdBarrier b; b.bar = bar; b.x = xb_xcc_id(); b.st = st;
    if (threadIdx.x == 0) (void)xb_add(&bar[XB_XCNT(b.x)], 1u);
    return b;
}
__device__ __forceinline__ void xcd_barrier_complete(unsigned* bar, unsigned x, unsigned& nloc, unsigned& nx) {
    const unsigned G = gridDim.x * gridDim.y * gridDim.z;
    unsigned sum, cnt, mine, sp = 0u;
    for (;;) {
        sum = 0u; cnt = 0u; mine = 0u;
#pragma unroll
        for (unsigned j = 0; j < 16; ++j) { const unsigned c = xb_ld(&bar[XB_XCNT(j)]); sum += c; cnt += (c > 0u) ? 1u : 0u; mine = (j == x) ? c : mine; }
        if (sum == G) break;
        __builtin_amdgcn_s_sleep(1);
        if ((++sp & 255u) == 0u) { if (xb_ld(&bar[XB_TMO])) break; if (sp > XB_SPIN_CAP) { atomicAdd(&bar[XB_TMO], 1u); break; } }
    }
    nloc = mine > 0u ? mine : 1u; nx = cnt > 0u ? cnt : 1u;
}
__device__ __forceinline__ void xcd_barrier(const XcdBarrier& b) {
    asm volatile("s_waitcnt vmcnt(0)" ::: "memory");
    __syncthreads();
    if (threadIdx.x == 0) {
        unsigned* bar = b.bar;
        __builtin_amdgcn_s_waitcnt(0);
        unsigned nloc = b.st[0], nx = b.st[1];
        if (nloc == 0u) { xcd_barrier_complete(bar, b.x, nloc, nx); b.st[0] = nloc; b.st[1] = nx; }
        const unsigned old = xb_add(&bar[XB_XSUB(b.x)], 1u);
        const unsigned gen = old / nloc;
        if (old + 1u == (gen + 1u) * nloc) {
            __builtin_amdgcn_fence(__ATOMIC_RELEASE, "agent");
            asm volatile("s_waitcnt vmcnt(0)" ::: "memory");
            const unsigned og = xb_add(&bar[XB_TOP], 1u);
            const unsigned tg = og / nx;
            if (og + 1u == (tg + 1u) * nx) xb_add(&bar[XB_TOPGEN], 1u);
            else XB_SPIN(xb_ld(&bar[XB_TOPGEN]) == tg, bar);
            __builtin_amdgcn_fence(__ATOMIC_ACQUIRE, "agent");
            xb_add(&bar[XB_XGEN(b.x)], 1u);
            asm volatile("s_waitcnt vmcnt(0)" ::: "memory");
        } else {
            XB_SPIN(xb_ld(&bar[XB_XGEN(b.x)]) == gen, bar);
            __builtin_amdgcn_fence(__ATOMIC_ACQUIRE, "agent");
            asm volatile("s_waitcnt vmcnt(0)" ::: "memory");
        }
    }
    __syncthreads();
}

__device__ __forceinline__ void glds16s(const void* sbase, unsigned voff, unsigned lds_dst) {
    unsigned keep;
    asm volatile("s_mov_b32 %0, m0\n\ts_mov_b32 m0, %3\n\ts_nop 0\n\tglobal_load_lds_dwordx4 %1, %2\n\ts_mov_b32 m0, %0" : "=&s"(keep) : "v"(voff), "s"(sbase), "s"(lds_dst) : "memory");
}
namespace pg8 {
constexpr int BM = 256, BK = 64, HALF = 128, HTB = HALF * BK * 2, NXCD = 8, WGM = 8;
__host__ __device__ __forceinline__ int lds_byte(int r, int c) { const int st = (r >> 4) * 2 + (c >> 5), rr = r & 15, cc = c & 31, ob = rr * 64 + cc * 2; return st * 1024 + (ob ^ (((ob >> 9) & 1) << 5)); }
__host__ __device__ __forceinline__ void stage_rc(int b, int& R, int& C) { const int st = b / 1024, sb = b % 1024, swz = sb ^ (((sb >> 9) & 1) << 5); R = (st >> 1) * 16 + swz / 64; C = (st & 1) * 32 + (swz % 64) / 2; }
__host__ __device__ __forceinline__ int perm32(int rho) { const int n = rho >> 4, i = rho & 15; return 8 * (i >> 2) + 4 * n + (i & 3); }
struct Unit { int pm, pn, e, row0, rows, li; };

struct DenseSched {
    int nM, nN, nwg, G, c; unsigned rowbytes; int arow0; const char* Bt;
    __device__ void init(int M, int N, int Kbytes, int G_, int c_, const void* Bt_, int arow0_ = 0) { nM = M / BM; nN = N / BM; nwg = nM * nN; G = G_; c = c_; rowbytes = (unsigned)Kbytes; arow0 = arow0_; Bt = (const char*)Bt_; }
    __device__ __forceinline__ bool next(int i, Unit& u) const {
        const long L = (long)i * G + c; if (L >= nwg) return false;
        int wgid = (int)L; { const int q = nwg / NXCD, r = nwg % NXCD, xcd = wgid % NXCD, off = wgid / NXCD; wgid = (xcd < r ? xcd * (q + 1) : r * (q + 1) + (xcd - r) * q) + off; }
        const int nig = WGM * nN, gid = wgid / nig, fm = gid * WGM, gsz = (nM - fm) < WGM ? (nM - fm) : WGM;
        u.pm = fm + ((wgid % nig) % gsz); u.pn = (wgid % nig) / gsz; u.e = 0; u.row0 = u.pm * BM; u.rows = BM; u.li = i; return true;
    }
    __device__ __forceinline__ unsigned a_off(const Unit& u, int r) const { return (unsigned)(arow0 + u.pm * BM + r) * rowbytes; }
    __device__ __forceinline__ const char* b_base(const Unit& u) const { return Bt + (size_t)u.pn * BM * rowbytes; }
};
template <int NPN, bool GATHER>
struct RoutedSched {
    const LAS int* tab; int ntiles, G, c; unsigned rowbytes; const char* Bt; size_t estride; const LAS unsigned short* rowlist;
    __device__ __forceinline__ bool next(int i, Unit& u) const {
        const long L = (long)i * G + c; if (L >= (long)ntiles * NPN) return false;
        const int ti = (int)(L / NPN); u.pn = (int)(L % NPN); u.pm = ti; u.li = i;
        u.e = __builtin_amdgcn_readfirstlane(tab[ti * 4 + 0]); u.row0 = __builtin_amdgcn_readfirstlane(tab[ti * 4 + 1]); u.rows = __builtin_amdgcn_readfirstlane(tab[ti * 4 + 2]); return true;
    }
    __device__ __forceinline__ unsigned a_off(const Unit& u, int r) const {
        const int s = u.row0 + r;
        if (GATHER) return (unsigned)rowlist[u.li * 256 + r] * rowbytes; else return (unsigned)s * rowbytes;
    }
    __device__ __forceinline__ const char* b_base(const Unit& u) const { return Bt + (size_t)u.e * estride + (size_t)u.pn * BM * rowbytes; }
};

struct RouterSched {
    int n, G, c; const char* Bt;
    __device__ __forceinline__ bool next(int i, Unit& u) const { const long L = (long)i * G + c; if (L >= n) return false; u.pm = (int)L; u.pn = 0; u.e = 0; u.row0 = u.pm * BM; u.rows = BM; u.li = i; return true; }
    __device__ __forceinline__ unsigned a_off(const Unit& u, int r) const { return (unsigned)(u.pm * BM + r) * 2048u; }
    __device__ __forceinline__ const char* b_base(const Unit& u) const { return Bt + (size_t)(u.pm >> 4) * (256 * 2048); }
};

template <bool ALIGN_EPI, bool FP8, class Epi, class Sched, int CM = 1>
__device__ __forceinline__ void gemm_phase(LAS unsigned char* lds, const char* Abase, const int Kbytes, const Sched& S, const Epi& E, const int scaleW = 0x7F7F7F7F, const int scaleX = 0x7F7F7F7F) {
    int tid = threadIdx.x; asm volatile("" : "+v"(tid));
    const int wid = __builtin_amdgcn_readfirstlane(tid >> 6), lane = tid & 63, wr = wid >> 2, wc = wid & 3, fr = lane & 15, fq = lane >> 4;
    const int nt = Kbytes / (BK * 2);
    unsigned voffB[2];
#pragma unroll
    for (int i = 0; i < 2; ++i) { int R, C; stage_rc(tid * 16 + i * 8192, R, C); const int Rb = (CM == 2) ? 2 * (R & ~31) + 16 * ((R & 15) >> 2) + 4 * ((R >> 4) & 1) + (R & 3) : (CM == 4) ? 2 * (R & ~31) + 8 * (2 * (((R & 15) >> 2) & 1) + ((R & 15) >> 3)) + 4 * ((R >> 4) & 1) + (R & 3) : (CM ? 2 * (R & ~31) : (R & ~31)) + perm32(R & 31); voffB[i] = (unsigned)(Rb * Kbytes + C * 2); }
    const size_t kstep = (size_t)(BK * 2);
    const size_t hstepB = (size_t)(CM == 2 ? 8 : CM ? 32 : HALF) * Kbytes;
    const unsigned ldsw = (unsigned)wid * 1024u;
    const unsigned lds0 = (unsigned)(uintptr_t)lds;
    const int aoff = lds_byte(wr * 64 + fr, fq * 8), boff = lds_byte(wc * 32 + fr, fq * 8);
#define PG8_SA(b, h) (((b) * 2 + (h)) * HTB)
#define PG8_SB(b, h) ((4 + (b) * 2 + (h)) * HTB)
#define PG8_STAGE(bufoff, gbase, voff) do { _Pragma("unroll") for (int _i = 0; _i < 2; ++_i) \
        glds16s((const void*)(gbase), (voff)[_i], lds0 + (unsigned)((bufoff) + _i * 8192) + ldsw); } while (0)
#define PG8_LD2(p) __builtin_shufflevector(*(const LAS v4i_t*)(p), *(const LAS v4i_t*)((p) + 1024), 0, 1, 2, 3, 4, 5, 6, 7)
#define PG8_LDA(dst, b, h) do { _Pragma("unroll") for (int m = 0; m < 4; ++m) dst[m] = PG8_LD2(lds + PG8_SA(b, h) + aoff + m * 2048); } while (0)
#define PG8_LDB(dst, b, h) do { _Pragma("unroll") for (int n = 0; n < 2; ++n) dst[n] = PG8_LD2(lds + PG8_SB(b, h) + boff + n * 2048); } while (0)
#define PG8_LO(v) __builtin_bit_cast(bf16x8, __builtin_shufflevector(v, v, 0, 1, 2, 3))
#define PG8_HI(v) __builtin_bit_cast(bf16x8, __builtin_shufflevector(v, v, 4, 5, 6, 7))
#define PG8_MMA(ai, bj, At, Bt) do { __builtin_amdgcn_s_setprio(1); _Pragma("unroll") for (int m = 0; m < 4; ++m) _Pragma("unroll") for (int n = 0; n < 2; ++n) { \
        if constexpr (FP8) acc[ai][bj][m][n] = __builtin_amdgcn_mfma_scale_f32_16x16x128_f8f6f4(Bt[n], At[m], acc[ai][bj][m][n], 0, 0, 0, scaleW, 0, scaleX); \
        else { acc[ai][bj][m][n] = __builtin_amdgcn_mfma_f32_16x16x32_bf16(PG8_LO(Bt[n]), PG8_LO(At[m]), acc[ai][bj][m][n], 0, 0, 0); acc[ai][bj][m][n] = __builtin_amdgcn_mfma_f32_16x16x32_bf16(PG8_HI(Bt[n]), PG8_HI(At[m]), acc[ai][bj][m][n], 0, 0, 0); } } __builtin_amdgcn_s_setprio(0); } while (0)
#define PG8_WAIT_V(n) asm volatile("s_waitcnt vmcnt(" #n ")" ::: "memory")
#define PG8_WAIT_L(n) asm volatile("s_waitcnt lgkmcnt(" #n ")" ::: "memory")
#define PG8_WAIT_VR(rf) asm volatile("s_waitcnt vmcnt(%1)\n\tv_readfirstlane_b32 vcc_lo, %0\n\ts_nop 4\n\ts_cmp_eq_u32 vcc_lo, 0\n\ts_cbranch_scc0 .Lpg8r%=\n\ts_waitcnt vmcnt(8)\n.Lpg8r%=:" :: "v"(rf), "n"(8 + (RELAX_ST ? Epi::NST : 0)) : "memory", "scc", "vcc")
#define PG8_BAR __builtin_amdgcn_s_barrier()
#define PG8_SCHED __builtin_amdgcn_sched_barrier(0)
#define PG8_AOFF(u, o0, o1) do { int _t = tid; asm volatile("" : "+v"(_t)); _Pragma("unroll") for (int _i = 0; _i < 2; ++_i) { int _R, _C; stage_rc(_t * 16 + _i * 8192, _R, _C); \
        o0[_i] = S.a_off(u, _R) + (unsigned)_C * 2u; o1[_i] = S.a_off(u, _R + HALF) + (unsigned)_C * 2u; } } while (0)
    Unit cur, nxt; int ui = 0; int relax = 0;
    if (!S.next(0, cur)) return;
    f32x4 acc[2][2][4][2];
#pragma unroll
    for (int a = 0; a < 2; ++a)
#pragma unroll
        for (int b = 0; b < 2; ++b)
#pragma unroll
            for (int m = 0; m < 4; ++m)
#pragma unroll
                for (int n = 0; n < 2; ++n) acc[a][b][m][n] = (f32x4){0.f, 0.f, 0.f, 0.f};
    v8i At[4], B0[2], B1[2];
    unsigned cA0[2], cA1[2];
    PG8_AOFF(cur, cA0, cA1);
    const char* cB = S.b_base(cur); const char* nB = cB;
    PG8_STAGE(PG8_SB(0, 0), cB, voffB); PG8_STAGE(PG8_SB(0, 1), cB + hstepB, voffB); PG8_STAGE(PG8_SA(0, 0), Abase, cA0); PG8_STAGE(PG8_SA(0, 1), Abase, cA1);
    if (wr == 1) PG8_BAR;
    PG8_WAIT_V(2); PG8_BAR;
    PG8_STAGE(PG8_SB(1, 0), cB + kstep, voffB); PG8_STAGE(PG8_SA(1, 0), Abase + kstep, cA0); PG8_STAGE(PG8_SB(1, 1), cB + hstepB + kstep, voffB);
    PG8_WAIT_V(6); PG8_BAR;
    for (;;) {
        const bool has_next = S.next(ui + 1, nxt);
#pragma unroll 1
        for (int t = 0; t < nt; t += 2) {
            const bool last = (t == nt - 2); const int rf = (t == 0) ? relax : 0;
            if constexpr (Epi::MID_T > 0) { if (t == Epi::MID_T) { PG8_SCHED; E.mid(acc, cur, wr, wc, fr, fq); PG8_SCHED; } }
            if (last && has_next) nB = S.b_base(nxt);
            const char* a1 = Abase + (size_t)(t + 1) * kstep;
            const char* a2 = last ? Abase : Abase + (size_t)(t + 2) * kstep; const char* b2 = last ? nB : cB + (size_t)(t + 2) * kstep;
            const char* a3 = a2 + kstep; const char* b3 = b2 + kstep;
            PG8_LDB(B0, 0, 0); PG8_LDB(B1, 0, 1); PG8_SCHED; PG8_LDA(At, 0, 0); PG8_STAGE(PG8_SA(1, 1), a1, cA1);
            if (last && has_next) { PG8_AOFF(nxt, cA0, cA1); }
            PG8_WAIT_VR(rf); PG8_WAIT_L(0); PG8_BAR; PG8_MMA(0, 0, At, B0); PG8_MMA(0, 1, At, B1); PG8_BAR; PG8_SCHED;
            PG8_LDA(At, 0, 1); PG8_STAGE(PG8_SB(0, 0), b2, voffB); PG8_STAGE(PG8_SB(0, 1), b2 + hstepB, voffB); PG8_STAGE(PG8_SA(0, 0), a2, cA0);
            PG8_WAIT_VR(rf); PG8_WAIT_L(0); PG8_BAR; PG8_MMA(1, 0, At, B0); PG8_MMA(1, 1, At, B1); PG8_BAR; PG8_SCHED;
            PG8_LDB(B0, 1, 0); PG8_LDB(B1, 1, 1); PG8_SCHED; PG8_LDA(At, 1, 0); PG8_STAGE(PG8_SA(0, 1), a2, cA1);
            PG8_WAIT_V(8); PG8_WAIT_L(0); PG8_BAR; PG8_MMA(0, 0, At, B0); PG8_MMA(0, 1, At, B1); PG8_BAR; PG8_SCHED;
            PG8_LDA(At, 1, 1); PG8_STAGE(PG8_SB(1, 0), b3, voffB); PG8_STAGE(PG8_SB(1, 1), b3 + hstepB, voffB); PG8_STAGE(PG8_SA(1, 0), a3, cA0);
            PG8_WAIT_V(8); PG8_WAIT_L(0); PG8_BAR; PG8_MMA(1, 0, At, B0); PG8_MMA(1, 1, At, B1); PG8_BAR; PG8_SCHED;
        }
        if constexpr (ALIGN_EPI) { if (wr == 0) PG8_BAR; }
        { Unit eu = cur; int efr = fr, efq = fq; asm volatile("" : "+s"(eu.pm), "+s"(eu.pn), "+s"(eu.e), "+s"(eu.row0), "+s"(eu.rows), "+v"(efr), "+v"(efq)); E(acc, eu, wr, wc, efr, efq); }
        if (!has_next) break;
        relax = (Epi::NST > 0 && E.full(cur)) ? 1 : 0;
#pragma unroll
        for (int a = 0; a < 2; ++a)
#pragma unroll
            for (int b = 0; b < 2; ++b)
#pragma unroll
                for (int m = 0; m < 4; ++m)
#pragma unroll
                    for (int n = 0; n < 2; ++n) acc[a][b][m][n] = (f32x4){0.f, 0.f, 0.f, 0.f};
        cur = nxt; cB = nB; ++ui;
        if constexpr (ALIGN_EPI) { if (wr == 1) PG8_BAR; }
    }
    PG8_WAIT_V(0);
    if constexpr (!ALIGN_EPI) { if (wr == 0) PG8_BAR; }
    PG8_BAR;
#undef PG8_SA
#undef PG8_SB
#undef PG8_STAGE
#undef PG8_LDA
#undef PG8_LDB
#undef PG8_MMA
#undef PG8_LO
#undef PG8_HI
#undef PG8_LD2
#undef PG8_WAIT_V
#undef PG8_WAIT_L
#undef PG8_WAIT_VR
#undef PG8_BAR
#undef PG8_SCHED
#undef PG8_AOFF
}

constexpr int WCS = 64, BJS = 32;
#define EPI_ROWS_BEGIN _Pragma("unroll") for (int ai = 0; ai < 2; ++ai) _Pragma("unroll") for (int m = 0; m < 4; ++m) { const int rt = ai * HALF + wr * 64 + m * 16 + fr;
#define EPI_ROWS_END }
__device__ __forceinline__ v4u pack8(const f32x4 a, const f32x4 b) { v4u w; w.x = cvt_pk_bf16(a[0], a[1]); w.y = cvt_pk_bf16(a[2], a[3]); w.z = cvt_pk_bf16(b[0], b[1]); w.w = cvt_pk_bf16(b[2], b[3]); return w; }

__device__ __forceinline__ v2u act8_fp8(const f32x4 a, const f32x4 b, const bool silu) {
    const float sc = (float)(1 << SH_G); float x[8] = {a[0], a[1], a[2], a[3], b[0], b[1], b[2], b[3]};
#pragma unroll
    for (int j = 0; j < 8; ++j) { const float sg = fsigmoid(x[j]); x[j] = (silu ? x[j] * sg : sg) * sc; }
    v2u w; w.x = cvt4_fp8(x[0], x[1], x[2], x[3]); w.y = cvt4_fp8(x[4], x[5], x[6], x[7]); return w;
}
struct EpiWin { static constexpr int MID_T = 0; static constexpr int NST = 8; __device__ __forceinline__ bool full(const Unit&) const { return !dry; }
    unsigned char *QF8, *AQKV8, *GAB8, *HG8; int dry;
    __device__ __forceinline__ void operator()(const f32x4 (&acc)[2][2][4][2], const Unit& u, int wr, int wc, int fr, int fq) const {
        if (dry) return;
        if (u.pn >= 17 || u.pn == 6 || u.pn == 7) {
            const bool silu = u.pn < 8; unsigned char* base = silu ? HG8 : GAB8; const int ldc = silu ? 512 : 2048, ct = silu ? u.pn - 6 : u.pn - 17;
            const int col0 = ct * BM + wc * 64 + 16 * fq;
            EPI_ROWS_BEGIN { unsigned char* rowp = base + (size_t)(u.pm * BM + rt) * ldc + col0;
                const v2u lo = act8_fp8(acc[ai][0][m][0], acc[ai][0][m][1], silu), hi = act8_fp8(acc[ai][1][m][0], acc[ai][1][m][1], silu);
                *(v4u*)rowp = (v4u){lo.x, lo.y, hi.x, hi.y}; } EPI_ROWS_END
            return;
        }
        unsigned char* base; int ldc, ct;
        if (u.pn < 8) { base = QF8; ldc = 1536; ct = u.pn; } else { base = AQKV8; ldc = 2304; ct = u.pn - 8; }
        const int col0 = ct * BM + wc * 64 + 16 * fq; const float sq = (float)(1 << SH_Q);
        EPI_ROWS_BEGIN { unsigned char* rowp = base + (size_t)(u.pm * BM + rt) * ldc + col0;
            const f32x4 a = acc[ai][0][m][0] * sq, b = acc[ai][0][m][1] * sq, c = acc[ai][1][m][0] * sq, d = acc[ai][1][m][1] * sq;
            *(v4u*)rowp = (v4u){cvt4_fp8(a[0], a[1], a[2], a[3]), cvt4_fp8(b[0], b[1], b[2], b[3]), cvt4_fp8(c[0], c[1], c[2], c[3]), cvt4_fp8(d[0], d[1], d[2], d[3])}; } EPI_ROWS_END
    }
};
template <bool ADD> struct EpiBranch { static constexpr int MID_T = 0; static constexpr int NST = 0; __device__ __forceinline__ bool full(const Unit&) const { return false; }
    const unsigned char* G; int goff; bf16* O;
    __device__ __forceinline__ void operator()(const f32x4 (&acc)[2][2][4][2], const Unit& u, int wr, int wc, int fr, int fq) const {
        const int col0 = u.pn * BM + wc * WCS + 8 * fq;
        EPI_ROWS_BEGIN { const size_t row = (size_t)(u.pm * BM + rt);
#pragma unroll
            for (int bj = 0; bj < 2; ++bj) {
                const v2u g = *(const v2u*)(G + row * 2048 + goff + col0 + bj * BJS); const float gs = 1.0f / (float)(1 << SH_G);
                const f32x2_t g0 = __builtin_amdgcn_cvt_pk_f32_fp8((int)g.x, false), g1 = __builtin_amdgcn_cvt_pk_f32_fp8((int)g.x, true), g2 = __builtin_amdgcn_cvt_pk_f32_fp8((int)g.y, false), g3 = __builtin_amdgcn_cvt_pk_f32_fp8((int)g.y, true);
                f32x4 a = acc[ai][bj][m][0] * (f32x4){g0[0], g0[1], g1[0], g1[1]} * gs, b = acc[ai][bj][m][1] * (f32x4){g2[0], g2[1], g3[0], g3[1]} * gs;
                bf16* op = O + row * 1024 + col0 + bj * BJS;
                if (ADD) { const v4u o = *(const v4u*)op; a[0] += bflo(o.x); a[1] += bfhi(o.x); a[2] += bflo(o.y); a[3] += bfhi(o.y); b[0] += bflo(o.z); b[1] += bfhi(o.z); b[2] += bflo(o.w); b[3] += bfhi(o.w); }
                *(v4u*)op = pack8(a, b); } } EPI_ROWS_END
    }
};
struct EpiMerge {
    static constexpr int NST = 8; __device__ __forceinline__ bool full(const Unit&) const { return true; }
    static constexpr int MID_T = 4;
    const unsigned char* G; unsigned char* O;
    __device__ __forceinline__ static void dec8(const v2u g, float (&f)[8]) { const f32x2_t a = __builtin_amdgcn_cvt_pk_f32_fp8((int)g.x, false), b = __builtin_amdgcn_cvt_pk_f32_fp8((int)g.x, true), c = __builtin_amdgcn_cvt_pk_f32_fp8((int)g.y, false), d = __builtin_amdgcn_cvt_pk_f32_fp8((int)g.y, true);
        f[0] = a[0]; f[1] = a[1]; f[2] = b[0]; f[3] = b[1]; f[4] = c[0]; f[5] = c[1]; f[6] = d[0]; f[7] = d[1]; }
    __device__ __forceinline__ void mid(f32x4 (&acc)[2][2][4][2], const Unit& u, int wr, int wc, int fr, int fq) const {
        const int col0 = u.pn * BM + wc * 64 + 16 * fq;
        v4u gav[8], gbv[8];
#pragma unroll
        for (int q = 0; q < 8; ++q) { const size_t row = (size_t)(u.pm * BM + (q >> 2) * HALF + wr * 64 + (q & 3) * 16 + fr); gav[q] = *(const v4u*)(G + row * 2048 + col0); gbv[q] = *(const v4u*)(G + row * 2048 + 1024 + col0); }
        asm volatile("" ::: "memory");
        EPI_ROWS_BEGIN { const v4u ga = gav[ai * 4 + m], gb = gbv[ai * 4 + m];
#pragma unroll
            for (int bj = 0; bj < 2; ++bj) { float sa[8], sb[8]; dec8(bj ? (v2u){ga.z, ga.w} : (v2u){ga.x, ga.y}, sa); dec8(bj ? (v2u){gb.z, gb.w} : (v2u){gb.x, gb.y}, sb);
#pragma unroll
                for (int j = 0; j < 4; ++j) { acc[ai][bj][m][0][j] *= sa[j] * __builtin_amdgcn_rcpf(fmaxf(sb[j], 0.001953125f)); acc[ai][bj][m][1][j] *= sa[4 + j] * __builtin_amdgcn_rcpf(fmaxf(sb[4 + j], 0.001953125f)); } } } EPI_ROWS_END
    }
    __device__ __forceinline__ void operator()(const f32x4 (&acc)[2][2][4][2], const Unit& u, int wr, int wc, int fr, int fq) const {
        const int col0 = u.pn * BM + wc * 64 + 16 * fq;
        v4u gbv[8];
#pragma unroll
        for (int q = 0; q < 8; ++q) { const size_t row = (size_t)(u.pm * BM + (q >> 2) * HALF + wr * 64 + (q & 3) * 16 + fr); gbv[q] = *(const v4u*)(G + row * 2048 + 1024 + col0); }
        asm volatile("" ::: "memory");
        EPI_ROWS_BEGIN { const size_t row = (size_t)(u.pm * BM + rt);
            const v4u gb = gbv[ai * 4 + m]; unsigned ow[4];
#pragma unroll
            for (int bj = 0; bj < 2; ++bj) { float sb[8]; dec8(bj ? (v2u){gb.z, gb.w} : (v2u){gb.x, gb.y}, sb); const float gs = 1.0f / (float)(1 << SH_G);
                f32x4 a = acc[ai][bj][m][0], b = acc[ai][bj][m][1];
#pragma unroll
                for (int j = 0; j < 4; ++j) { a[j] *= fmaxf(sb[j], 0.001953125f) * (gs * (float)(1 << SH_M)); b[j] *= fmaxf(sb[4 + j], 0.001953125f) * (gs * (float)(1 << SH_M)); }
                ow[2 * bj] = cvt4_fp8(a[0], a[1], a[2], a[3]); ow[2 * bj + 1] = cvt4_fp8(b[0], b[1], b[2], b[3]); }
            *(v4u*)(O + row * 1024 + col0) = (v4u){ow[0], ow[1], ow[2], ow[3]}; } EPI_ROWS_END
    }
};
struct EpiOut { static constexpr int MID_T = 0; static constexpr int NST = 16; __device__ __forceinline__ bool full(const Unit&) const { return true; }
    const float* x; bf16* x1; const float* mod;
    __device__ __forceinline__ void operator()(const f32x4 (&acc)[2][2][4][2], const Unit& u, int wr, int wc, int fr, int fq) const {
        const int col0 = u.pn * BM + wc * WCS + 8 * fq; const int b = u.pm >> 4;
        f32x4 gt[2][2];
#pragma unroll
        for (int bj = 0; bj < 2; ++bj)
#pragma unroll
            for (int n = 0; n < 2; ++n) { const int c = 2048 + col0 + bj * BJS + 4 * n; gt[bj][n] = *(const f32x4*)(mod + b * 6144 + c); }
        EPI_ROWS_BEGIN { const size_t off = (size_t)(u.pm * BM + rt) * 1024 + col0;
#pragma unroll
            for (int bj = 0; bj < 2; ++bj) { const size_t o2 = off + bj * BJS;
                *(v4u*)(x1 + o2) = pack8(__builtin_nontemporal_load((const f32x4*)(x + o2)) + gt[bj][0] * acc[ai][bj][m][0], __builtin_nontemporal_load((const f32x4*)(x + o2 + 4)) + gt[bj][1] * acc[ai][bj][m][1]); } } EPI_ROWS_END
    }
};
__device__ __forceinline__ v4u swiglu8(const f32x4 g0, const f32x4 g1, const f32x4 u0, const f32x4 u1) {
    f32x4 a, b;
#pragma unroll
    for (int j = 0; j < 4; ++j) { a[j] = fsilu(g0[j]) * u0[j]; b[j] = fsilu(g1[j]) * u1[j]; }
    return pack8(a, b);
}
__device__ __forceinline__ v2u swiglu8_fp8(const f32x4 g0, const f32x4 g1, const f32x4 u0, const f32x4 u1) {
    const float sc = (float)(1 << SH_HMID); float a[4], b[4];
#pragma unroll
    for (int j = 0; j < 4; ++j) { a[j] = fsilu(g0[j]) * u0[j] * sc; b[j] = fsilu(g1[j]) * u1[j] * sc; }
    v2u w; w.x = cvt4_fp8(a[0], a[1], a[2], a[3]); w.y = cvt4_fp8(b[0], b[1], b[2], b[3]); return w;
}
struct EpiRS { static constexpr int MID_T = 0; static constexpr int NST = 0; __device__ __forceinline__ bool full(const Unit&) const { return false; }
    float* logits; unsigned char* hsh;
    __device__ __forceinline__ void operator()(const f32x4 (&acc)[2][2][4][2], const Unit& u, int wr, int wc, int fr, int fq) const {
        if (u.pn == 0) {
            EPI_ROWS_BEGIN { float* rowp = logits + (size_t)(u.pm * BM + rt) * 256 + wc * WCS + 8 * fq;
#pragma unroll
                for (int bj = 0; bj < 2; ++bj)
#pragma unroll
                    for (int n = 0; n < 2; ++n) *(f32x4*)(rowp + bj * BJS + 4 * n) = acc[ai][bj][m][n]; } EPI_ROWS_END
        } else {
            const int hc = (u.pn - 1) * HALF + wc * WCS + 8 * fq;
            EPI_ROWS_BEGIN { *(v2u*)(hsh + (size_t)(u.pm * BM + rt) * 256 + hc) = swiglu8_fp8(acc[ai][0][m][0], acc[ai][0][m][1], acc[ai][1][m][0], acc[ai][1][m][1]); } EPI_ROWS_END
        }
    }
};
struct EpiRL { static constexpr int MID_T = 0; static constexpr int NST = 0; __device__ __forceinline__ bool full(const Unit&) const { return false; }
    float* logits;
    __device__ __forceinline__ void operator()(const f32x4 (&acc)[2][2][4][2], const Unit& u, int wr, int wc, int fr, int fq) const {
        EPI_ROWS_BEGIN { float* rowp = logits + (size_t)(u.pm * BM + rt) * 256 + wc * WCS + 8 * fq;
#pragma unroll
            for (int bj = 0; bj < 2; ++bj)
#pragma unroll
                for (int n = 0; n < 2; ++n) *(f32x4*)(rowp + bj * BJS + 4 * n) = acc[ai][bj][m][n]; } EPI_ROWS_END
    }
};
struct EpiGU { static constexpr int MID_T = 0; static constexpr int NST = 4; __device__ __forceinline__ bool full(const Unit& u) const { return u.rows == BM; }
    unsigned char* hmid;
    __device__ __forceinline__ void operator()(const f32x4 (&acc)[2][2][4][2], const Unit& u, int wr, int wc, int fr, int fq) const {
        const int hi = fq >> 1, hc = u.pn * HALF + wc * 32 + 16 * (fq & 1);
#pragma unroll
        for (int ai = 0; ai < 2; ++ai)
#pragma unroll
            for (int m = 0; m < 4; m += 2) {
                v2u a = swiglu8_fp8(acc[ai][0][m][0], acc[ai][0][m][1], acc[ai][1][m][0], acc[ai][1][m][1]), b = swiglu8_fp8(acc[ai][0][m + 1][0], acc[ai][0][m + 1][1], acc[ai][1][m + 1][0], acc[ai][1][m + 1][1]);
                { auto r0 = __builtin_amdgcn_permlane32_swap(a.x, b.x, false, false); a.x = r0[0]; b.x = r0[1]; auto r1 = __builtin_amdgcn_permlane32_swap(a.y, b.y, false, false); a.y = r1[0]; b.y = r1[1]; }
                const int rt = ai * HALF + wr * 64 + (m + hi) * 16 + fr;
                if (rt < u.rows) *(v4u*)(hmid + (size_t)(u.row0 + rt) * 256 + hc) = (v4u){a.x, a.y, b.x, b.y}; }
    }
};
struct EpiSD { static constexpr int MID_T = 0; static constexpr int NST = 0; __device__ __forceinline__ bool full(const Unit&) const { return false; }
    bf16* ysh;
    __device__ __forceinline__ void operator()(const f32x4 (&acc)[2][2][4][2], const Unit& u, int wr, int wc, int fr, int fq) const {
        const int col0 = u.pn * BM + wc * WCS + 8 * fq;
        EPI_ROWS_BEGIN { bf16* rowp = ysh + (size_t)(u.pm * BM + rt) * 1024 + col0;
#pragma unroll
            for (int bj = 0; bj < 2; ++bj) *(v4u*)(rowp + bj * BJS) = pack8(acc[ai][bj][m][0], acc[ai][bj][m][1]); } EPI_ROWS_END
    }
};
struct EpiRD { static constexpr int MID_T = 0; static constexpr int NST = 8; __device__ __forceinline__ bool full(const Unit& u) const { return u.rows == BM; }
    unsigned char* yslot; const float* slot_w;
    __device__ __forceinline__ void operator()(const f32x4 (&acc)[2][2][4][2], const Unit& u, int wr, int wc, int fr, int fq) const {
        const int col0 = u.pn * BM + wc * 64 + 16 * fq;
        EPI_ROWS_BEGIN { if (rt < u.rows) { const float w = (float)(1 << SH_Y); unsigned char* rowp = yslot + (size_t)(u.row0 + rt) * 1024 + col0;
            const f32x4 a = acc[ai][0][m][0] * w, b = acc[ai][0][m][1] * w, c = acc[ai][1][m][0] * w, d = acc[ai][1][m][1] * w;
            *(v4u*)rowp = (v4u){cvt4_fp8(a[0], a[1], a[2], a[3]), cvt4_fp8(b[0], b[1], b[2], b[3]), cvt4_fp8(c[0], c[1], c[2], c[3]), cvt4_fp8(d[0], d[1], d[2], d[3])}; } } EPI_ROWS_END
    }
};
}

struct Args { const float* in[21]; float* out; unsigned char* ws; int ph_lo, ph_hi; };
struct Frame {
    LAS unsigned char* lds; volatile LAS unsigned* MISC; gu32* ctl;
    int tid, lane, wave, vcu, G, gw, NGW;
};

__device__ __forceinline__ void transpose_item(const float* W, int ldn, bf16* WT, int ldk, int k0, int n0, int drow0, LAS float* scr, int lane) {
#pragma unroll 8
    for (int i = 0; i < 32; ++i) { const int kk = 2 * i + (lane >> 5); scr[kk * 33 + (lane & 31)] = W[(size_t)(k0 + kk) * ldn + n0 + (lane & 31)]; }
    LDS_WAIT(); asm volatile("" ::: "memory");
    const int c = lane & 7;
#pragma unroll
    for (int j = 0; j < 4; ++j) { const int n = (lane >> 3) + 8 * j; const LAS float* s = scr + (8 * c) * 33 + n;
        v4u o; o.x = cvt_pk_bf16(s[0 * 33], s[1 * 33]); o.y = cvt_pk_bf16(s[2 * 33], s[3 * 33]); o.z = cvt_pk_bf16(s[4 * 33], s[5 * 33]); o.w = cvt_pk_bf16(s[6 * 33], s[7 * 33]);
        *(GAS v4u*)(WT + (size_t)(drow0 + n) * ldk + k0 + 8 * c) = o; }
    LDS_WAIT(); asm volatile("" ::: "memory");
}
struct ConvDesc { const float* W; unsigned char* WT; int ldn, ldk, k0, n0, drow0; float scale; };
__device__ __forceinline__ void ti_load(const ConvDesc& d, int lane, f32x4 (&r)[16]) {
#pragma unroll
    for (int i = 0; i < 16; ++i) r[i] = __builtin_nontemporal_load((const f32x4*)(d.W + (size_t)(d.k0 + 8 * i + (lane >> 3)) * d.ldn + d.n0 + (lane & 7) * 4));
}
#ifndef TR8_MAP
#define TR8_MAP 0
#endif
typedef int v2i_t __attribute__((ext_vector_type(2)));
__device__ __forceinline__ void ti_store(const ConvDesc& d, const f32x4 (&r)[16], LAS float* scr, int lane) {
    LAS unsigned char* Tl = (LAS unsigned char*)scr; const float sc = d.scale;
#pragma unroll
    for (int i = 0; i < 16; ++i) *(LAS unsigned*)(Tl + (8 * i + (lane >> 3)) * 32 + (lane & 7) * 4) = cvt4_fp8(r[i][0] * sc, r[i][1] * sc, r[i][2] * sc, r[i][3] * sc);
    LDS_WAIT(); asm volatile("" ::: "memory");
    const int g = lane >> 4, l = lane & 15, nh = g & 1, ch = g >> 1, n = 16 * nh + l;
    const int rr = TR8_MAP ? (l & 7) : (l >> 1), cc = TR8_MAP ? (l >> 3) : (l & 1);
    LAS unsigned char* T2 = Tl + 4096;
#pragma unroll
    for (int j = 0; j < 4; ++j) { const int c = 4 * ch + j;
        const v2i_t lo = __builtin_amdgcn_ds_read_tr8_b64_v2i32((LAS v2i_t*)(Tl + (16 * c + rr) * 32 + 16 * nh + 8 * cc));
        const v2i_t hi = __builtin_amdgcn_ds_read_tr8_b64_v2i32((LAS v2i_t*)(Tl + (16 * c + 8 + rr) * 32 + 16 * nh + 8 * cc));
        *(LAS v4u*)(T2 + n * 144 + 16 * c) = (v4u){(unsigned)lo.x, (unsigned)lo.y, (unsigned)hi.x, (unsigned)hi.y}; }
    LDS_WAIT(); asm volatile("" ::: "memory");
#pragma unroll
    for (int j = 0; j < 4; ++j) { const int n2 = (lane >> 3) + 8 * j, c2 = lane & 7;
        __builtin_nontemporal_store(*(const LAS v4u*)(T2 + n2 * 144 + 16 * c2), (GAS v4u*)(d.WT + (size_t)(d.drow0 + n2) * d.ldk + d.k0 + 16 * c2)); }
    LDS_WAIT(); asm volatile("" ::: "memory");
}
__device__ __forceinline__ ConvDesc conv_desc_fp8(const float* W, int K, int N, unsigned char* WT, int mode, int rowbase, int item, float scale) {
    const int nblk = N / 32, kb = item / nblk, nb = item % nblk, k0 = 128 * kb, n0 = 32 * nb;
    int drow0 = rowbase + n0;
    if (mode) drow0 = rowbase + (n0 >> 5) * 64 + (mode - 1) * 32;
    return ConvDesc{W, WT, N, K, k0, n0, drow0, scale};
}
__device__ __forceinline__ void conv_item(const float* W, int K, int N, bf16* WT, int mode, int rowbase, int item, LAS float* scr, int lane) {
    const int nblk = N / 32, kb = item / nblk, nb = item % nblk, k0 = 64 * kb, n0 = 32 * nb;
    int drow0 = rowbase + n0;
    if (mode) drow0 = rowbase + (n0 >> 7) * 256 + (mode - 1) * 128 + (n0 & 127);
    transpose_item(W, N, WT, K, k0, n0, drow0, scr, lane);
}

__global__ void __launch_bounds__(NWAVES * 64, 2) mk_fwd(Args args) {
    extern __shared__ __attribute__((aligned(16))) unsigned char lds_raw[];
    Frame F;
    F.lds = (LAS unsigned char*)lds_raw;
    F.MISC = (volatile LAS unsigned*)(F.lds + MISC_OFF);
    F.tid = threadIdx.x; F.lane = F.tid & 63; F.wave = __builtin_amdgcn_readfirstlane(F.tid >> 6);
    F.G = gridDim.x; { const int bx = blockIdx.x; F.vcu = (F.G % 8 == 0) ? (bx % 8) * (F.G / 8) + bx / 8 : bx; }
    F.gw = F.vcu * NWAVES + F.wave; F.NGW = F.G * NWAVES;
    unsigned char* ws = args.ws;
    F.ctl = (gu32*)(ws + WS_CTL);
    const int tid = F.tid, lane = F.lane, wave = F.wave;
    LAS unsigned char* lds = F.lds;

#define X_IN (args.in[0])
#define cvec (args.in[1])
#define ada_w (args.in[2])
#define ada_b (args.in[3])
#define norm1_g (args.in[4])
#define w_in (args.in[5])
#define lb_logits (args.in[6])
#define hg_norm_g (args.in[7])
#define w_branch_a (args.in[8])
#define w_branch_b (args.in[9])
#define w_out (args.in[10])
#define norm2_g (args.in[11])
#define w_router (args.in[12])
#define router_bias (args.in[13])
#define w_exp_gate (args.in[14])
#define w_exp_up (args.in[15])
#define w_exp_down (args.in[16])
#define w_sh_gate (args.in[17])
#define w_sh_up (args.in[18])
#define w_sh_down (args.in[19])
#define final_g (args.in[20])
#define out (args.out)
#define WIN_T ((bf16*)(ws + WS_WIN_T))
#define WA_T ((bf16*)(ws + WS_WA_T))
#define WB_T ((bf16*)(ws + WS_WB_T))
#define WO_T ((bf16*)(ws + WS_WO_T))
#define RS_T ((bf16*)(ws + WS_RS_T))
#define WSD_T ((bf16*)(ws + WS_WSD_T))
#define WD ((bf16*)(ws + WS_WD))
#define WGU ((bf16*)(ws + WS_WGU))
#define PE ((int*)(ws + WS_PE))
#define PR ((int*)(ws + WS_PR))
#define PW ((float*)(ws + WS_PW))
#define SLOT_TOK ((int*)(ws + WS_SLOT_TOK))
#define SLOT_W ((float*)(ws + WS_SLOT_W))
#define TOK_SLOT ((int*)(ws + WS_TOK_SLOT))
#define LSE ((float*)(ws + WS_LSE))
#define QF ((bf16*)(ws + WS_QF))
#define OA ((bf16*)(ws + WS_OA))
#define OG ((bf16*)(ws + WS_OG))
#define MERGED ((bf16*)(ws + WS_MERGED))
#define HMID ((bf16*)(ws + WS_HMID))
#define YSH (((unsigned char*)(ws + WS_YSLOT)) + (size_t)NSLOTP * 1024)
#define AQKV ((bf16*)(ws + WS_AQKV))
#define GAB ((bf16*)(ws + WS_GAB))
#define XN ((bf16*)(ws + WS_XN))
#define YA ((bf16*)(ws + WS_YA))
#define YB ((bf16*)(ws + WS_YB))
#define H2 ((bf16*)(ws + WS_H2))
#define LOGITS ((float*)(ws + WS_LOGITS))
#define YSLOT ((bf16*)(ws + WS_YSLOT))
#define MOD ((float*)(ws + WS_MOD))
#define HISTG ((unsigned*)(ws + WS_HISTG))
#define ATTQ (((unsigned*)(ws + WS_CTL)) + CW_ATTQ)
    for (int u = tid; u < 64; u += NWAVES * 64) ((LAS unsigned*)(lds + MISC_OFF))[u] = 0u;
    __syncthreads();
    XcdBarrier bar = xcd_barrier_post((unsigned*)(F.ctl + CW_BAR), F.MISC + 8);
    const int lo = args.ph_lo, hi = args.ph_hi;
#ifndef PHMASK
#define PHMASK 0x3fff
#endif
#define IN(k) (((PHMASK >> (k)) & 1) && lo <= (k) && (k) < hi)
#define SEAM(k) do { if (IN(k) && IN((k) + 1)) xcd_barrier(bar); } while (0)
#ifndef ALIGN_P2
#define ALIGN_P2 true
#endif
#ifndef ALIGN_P12
#define ALIGN_P12 true
#endif
#ifndef ALIGN_DEFAULT
#define ALIGN_DEFAULT true
#endif
#ifndef REPMASK
#define REPMASK 0
#endif
#ifndef CONV2_ITEMS
#define CONV2_ITEMS 42700
#endif
#ifndef DBG_H1_ST
#define DBG_H1_ST 1
#endif
#ifndef DBG_ATT_NOLOAD
#define DBG_ATT_NOLOAD 0
#endif
#ifndef TKI
#define TKI 8
#endif
#ifndef CONV11_ITEMS
#define CONV11_ITEMS 7000
#endif
#ifndef CONV11_MINWG
#define CONV11_MINWG 16
#endif
#ifndef P2_GEMM_WGS
#define P2_GEMM_WGS 178
#endif
#define REPS(k) (((REPMASK >> (k)) & 1) ? 2 : 1)
#define REP_BEGIN(k) _Pragma("unroll") for (int rep = 0; rep < REPS(k); ++rep) {
#define REP_END(k) if (rep + 1 < REPS(k)) xcd_barrier(bar); }

        constexpr int I_IN = 8 * 200, I_A = 4 * 32, I_B = 2 * 32, I_O = 8 * 32, I_SD = 2 * 32, I_E = 8 * 8, I_ED = 2 * 32;
        constexpr int NSMALL = I_IN + I_A + I_B + I_O + I_SD;
        constexpr int NITEMS = NSMALL + 2 * (NEXP + 1) * I_E + NEXP * I_ED;
    constexpr int NCONV2 = CONV2_ITEMS;
    const int NGB = (F.G == 256 && NCONV2 > 0) ? P2_GEMM_WGS : F.G;
    constexpr int NCONV11 = CONV11_ITEMS;
    static_assert(NITEMS - NCONV2 - NCONV11 >= I_IN, "the input-projection weights must be converted in P0");
    const int nitems0 = (NGB < F.G) ? NITEMS - NCONV2 - NCONV11 : NITEMS;
    auto conv_desc = [&](int it) __attribute__((always_inline)) -> ConvDesc {
            int r = it;
            if (r < I_IN) return conv_desc_fp8(w_in, 1024, NIN, (unsigned char*)WIN_T, 0, 0, r, (float)(1 << SH_WGU)); r -= I_IN;
            if (r < I_A) { const int kb = r / 32, nb = r % 32; return ConvDesc{w_branch_a, (unsigned char*)WA_T, 1024, 768, 128 * kb, 32 * nb, 32 * nb, (float)(1 << SH_WAB)}; } r -= I_A;
            if (r < I_B) { const int kb = r / 32, nb = r % 32; return ConvDesc{w_branch_b, (unsigned char*)WA_T + 512, 1024, 768, 128 * kb, 32 * nb, 32 * nb, (float)(1 << SH_WAB)}; } r -= I_B;
            if (r < I_O) return conv_desc_fp8(w_out, 1024, 1024, (unsigned char*)WO_T, 0, 0, r, (float)(1 << SH_WGU)); r -= I_O;
            if (r < I_SD) return conv_desc_fp8(w_sh_down, 256, 1024, (unsigned char*)WD, 0, NEXP * 1024, r, (float)(1 << SH_WD)); r -= I_SD;
            if (r < 2 * (NEXP + 1) * I_E) { const int seg = r / ((NEXP + 1) * I_E), rr = r % ((NEXP + 1) * I_E), e = rr / I_E, ii = rr % I_E;
                const float* src = (seg == 0) ? (e < NEXP ? w_exp_gate + (size_t)e * 1024 * 256 : w_sh_gate) : (e < NEXP ? w_exp_up + (size_t)e * 1024 * 256 : w_sh_up);
                return conv_desc_fp8(src, 1024, 256, (unsigned char*)WGU, seg + 1, e * 512, ii, (float)(1 << SH_WGU)); }
            r -= 2 * (NEXP + 1) * I_E; const int e = r / I_ED, ii = r % I_ED;
            return conv_desc_fp8(w_exp_down + (size_t)e * 256 * 1024, 256, 1024, (unsigned char*)WD, 0, e * 1024, ii, (float)(1 << SH_WD));
    };
    auto conv_run = [&](int first, int end, int stride, LAS float* scr) __attribute__((always_inline)) {
        int it = first; if (it >= end) return;
        ConvDesc d = conv_desc(it); f32x4 r[16]; ti_load(d, lane, r);
        for (;;) {
            const int nx = it + stride; const bool more = nx < end;
            ConvDesc dn = d; f32x4 rn[16];
            if (more) { dn = conv_desc(nx); ti_load(dn, lane, rn); }
            ti_store(d, r, scr, lane);
            if (!more) break;
            d = dn; it = nx;
#pragma unroll
            for (int i = 0; i < 16; ++i) r[i] = rn[i];
        }
    };

    if (IN(0)) { REP_BEGIN(0)
        {
            LAS float* sc = (LAS float*)lds; LAS float* red = (LAS float*)(lds + 32768);
            for (int i = tid; i < NB * D; i += NWAVES * 64) sc[i] = fsilu(cvec[i]);
            __syncthreads();
            _Pragma("unroll") for (int sr = 0; sr < (((REPMASK >> 19) & 1) ? 2 : 1); ++sr)
            for (int cbk = blockIdx.x; cbk < 256; cbk += F.G) {
                const int j0 = cbk * 24, kg = tid >> 3, cc = tid & 7;
                float a8[8][3];
#pragma unroll
                for (int b = 0; b < 8; ++b) { a8[b][0] = 0.f; a8[b][1] = 0.f; a8[b][2] = 0.f; }
                for (int r = 0; r < 16; ++r) { const int i = kg * 16 + r; const float* wp = ada_w + (size_t)i * 6144 + j0 + 3 * cc; const float w0 = wp[0], w1 = wp[1], w2 = wp[2];
#pragma unroll
                    for (int b = 0; b < 8; ++b) { const float sv = sc[b * 1024 + i]; a8[b][0] += sv * w0; a8[b][1] += sv * w1; a8[b][2] += sv * w2; } }
#pragma unroll
                for (int b = 0; b < 8; ++b) { red[(kg * 8 + b) * 24 + 3 * cc + 0] = a8[b][0]; red[(kg * 8 + b) * 24 + 3 * cc + 1] = a8[b][1]; red[(kg * 8 + b) * 24 + 3 * cc + 2] = a8[b][2]; }
                __syncthreads();
                if (tid < 192) { const int b = tid / 24, col = tid % 24; float sum = ada_b[j0 + col];
                    for (int g = 0; g < 64; ++g) sum += red[(g * 8 + b) * 24 + col];
                    MOD[b * 6144 + j0 + col] = sum; }
                __syncthreads();
            }
        }
        LAS float* scr = (LAS float*)(lds + wave * 16384);
        conv_run(F.gw, nitems0, F.NGW, scr);
    REP_END(0) }
    SEAM(0);

    if (IN(1)) { REP_BEGIN(1)
        for (int m0 = F.gw * 16; m0 < T; m0 += F.NGW * 16) {
            const int b = m0 >> 12;
            f32x4 mul[4], add[4];
#pragma unroll
            for (int j = 0; j < 4; ++j) { const int c = 4 * lane + 256 * j;
                const f32x4 s1 = *(const f32x4*)(MOD + b * 6144 + 1024 + c);
                mul[j] = *(const f32x4*)(norm1_g + c) * (s1 + 1.0f);
                add[j] = *(const f32x4*)(MOD + b * 6144 + c); }
            for (int m = m0; m < m0 + 16; ++m) {
                const GAS f32x4* xr = (const GAS f32x4*)(X_IN + (size_t)m * D) + lane;
                f32x4 v[4]; float s = 0.f;
#pragma unroll
                for (int j = 0; j < 4; ++j) { v[j] = xr[64 * j]; s += (v[j].x * v[j].x + v[j].y * v[j].y) + (v[j].z * v[j].z + v[j].w * v[j].w); }
                const float rstd = 1.0f / sqrtf(wave_sum(s) * (1.f / D) + RMS_EPS);
                GAS unsigned* o4 = (GAS unsigned*)((unsigned char*)XN + (size_t)m * D) + lane;
#pragma unroll
                for (int j = 0; j < 4; ++j) { const f32x4 y = v[j] * rstd * mul[j] + add[j]; const float sx = (float)(1 << SH_X); o4[64 * j] = cvt4_fp8(y.x * sx, y.y * sx, y.z * sx, y.w * sx); }
            }
        }
        for (int it = blockIdx.x; it < 256; it += F.G) {
            const int b = it >> 5, e = tid & 255, dh = tid >> 8, d0 = 32 * (it & 31) + 16 * dh;
            float wv[16];
#pragma unroll
            for (int j = 0; j < 16; ++j) wv[j] = w_router[(size_t)(d0 + j) * 256 + e];
            float part = 0.f; unsigned pk[8];
#pragma unroll
            for (int j = 0; j < 16; j += 2) {
                const float a0 = norm2_g[d0 + j] * (1.0f + MOD[b * 6144 + 4096 + d0 + j]), a1 = norm2_g[d0 + j + 1] * (1.0f + MOD[b * 6144 + 4096 + d0 + j + 1]);
                part += MOD[b * 6144 + 3072 + d0 + j] * wv[j]; part += MOD[b * 6144 + 3072 + d0 + j + 1] * wv[j + 1];
                pk[j >> 1] = cvt_pk_bf16(wv[j] * a0, wv[j + 1] * a1); }
            GAS v4u* wp = (GAS v4u*)((bf16*)(ws + WS_WRB) + ((size_t)(b * 256 + e) * 1024 + d0));
            v4u o0, o1; o0.x = pk[0]; o0.y = pk[1]; o0.z = pk[2]; o0.w = pk[3]; o1.x = pk[4]; o1.y = pk[5]; o1.z = pk[6]; o1.w = pk[7]; wp[0] = o0; wp[1] = o1;
            ((float*)(ws + WS_PART))[(size_t)(b * 64 + (it & 31) * 2 + dh) * 256 + e] = part;
        }
    REP_END(1) }
    SEAM(1);

    if (IN(2)) { REP_BEGIN(2)
        if ((int)blockIdx.x < NGB) {
            pg8::DenseSched S; S.init(T, NIN, 1024, NGB, (int)blockIdx.x, WIN_T);
            pg8::EpiWin E{(unsigned char*)QF, (unsigned char*)AQKV, (unsigned char*)GAB, (unsigned char*)GAB + (size_t)T * 2048, 0};
            pg8::gemm_phase<ALIGN_P2, true, pg8::EpiWin, pg8::DenseSched, 2>(lds, (const char*)XN, 1024, S, E, SC_WGU, SC_X);
        } else {
            LAS float* scr2 = (LAS float*)(lds + wave * 16384);
            conv_run(nitems0 + ((int)blockIdx.x - NGB) * NWAVES + wave, NITEMS - NCONV11, (F.G - NGB) * NWAVES, scr2);
        }
    REP_END(2) }
    SEAM(2);

    if (IN(3)) { REP_BEGIN(3)
        const int fr = lane & 15, fq = lane >> 4;
        bf16* QTB = (bf16*)(ws + WS_QTB); unsigned char* UT = (unsigned char*)(ws + WS_UT); float* DKB = (float*)(ws + WS_DK);
        {
            constexpr int NH1 = NB * 4 * 64, NATT = NB * 3 * 4 * 32;
            {
                const int kq = tid & 31, rg = tid >> 5, vrow = tid >> 3, v16 = (tid & 7) * 16;
                unsigned rq[4], rf[4]; v4u rv0;
                const unsigned char* QF8 = (const unsigned char*)QF;
#define H1_LOAD(w) do { const int b_ = (w) >> 8, h_ = ((w) >> 6) & 3, c_ = (w) & 63; const size_t r0_ = (size_t)(b_ * SEQ + c_ * 64); \
                _Pragma("unroll") for (int rr = 0; rr < 4; ++rr) { const size_t ro = (r0_ + rg * 4 + rr) * 1536 + h_ * 128 + 4 * kq; rq[rr] = *(const unsigned*)(QF8 + ro); rf[rr] = *(const unsigned*)(QF8 + ro + 512); } \
                rv0 = *(const v4u*)(QF8 + (r0_ + vrow) * 1536 + 1024 + h_ * 128 + v16); } while (0)
                if ((int)blockIdx.x < NH1) { H1_LOAD((int)blockIdx.x); }
                _Pragma("unroll") for (int sr = 0; sr < (((REPMASK >> 16) & 1) ? 2 : 1); ++sr) { if (sr) { H1_LOAD((int)blockIdx.x); }
                int hprev = -1; float lbv[4] = {0.f, 0.f, 0.f, 0.f};
                for (int wi = blockIdx.x, j1 = 0; wi < NH1; wi += F.G, ++j1) {
                    const int b = wi >> 8, h = (wi >> 6) & 3, c = wi & 63;
                    constexpr int QT_S = 272, KH_S = 144, VR_S = 288;
                    LAS unsigned char* Qt = lds;
                    LAS unsigned char* Kt = lds + 17408;
                    LAS unsigned char* Kh = lds + 34816;
                    LAS unsigned char* Vr = lds + 53248;
                    LAS unsigned char* Asc = lds + 71680;
                    LAS float* btot = (LAS float*)(lds + 80896);
                    if (h != hprev) { hprev = h;
                        const f32x4 l0 = *(const f32x4*)(lb_logits + h * 128 + 4 * kq), l1 = *(const f32x4*)(lb_logits + 512 + h * 128 + 4 * kq);
#pragma unroll
                        for (int ch = 0; ch < 4; ++ch) lbv[ch] = 1.0f / (1.0f + __expf(l1[ch] - l0[ch])); }
                    const size_t row0 = (size_t)(b * SEQ + c * 64);
                    const float rq_ = 1.0f / (float)(1 << SH_Q);
                    LBAR();
                    for (int i = tid; i < 9216 / 4; i += NWAVES * 64) ((LAS unsigned*)Asc)[i] = 0u;
                    float kk[4][4], bl[4][4]; float run[4] = {0.f, 0.f, 0.f, 0.f};
#pragma unroll
                    for (int rr = 0; rr < 4; ++rr) { const f32x2_t lo = __builtin_amdgcn_cvt_pk_f32_fp8((int)rf[rr], false), hi = __builtin_amdgcn_cvt_pk_f32_fp8((int)rf[rr], true); const float fv[4] = {lo[0], lo[1], hi[0], hi[1]};
#pragma unroll
                        for (int ch = 0; ch < 4; ++ch) { const float sg = fsigmoid(fv[ch] * rq_); const float f = lbv[ch] + (1.0f - lbv[ch]) * sg; run[ch] += __logf(f); bl[rr][ch] = run[ch]; kk[rr][ch] = (1.0f - lbv[ch]) * (1.0f - sg); } }
                    *(LAS f32x4*)(btot + rg * 128 + 4 * kq) = (f32x4){run[0], run[1], run[2], run[3]};
                    {   const unsigned vw[4] = {rv0.x, rv0.y, rv0.z, rv0.w}; unsigned w8[8];
#pragma unroll
                        for (int j = 0; j < 4; ++j) { const f32x2_t lo = __builtin_amdgcn_cvt_pk_f32_fp8((int)vw[j], false), hi = __builtin_amdgcn_cvt_pk_f32_fp8((int)vw[j], true); w8[2 * j] = cvt_pk_bf16(lo[0] * rq_, lo[1] * rq_); w8[2 * j + 1] = cvt_pk_bf16(hi[0] * rq_, hi[1] * rq_); }
                        *(LAS v4u*)(Vr + vrow * VR_S + v16 * 2) = (v4u){w8[0], w8[1], w8[2], w8[3]}; *(LAS v4u*)(Vr + vrow * VR_S + v16 * 2 + 16) = (v4u){w8[4], w8[5], w8[6], w8[7]}; }
                    LBAR();
                    float pre[4] = {0.f, 0.f, 0.f, 0.f}, bend[4] = {0.f, 0.f, 0.f, 0.f};
#pragma unroll
                    for (int g = 0; g < 16; ++g) { const f32x4 tg = *(const LAS f32x4*)(btot + g * 128 + 4 * kq);
#pragma unroll
                        for (int ch = 0; ch < 4; ++ch) { if (g < rg) pre[ch] += tg[ch]; bend[ch] += tg[ch]; } }
#pragma unroll
                    for (int rr = 0; rr < 4; ++rr) { const f32x2_t lo = __builtin_amdgcn_cvt_pk_f32_fp8((int)rq[rr], false), hi = __builtin_amdgcn_cvt_pk_f32_fp8((int)rq[rr], true); const float qf4[4] = {lo[0], lo[1], hi[0], hi[1]};
                        float qv[4], kv[4], kh[4];
#pragma unroll
                        for (int ch = 0; ch < 4; ++ch) { const float bb = pre[ch] + bl[rr][ch]; qv[ch] = qf4[ch] * rq_ * __expf(bb); kv[ch] = kk[rr][ch] * __expf(fminf(-bb, 80.f)); kh[ch] = kk[rr][ch] * __expf(bend[ch] - bb); }
                        *(LAS v2u*)(Qt + (rg * 4 + rr) * QT_S + kq * 8) = (v2u){cvt_pk_bf16(qv[0], qv[1]), cvt_pk_bf16(qv[2], qv[3])};
                        *(LAS v2u*)(Kt + (rg * 4 + rr) * QT_S + kq * 8) = (v2u){cvt_pk_bf16(kv[0], kv[1]), cvt_pk_bf16(kv[2], kv[3])};
                        *(LAS v2u*)(Kh + (rg * 4 + rr) * VR_S + kq * 8) = (v2u){cvt_pk_bf16(kh[0], kh[1]), cvt_pk_bf16(kh[2], kh[3])}; }
                    if (rg == 0) *(f32x4*)(DKB + (size_t)wi * 128 + 4 * kq) = (f32x4){__expf(bend[0]), __expf(bend[1]), __expf(bend[2]), __expf(bend[3])};
                    { const int wn = wi + (int)F.G; if (wn < NH1) { H1_LOAD(wn); } }
                    LBAR();
                    for (int idx = wave; idx < 10; idx += 8) {
                        const int ti = idx < 1 ? 0 : idx < 3 ? 1 : idx < 6 ? 2 : 3; const int si = idx - (ti * (ti + 1)) / 2;
                        f32x4 a4 = (f32x4){0.f, 0.f, 0.f, 0.f};
#pragma unroll
                        for (int ks = 0; ks < 4; ++ks) { const bf16x8 af = *(const LAS bf16x8*)(Qt + (16 * ti + fr) * QT_S + (32 * ks + 8 * fq) * 2); const bf16x8 bfr = *(const LAS bf16x8*)(Kt + (16 * si + fr) * QT_S + (32 * ks + 8 * fq) * 2);
                            a4 = __builtin_amdgcn_mfma_f32_16x16x32_bf16(af, bfr, a4, 0, 0, 0); }
#pragma unroll
                        for (int i = 0; i < 4; ++i) { const int tt = 16 * ti + 4 * fq + i, ss = 16 * si + fr; const float v = (ss <= tt) ? a4[i] : 0.f;
                            *(LAS unsigned short*)(Asc + tt * KH_S + ss * 2) = (unsigned short)(cvt_pk_bf16(v, 0.f) & 0xffff); }
                    }
#pragma unroll
                    for (int j = 0; j < 2; ++j) { const int p = tid + 512 * j, prow = p >> 4, c16 = p & 15; if (DBG_H1_ST || sr) *(v4u*)(QTB + (row0 + prow) * 512 + h * 128 + c16 * 8) = *(const LAS v4u*)(Qt + prow * QT_S + c16 * 16); }
                    bf16x8 vf[2];
#pragma unroll
                    for (int ks = 0; ks < 2; ++ks) {
                        const v2u a0 = __builtin_bit_cast(v2u, __builtin_amdgcn_ds_read_tr16_b64_v4i16((LAS v4i16_t*)(Vr + (32 * ks + 8 * fq + (fr >> 2)) * VR_S + (16 * wave + 4 * (fr & 3)) * 2)));
                        const v2u a1 = __builtin_bit_cast(v2u, __builtin_amdgcn_ds_read_tr16_b64_v4i16((LAS v4i16_t*)(Vr + (32 * ks + 8 * fq + 4 + (fr >> 2)) * VR_S + (16 * wave + 4 * (fr & 3)) * 2)));
                        vf[ks] = __builtin_bit_cast(bf16x8, (v4u){a0.x, a0.y, a1.x, a1.y}); }
                    {   unsigned uw[8];
#pragma unroll
                        for (int kt = 0; kt < 8; ++kt) { f32x4 u4 = (f32x4){0.f, 0.f, 0.f, 0.f};
#pragma unroll
                            for (int ks = 0; ks < 2; ++ks) {
                                const v2u a0 = __builtin_bit_cast(v2u, __builtin_amdgcn_ds_read_tr16_b64_v4i16((LAS v4i16_t*)(Kh + (32 * ks + 8 * fq + (fr >> 2)) * VR_S + (32 * (fr & 3) + 4 * kt) * 2)));
                                const v2u a1 = __builtin_bit_cast(v2u, __builtin_amdgcn_ds_read_tr16_b64_v4i16((LAS v4i16_t*)(Kh + (32 * ks + 8 * fq + 4 + (fr >> 2)) * VR_S + (32 * (fr & 3) + 4 * kt) * 2)));
                                u4 = __builtin_amdgcn_mfma_f32_16x16x32_bf16(__builtin_bit_cast(bf16x8, (v4u){a0.x, a0.y, a1.x, a1.y}), vf[ks], u4, 0, 0, 0); }
                            const float su = (float)(1 << SH_U); uw[kt] = cvt4_fp8(u4[0] * su, u4[1] * su, u4[2] * su, u4[3] * su); }
                        unsigned char* up = UT + ((size_t)wi * 128 + 16 * wave + fr) * 128 + 32 * fq;
                        if (DBG_H1_ST || sr) { *(v4u*)up = (v4u){uw[0], uw[1], uw[2], uw[3]}; *(v4u*)(up + 16) = (v4u){uw[4], uw[5], uw[6], uw[7]}; } }
                    LBAR();
                    {   const int tt = wave & 3, vh = wave >> 2; bf16x8 af[2]; unsigned ow[8];
#pragma unroll
                        for (int ks = 0; ks < 2; ++ks) af[ks] = *(const LAS bf16x8*)(Asc + (16 * tt + fr) * KH_S + (32 * ks + 8 * fq) * 2);
#pragma unroll
                        for (int vt = 0; vt < 4; ++vt) { f32x4 o4 = (f32x4){0.f, 0.f, 0.f, 0.f};
#pragma unroll
                            for (int ks = 0; ks < 2; ++ks) {
                                const v2u a0 = __builtin_bit_cast(v2u, __builtin_amdgcn_ds_read_tr16_b64_v4i16((LAS v4i16_t*)(Vr + (32 * ks + 8 * fq + (fr >> 2)) * VR_S + (64 * vh + 16 * (fr & 3) + 4 * vt) * 2)));
                                const v2u a1 = __builtin_bit_cast(v2u, __builtin_amdgcn_ds_read_tr16_b64_v4i16((LAS v4i16_t*)(Vr + (32 * ks + 8 * fq + 4 + (fr >> 2)) * VR_S + (64 * vh + 16 * (fr & 3) + 4 * vt) * 2)));
                                o4 = __builtin_amdgcn_mfma_f32_16x16x32_bf16(__builtin_bit_cast(bf16x8, (v4u){a0.x, a0.y, a1.x, a1.y}), af[ks], o4, 0, 0, 0); }
                            ow[2 * vt] = cvt_pk_bf16(o4[0], o4[1]); ow[2 * vt + 1] = cvt_pk_bf16(o4[2], o4[3]); }
                        bf16* op = OA + (row0 + 16 * tt + fr) * 512 + h * 128 + 64 * vh + 16 * fq;
                        if (DBG_H1_ST || sr) { *(v4u*)op = (v4u){ow[0], ow[1], ow[2], ow[3]}; *(v4u*)(op + 8) = (v4u){ow[4], ow[5], ow[6], ow[7]}; } }
                } }
#undef H1_LOAD
            }
            {
                constexpr int K_S = 144, VT_S = 528;
                LAS unsigned char* Kl = lds;
                LAS unsigned char* Vt = lds + 36864;
                v4u kx[2], vx[2]; v2u qn[2];
#define ATT_DECODE(un) const int rn = (un) & 31, hh = ((un) >> 5) & 3, g = ((un) >> 7) % 3, b = (un) / 384; \
                const int dl = g == 0 ? 0 : g == 1 ? 2 : 4, d = 1 << dl, nbk = 32 >> dl, r = rn / nbk, n = rn % nbk; \
                const unsigned char* base = (const unsigned char*)AQKV + (size_t)(b * SEQ) * 2304 + (g * 4 + hh) * 64; const int qi = 16 * wave + fr; const int tq = (n * 128 + qi) * d + r;
#define ATT_LOAD(un) do { ATT_DECODE(un)       \
                _Pragma("unroll") for (int j = 0; j < 2; ++j) { const int p = tid + 512 * j, key = p >> 2, c16 = p & 3; const int l = (n - 1) * 128 + key; \
                    kx[j] = (v4u){0u, 0u, 0u, 0u}; vx[j] = kx[j]; \
                    if (l >= 0) { const unsigned char* rowp = base + (size_t)(l * d + r) * 2304 + c16 * 16; kx[j] = *(const v4u*)(rowp + 768); vx[j] = *(const v4u*)(rowp + 1536); } } \
                _Pragma("unroll") for (int ks = 0; ks < 2; ++ks) qn[ks] = *(const v2u*)(base + (size_t)tq * 2304 + 32 * ks + 8 * fq); } while (0)
                if (F.vcu < NATT) { ATT_LOAD(F.vcu); }
                _Pragma("unroll") for (int sr = 0; sr < (((REPMASK >> 17) & 1) ? 2 : 1); ++sr) { if (sr) { ATT_LOAD(F.vcu); }
                for (int un = F.vcu; un < NATT; un += F.G) {
                    ATT_DECODE(un)
                    LBAR();
#pragma unroll
                    for (int j = 0; j < 2; ++j) { const int p = tid + 512 * j, key = p >> 2, c16 = p & 3;
                        *(LAS v4u*)(Kl + key * K_S + c16 * 32) = f8x8_to_bf16(kx[j].x, kx[j].y); *(LAS v4u*)(Kl + key * K_S + c16 * 32 + 16) = f8x8_to_bf16(kx[j].z, kx[j].w);
                        *(LAS v4u*)(Vt + key * K_S + c16 * 32) = f8x8_to_bf16(vx[j].x, vx[j].y); *(LAS v4u*)(Vt + key * K_S + c16 * 32 + 16) = f8x8_to_bf16(vx[j].z, vx[j].w); }
                    bf16x8 qf[2]; qf[0] = __builtin_bit_cast(bf16x8, f8x8_to_bf16(qn[0].x, qn[0].y)); qf[1] = __builtin_bit_cast(bf16x8, f8x8_to_bf16(qn[1].x, qn[1].y));
                    if (un + (int)F.G < NATT && !(DBG_ATT_NOLOAD && sr)) { ATT_LOAD(un + (int)F.G); }
                    LBAR();
                    float p[10][4]; float mx = -INFINITY;
#pragma unroll
                    for (int jt = 0; jt < 10; ++jt) { const int kt = (wave + jt) < 15 ? (wave + jt) : 15; f32x4 s4 = (f32x4){0.f, 0.f, 0.f, 0.f};
#pragma unroll
                        for (int ks = 0; ks < 2; ++ks) { const bf16x8 af = *(const LAS bf16x8*)(Kl + (16 * kt + fr) * K_S + (32 * ks + 8 * fq) * 2); s4 = __builtin_amdgcn_mfma_f32_16x16x32_bf16(af, qf[ks], s4, 0, 0, 0); }
#pragma unroll
                        for (int i = 0; i < 4; ++i) { const int kj = 16 * (wave + jt) + 4 * fq + i; const bool ok = (kj >= qi) && (kj <= qi + 128) && (n > 0 || kj >= 128);
                            const float sv = ok ? s4[i] * (0.125f / (float)(1 << (2 * SH_Q))) : -INFINITY; p[jt][i] = sv; mx = fmaxf(mx, sv); } }
                    mx = fmaxf(mx, __shfl_xor(mx, 16)); mx = fmaxf(mx, __shfl_xor(mx, 32));
                    float ls = 0.f;
#pragma unroll
                    for (int jt = 0; jt < 10; ++jt)
#pragma unroll
                        for (int i = 0; i < 4; ++i) { const float e = __expf(p[jt][i] - mx); p[jt][i] = e; ls += e; }
                    ls += __shfl_xor(ls, 16); ls += __shfl_xor(ls, 32);
                    f32x4 o4[4];
#pragma unroll
                    for (int dt = 0; dt < 4; ++dt) o4[dt] = (f32x4){0.f, 0.f, 0.f, 0.f};
#pragma unroll
                    for (int pp = 0; pp < 5; ++pp) { const int k0 = (wave + 2 * pp) < 15 ? (wave + 2 * pp) : 15, k1 = (wave + 2 * pp + 1) < 15 ? (wave + 2 * pp + 1) : 15;
                        v4u pb; pb.x = cvt_pk_bf16(p[2 * pp][0], p[2 * pp][1]); pb.y = cvt_pk_bf16(p[2 * pp][2], p[2 * pp][3]); pb.z = cvt_pk_bf16(p[2 * pp + 1][0], p[2 * pp + 1][1]); pb.w = cvt_pk_bf16(p[2 * pp + 1][2], p[2 * pp + 1][3]);
                        const bf16x8 pf = __builtin_bit_cast(bf16x8, pb);
#pragma unroll
                        for (int dt = 0; dt < 4; ++dt) {
                            const v2u a0 = __builtin_bit_cast(v2u, __builtin_amdgcn_ds_read_tr16_b64_v4i16((LAS v4i16_t*)(Vt + (16 * k0 + 4 * fq + (fr >> 2)) * K_S + (16 * (fr & 3) + 4 * dt) * 2)));
                            const v2u a1 = __builtin_bit_cast(v2u, __builtin_amdgcn_ds_read_tr16_b64_v4i16((LAS v4i16_t*)(Vt + (16 * k1 + 4 * fq + (fr >> 2)) * K_S + (16 * (fr & 3) + 4 * dt) * 2)));
                            const v4u av = (v4u){a0.x, a0.y, a1.x, a1.y};
                            o4[dt] = __builtin_amdgcn_mfma_f32_16x16x32_bf16(__builtin_bit_cast(bf16x8, av), pf, o4[dt], 0, 0, 0); } }
                    const float inv = 1.0f / (ls * (float)(1 << SH_Q)); const size_t trow = (size_t)(b * SEQ + tq);
                    bf16* og = OG + ((size_t)g * T + trow) * 256 + hh * 64 + 16 * fq;
                    { unsigned ow[8];
#pragma unroll
                      for (int dt = 0; dt < 4; ++dt) { ow[2 * dt] = cvt_pk_bf16(o4[dt][0] * inv, o4[dt][1] * inv); ow[2 * dt + 1] = cvt_pk_bf16(o4[dt][2] * inv, o4[dt][3] * inv); }
                      *(v4u*)og = (v4u){ow[0], ow[1], ow[2], ow[3]}; *(v4u*)(og + 8) = (v4u){ow[4], ow[5], ow[6], ow[7]}; }
                    if (fq == 0) LSE[((size_t)(g * 4 + hh) * NB + b) * SEQ + r * (SEQ >> dl) + n * 128 + qi] = mx + __logf(ls);
                } }
#undef ATT_LOAD
#undef ATT_DECODE
            }
        }
        xcd_barrier(bar);
        for (int vb = blockIdx.x; vb < 256; vb += F.G) {
            const int bh = vb >> 3, eg = (vb & 7) * 512 + tid, v = eg >> 5, kq = eg & 31;
            LAS float* Dl = (LAS float*)lds;
            __syncthreads();
            for (int i = tid; i < 64 * 128; i += NWAVES * 64) Dl[i] = DKB[(size_t)bh * 64 * 128 + i];
            unsigned char* up = UT + ((size_t)bh * 64 * 128 + v) * 128 + kq * 4;
            __syncthreads();
            float S0 = 0.f, S1 = 0.f, S2 = 0.f, S3 = 0.f; const float su = (float)(1 << SH_U), ru = 1.0f / su;
            for (int c0 = 0; c0 < 64; c0 += 32) {
                unsigned u[32];
                { const unsigned char* lp = up + (size_t)c0 * 128 * 128;
#pragma unroll
                  for (int c = 0; c < 32; ++c) { u[c] = *(const unsigned*)lp; lp += 128 * 128; asm volatile("" : "+v"(lp)); } }
                unsigned char* sp = up + (size_t)c0 * 128 * 128;
#pragma unroll
                for (int c = 0; c < 32; ++c) { const f32x4 d = *(const LAS f32x4*)(Dl + (c0 + c) * 128 + kq * 4);
                    *(unsigned*)sp = cvt4_fp8(S0 * su, S1 * su, S2 * su, S3 * su); sp += 128 * 128; asm volatile("" : "+v"(sp));
                    const f32x2_t ua = __builtin_amdgcn_cvt_pk_f32_fp8((int)u[c], false), ub = __builtin_amdgcn_cvt_pk_f32_fp8((int)u[c], true);
                    S0 = d[0] * S0 + ua[0] * ru; S1 = d[1] * S1 + ua[1] * ru; S2 = d[2] * S2 + ub[0] * ru; S3 = d[3] * S3 + ub[1] * ru; }
            }
        }
        for (int m0 = F.gw * 16; m0 < T; m0 += F.NGW * 16)
            for (int mb = m0; mb < m0 + 16; mb += 8) {
                const int hh = lane >> 4;
                float l0[8], l1[8], l2[8]; v2u a0[8], a1[8], a2[8];
#pragma unroll
                for (int q = 0; q < 8; ++q) { const int m = mb + q, bb = m >> 12, tt = m & 4095;
                    l0[q] = LSE[((size_t)(0 + hh) * NB + bb) * SEQ + tt]; l1[q] = LSE[((size_t)(4 + hh) * NB + bb) * SEQ + (tt & 3) * 1024 + (tt >> 2)]; l2[q] = LSE[((size_t)(8 + hh) * NB + bb) * SEQ + (tt & 15) * 256 + (tt >> 4)];
                    a0[q] = __builtin_nontemporal_load((const v2u*)(OG + ((size_t)0 * T + m) * 256 + 4 * lane)); a1[q] = __builtin_nontemporal_load((const v2u*)(OG + ((size_t)1 * T + m) * 256 + 4 * lane)); a2[q] = __builtin_nontemporal_load((const v2u*)(OG + ((size_t)2 * T + m) * 256 + 4 * lane)); }
                asm volatile("" ::: "memory");
#pragma unroll
                for (int q = 0; q < 8; ++q) { const int m = mb + q;
                    const float mxl = fmaxf(l0[q], fmaxf(l1[q], l2[q])); const float e0 = __expf(l0[q] - mxl), e1 = __expf(l1[q] - mxl), e2 = __expf(l2[q] - mxl); const float inv = 1.0f / (e0 + e1 + e2);
                    const float w0 = e0 * inv, w1 = e1 * inv, w2 = e2 * inv;
                    const float sy = (float)(1 << SH_YAB);
                    *(unsigned*)((unsigned char*)YA + (size_t)m * 768 + 512 + 4 * lane) = cvt4_fp8(sy * (w0 * bflo(a0[q].x) + w1 * bflo(a1[q].x) + w2 * bflo(a2[q].x)), sy * (w0 * bfhi(a0[q].x) + w1 * bfhi(a1[q].x) + w2 * bfhi(a2[q].x)),
                                                                                                         sy * (w0 * bflo(a0[q].y) + w1 * bflo(a1[q].y) + w2 * bflo(a2[q].y)), sy * (w0 * bfhi(a0[q].y) + w1 * bfhi(a1[q].y) + w2 * bfhi(a2[q].y))); }
            }
        xcd_barrier(bar);
        {
            LAS float* Ot = (LAS float*)lds;
            const int t = tid >> 3, seg = (tid & 7) * 16;
            v2u sfN[4]; bf16x8 afN[4][4]; v4u oiN0, oiN1, hzN;
#define P3C_LOAD(un_) do { const int b_ = (un_) >> 8, h_ = ((un_) >> 6) & 3, c_ = (un_) & 63; const size_t r0_ = (size_t)(b_ * SEQ + c_ * 64); \
                _Pragma("unroll") for (int ks = 0; ks < 4; ++ks) sfN[ks] = *(const v2u*)(UT + ((size_t)(un_) * 128 + 16 * wave + fr) * 128 + 32 * ks + 8 * fq); \
                _Pragma("unroll") for (int tt = 0; tt < 4; ++tt) _Pragma("unroll") for (int ks = 0; ks < 4; ++ks) afN[tt][ks] = *(const bf16x8*)(QTB + (r0_ + 16 * tt + fr) * 512 + h_ * 128 + 32 * ks + 8 * fq); \
                oiN0 = *(const v4u*)(OA + (r0_ + t) * 512 + h_ * 128 + seg); oiN1 = *(const v4u*)(OA + (r0_ + t) * 512 + h_ * 128 + seg + 8); \
                hzN = *(const v4u*)((const unsigned char*)GAB + (size_t)T * 2048 + (r0_ + t) * 512 + h_ * 128 + seg); } while (0)
            if (F.vcu < NB * 4 * 64) { P3C_LOAD(F.vcu); }
            int hprev3 = -1; f32x4 ggv[4];
#pragma unroll
            for (int j = 0; j < 4; ++j) ggv[j] = (f32x4){0.f, 0.f, 0.f, 0.f};
            for (int unit = F.vcu; unit < NB * 4 * 64; unit += F.G) {
                const int b = unit >> 8, h = (unit >> 6) & 3, c = unit & 63; const size_t row0 = (size_t)(b * SEQ + c * 64);
                if (h != hprev3) { hprev3 = h;
#pragma unroll
                    for (int j = 0; j < 4; ++j) ggv[j] = *(const f32x4*)(hg_norm_g + h * 128 + seg + 4 * j); }
                bf16x8 sf[4], af[4][4]; f32x4 o4[4];
#pragma unroll
                for (int ks = 0; ks < 4; ++ks) { const f32x2_t s0 = __builtin_amdgcn_cvt_pk_f32_fp8((int)sfN[ks].x, false), s1 = __builtin_amdgcn_cvt_pk_f32_fp8((int)sfN[ks].x, true), s2 = __builtin_amdgcn_cvt_pk_f32_fp8((int)sfN[ks].y, false), s3 = __builtin_amdgcn_cvt_pk_f32_fp8((int)sfN[ks].y, true);
                    const float ru = 1.0f / (float)(1 << SH_U); v4u sw; sw.x = cvt_pk_bf16(s0[0] * ru, s0[1] * ru); sw.y = cvt_pk_bf16(s1[0] * ru, s1[1] * ru); sw.z = cvt_pk_bf16(s2[0] * ru, s2[1] * ru); sw.w = cvt_pk_bf16(s3[0] * ru, s3[1] * ru);
                    sf[ks] = __builtin_bit_cast(bf16x8, sw);
#pragma unroll
                    for (int tt = 0; tt < 4; ++tt) af[tt][ks] = afN[tt][ks]; }
                const v4u oi0 = oiN0, oi1 = oiN1, hz = hzN;
                if (unit + (int)F.G < NB * 4 * 64) { P3C_LOAD(unit + (int)F.G); }
#pragma unroll
                for (int tt = 0; tt < 4; ++tt) { o4[tt] = (f32x4){0.f, 0.f, 0.f, 0.f};
#pragma unroll
                    for (int ks = 0; ks < 4; ++ks) o4[tt] = __builtin_amdgcn_mfma_f32_16x16x32_bf16(af[tt][ks], sf[ks], o4[tt], 0, 0, 0); }
                LBAR();
#pragma unroll
                for (int tt = 0; tt < 4; ++tt)
#pragma unroll
                    for (int i = 0; i < 4; ++i) Ot[(16 * tt + 4 * fq + i) * 132 + 16 * wave + fr] = o4[tt][i];
                LBAR();
                float o[16];
                { const unsigned ow[8] = {oi0.x, oi0.y, oi0.z, oi0.w, oi1.x, oi1.y, oi1.z, oi1.w};
#pragma unroll
                  for (int j = 0; j < 4; ++j) { const f32x4 q4 = *(const LAS f32x4*)(Ot + t * 132 + seg + 4 * j); o[4 * j] = q4[0] + bflo(ow[2 * j]); o[4 * j + 1] = q4[1] + bfhi(ow[2 * j]); o[4 * j + 2] = q4[2] + bflo(ow[2 * j + 1]); o[4 * j + 3] = q4[3] + bfhi(ow[2 * j + 1]); } }
                float ss = 0.f;
#pragma unroll
                for (int j = 0; j < 16; ++j) ss += o[j] * o[j];
                ss += __shfl_xor(ss, 1); ss += __shfl_xor(ss, 2); ss += __shfl_xor(ss, 4);
                const float rstd = 1.0f / sqrtf(ss * (1.f / 128.f) + RMS_EPS);
                const unsigned hw[4] = {hz.x, hz.y, hz.z, hz.w}; const float rs = rstd * (1.0f / (float)(1 << SH_G));
                unsigned yw[4]; const float rsy = rs * (float)(1 << SH_YAB);
#pragma unroll
                for (int j = 0; j < 4; ++j) { const f32x2_t s0 = __builtin_amdgcn_cvt_pk_f32_fp8((int)hw[j], false), s1 = __builtin_amdgcn_cvt_pk_f32_fp8((int)hw[j], true); const f32x4 gg = ggv[j];
                    yw[j] = cvt4_fp8(o[4 * j] * rsy * gg[0] * s0[0], o[4 * j + 1] * rsy * gg[1] * s0[1], o[4 * j + 2] * rsy * gg[2] * s1[0], o[4 * j + 3] * rsy * gg[3] * s1[1]); }
                *(v4u*)((unsigned char*)YA + (row0 + t) * 768 + h * 128 + seg) = (v4u){yw[0], yw[1], yw[2], yw[3]};
            }
#undef P3C_LOAD
        }
    REP_END(3) }

    SEAM(4);

    if (IN(5)) { REP_BEGIN(5)
        { pg8::DenseSched S; S.init(T, 1024, 768, F.G, (int)blockIdx.x, WA_T); pg8::EpiMerge E{(const unsigned char*)GAB, (unsigned char*)MERGED}; pg8::gemm_phase<ALIGN_DEFAULT, true, pg8::EpiMerge, pg8::DenseSched, 2>(lds, (const char*)YA, 768, S, E, SC_WAB, SC_YAB); }
    REP_END(5) }
    SEAM(5);

    if (IN(6)) { REP_BEGIN(6)
        pg8::DenseSched S; S.init(T, 1024, 1024, F.G, (int)blockIdx.x, WO_T); pg8::EpiOut E{X_IN, (bf16*)(ws + WS_X1B), MOD};
        pg8::gemm_phase<ALIGN_DEFAULT, true>(lds, (const char*)MERGED, 1024, S, E, SC_WGU, SC_M);
    REP_END(6) }
    SEAM(6);

    if (IN(7)) { REP_BEGIN(7)
        const int NRB = (F.G >= 256) ? 128 : F.G / 2;
        if ((int)blockIdx.x < NRB) {
            pg8::RouterSched S{T / 256, NRB, (int)blockIdx.x, (const char*)(ws + WS_WRB)}; pg8::EpiRL E{LOGITS};
            pg8::gemm_phase<ALIGN_DEFAULT, false>(lds, (const char*)(ws + WS_X1B), 2048, S, E);
        } else {
            const int rb = (int)blockIdx.x - NRB, nrow = F.G - NRB;
            for (int b = rb; b < NB; b += nrow) if (tid < 256) { float sum = 0.f;
                for (int p0 = 0; p0 < 64; p0 += 16) { float v[16];
#pragma unroll
                    for (int j = 0; j < 16; ++j) v[j] = ((const float*)(ws + WS_PART))[(size_t)(b * 64 + p0 + j) * 256 + tid];
#pragma unroll
                    for (int j = 0; j < 16; ++j) sum += v[j]; }
                ((float*)(ws + WS_CB))[b * 256 + tid] = sum; }
            for (int m0 = (rb * NWAVES + wave) * 16; m0 < T; m0 += nrow * NWAVES * 16) {
                const int b = m0 >> 12;
                f32x4 mul[4], add[4];
#pragma unroll
                for (int j = 0; j < 4; ++j) { const int c = 4 * lane + 256 * j;
                    const f32x4 s2 = *(const f32x4*)(MOD + b * 6144 + 4096 + c);
                    mul[j] = *(const f32x4*)(norm2_g + c) * (s2 + 1.0f);
                    add[j] = *(const f32x4*)(MOD + b * 6144 + 3072 + c); }
                for (int m = m0; m < m0 + 16; ++m) {
                    const GAS v2u* xr = (const GAS v2u*)((const bf16*)(ws + WS_X1B) + (size_t)m * D) + lane;
                    f32x4 v[4]; float s = 0.f;
#pragma unroll
                    for (int j = 0; j < 4; ++j) { const v2u xw = xr[64 * j]; v[j] = (f32x4){bflo(xw.x), bfhi(xw.x), bflo(xw.y), bfhi(xw.y)}; s += (v[j].x * v[j].x + v[j].y * v[j].y) + (v[j].z * v[j].z + v[j].w * v[j].w); }
                    const float rstd = 1.0f / sqrtf(wave_sum(s) * (1.f / D) + RMS_EPS);
                    if (lane == 0) ((float*)(ws + WS_RSTD))[m] = rstd;
                    GAS unsigned* o4 = (GAS unsigned*)((unsigned char*)(ws + WS_H2F8) + (size_t)m * D) + lane;
#pragma unroll
                    for (int j = 0; j < 4; ++j) { const f32x4 y = v[j] * rstd * mul[j] + add[j]; const float sx = (float)(1 << SH_X); o4[64 * j] = cvt4_fp8(y.x * sx, y.y * sx, y.z * sx, y.w * sx); }
                }
            }
        }
    REP_END(7) }
    SEAM(7);

    if (IN(9)) { REP_BEGIN(9)
        LAS unsigned* whist = (LAS unsigned*)lds;
        LAS unsigned* wbase = whist + 2048;
        LAS int* pe_l = (LAS int*)(lds + 16384); LAS int* pr_l = pe_l + 1024; LAS float* pw_l = (LAS float*)(pr_l + 1024);
        for (int cid = F.vcu; cid < T / 128; cid += F.G) {
            const int m0w = cid * 128;
            __syncthreads();
            for (int i = tid; i < 2048; i += NWAVES * 64) whist[i] = 0u;
            __syncthreads();
            float cb4[4], rb4[4];
#pragma unroll
            for (int i = 0; i < 4; ++i) { cb4[i] = ((const float*)(ws + WS_CB))[(cid >> 5) * 256 + lane + 64 * i]; rb4[i] = router_bias[lane + 64 * i]; }
            for (int jg = 0; jg < 16 / TKI; ++jg) {
                float sc[TKI][4]; unsigned key[TKI][4];
#pragma unroll
                for (int tt = 0; tt < TKI; ++tt) { const int t = m0w + wave * 16 + jg * TKI + tt; const float rs = ((const float*)(ws + WS_RSTD))[t];
#pragma unroll
                    for (int i = 0; i < 4; ++i) { sc[tt][i] = fsigmoid(rs * LOGITS[(size_t)t * 256 + lane + 64 * i] + cb4[i]); const float sl = fmaxf(sc[tt][i] + rb4[i], 0.f);
                        key[tt][i] = (__float_as_uint(sl) & 0xFFFFFF00u) | (unsigned)(255 - (lane + 64 * i)); } }
                float myw[TKI], ssum[TKI]; int mye[TKI];
#pragma unroll
                for (int tt = 0; tt < TKI; ++tt) { myw[tt] = 0.f; ssum[tt] = 0.f; mye[tt] = 0; }
                for (int k = 0; k < 8; ++k) {
#pragma unroll
                    for (int tt = 0; tt < TKI; ++tt) {
                        unsigned bk = max(max(key[tt][0], key[tt][1]), max(key[tt][2], key[tt][3]));
                        bk = max(bk, (unsigned)__builtin_amdgcn_update_dpp(0, (int)bk, 0xB1, 0xF, 0xF, false));
                        bk = max(bk, (unsigned)__builtin_amdgcn_update_dpp(0, (int)bk, 0x4E, 0xF, 0xF, false));
                        bk = max(bk, (unsigned)__builtin_amdgcn_update_dpp(0, (int)bk, 0x141, 0xF, 0xF, false));
                        bk = max(bk, (unsigned)__builtin_amdgcn_update_dpp(0, (int)bk, 0x140, 0xF, 0xF, false));
                        bk = max(bk, (unsigned)__builtin_amdgcn_update_dpp(0, (int)bk, 0x142, 0xA, 0xF, false));
                        bk = max(bk, (unsigned)__builtin_amdgcn_update_dpp(0, (int)bk, 0x143, 0xC, 0xF, false));
                        bk = (unsigned)__builtin_amdgcn_readlane((int)bk, 63);
                        const int idx = 255 - (int)(bk & 0xFFu), own = idx & 63, ii = idx >> 6;
                        float sv = ii == 0 ? sc[tt][0] : ii == 1 ? sc[tt][1] : ii == 2 ? sc[tt][2] : sc[tt][3];
                        sv = __int_as_float(__builtin_amdgcn_readlane(__float_as_int(sv), own));
#pragma unroll
                        for (int i = 0; i < 4; ++i) if (lane == own && ii == i) key[tt][i] = 0u;
                        ssum[tt] += sv;
                        if (lane == k) { mye[tt] = idx; myw[tt] = sv; }
                    }
                }
#pragma unroll
                for (int tt = 0; tt < TKI; ++tt) {
                    const float w = myw[tt] / ssum[tt] * 2.5f; const int j = jg * TKI + tt;
                    if (lane < 8) { LAS unsigned* hp = whist + wave * 256 + mye[tt]; const unsigned lr = *hp; *hp = lr + 1u;
                        const int ix = (wave * 16 + j) * 8 + lane; pe_l[ix] = mye[tt]; pr_l[ix] = (int)lr; pw_l[ix] = w; }
                    LDS_WAIT();
                }
            }
            __syncthreads();
            if (tid < 256) { unsigned run = 0u;
#pragma unroll
                for (int w = 0; w < 8; ++w) { wbase[w * 256 + tid] = run; run += whist[w * 256 + tid]; }
                HISTG[cid * 256 + tid] = run; }
            __syncthreads();
            for (int i = tid; i < 1024; i += NWAVES * 64) { const int e = pe_l[i]; const size_t gi = (size_t)m0w * 8 + i; PE[gi] = e; PR[gi] = pr_l[i] + (int)wbase[(i >> 7) * 256 + e]; PW[gi] = pw_l[i]; }
        }
    REP_END(9) }
    SEAM(9);

    if (IN(10) || IN(11) || IN(12)) {
        LAS int* tab = (LAS int*)(lds + TAB_OFF);
        LAS int* est = (LAS int*)lds; LAS int* tst = est + 256; LAS int* cntl = tst + 256; LAS int* ntl = cntl + 256; LAS int* cbl = ntl + 64;
        REP_BEGIN(10)
        for (int cid = F.vcu; cid < T / 128; cid += F.G) {
            __syncthreads();
            {
                const int e = tid & 255, hf = tid >> 8; int tot = 0, cb = 0;
                for (int c0 = hf * 128; c0 < hf * 128 + 128; c0 += 32) { int v[32];
#pragma unroll
                    for (int j = 0; j < 32; ++j) v[j] = (int)HISTG[(c0 + j) * 256 + e];
#pragma unroll
                    for (int j = 0; j < 32; ++j) { tot += v[j]; cb += (c0 + j < cid) ? v[j] : 0; } }
                if (hf) { cntl[e] = tot; cbl[e] = cb; }
                __syncthreads();
                if (!hf) { cntl[e] += tot; cbl[e] += cb; }
            }
            __syncthreads();
            if (wave == 0) {
                int c4[4], loc = 0, locT = 0;
#pragma unroll
                for (int i = 0; i < 4; ++i) { c4[i] = cntl[4 * lane + i]; loc += c4[i]; locT += (c4[i] + 255) >> 8; }
                int inc = loc, incT = locT;
#pragma unroll
                for (int o = 1; o < 64; o <<= 1) { const int a = __shfl_up(inc, o), bt = __shfl_up(incT, o); if (lane >= o) { inc += a; incT += bt; } }
                int ex = inc - loc, exT = incT - locT;
#pragma unroll
                for (int i = 0; i < 4; ++i) { est[4 * lane + i] = exT * 256; tst[4 * lane + i] = exT; ex += c4[i]; exT += (c4[i] + 255) >> 8; }
                if (lane == 63) ntl[0] = incT;
            }
            __syncthreads();
            if (tid < 256) { const int cn = cntl[tid], t0 = tst[tid], e0 = est[tid]; for (int j = 0; j * 256 < cn; ++j) { const int rem = cn - j * 256; tab[(t0 + j) * 4 + 0] = tid; tab[(t0 + j) * 4 + 1] = e0 + j * 256; tab[(t0 + j) * 4 + 2] = rem < 256 ? rem : 256; tab[(t0 + j) * 4 + 3] = 0; } }
            if (tid < T / 256) { const int ti = ntl[0] + tid; tab[ti * 4 + 0] = NEXP; tab[ti * 4 + 1] = NSLOTP + 256 * tid; tab[ti * 4 + 2] = 256; tab[ti * 4 + 3] = 0; }
            if (tid == 0) { F.MISC[16] = (unsigned)ntl[0]; F.MISC[17] = (unsigned)(ntl[0] + T / 256); }
            __syncthreads();
            if (IN(10)) {
                for (int i = cid * 128 + tid; i < cid * 128 + 128; i += NWAVES * 64) SLOT_TOK[NSLOTP + i] = i;
                for (int e = blockIdx.x; e < NEXP; e += F.G) { const int cn = cntl[e], e0 = est[e], pend = e0 + (((cn + 255) >> 8) << 8); for (int i = e0 + cn + tid; i < pend; i += NWAVES * 64) __hip_atomic_store(SLOT_TOK + i, 0, RLX_AGENT); }
                for (int i = tid; i < 1024; i += NWAVES * 64) { const size_t gi = (size_t)cid * 1024 + i; const int e = PE[gi]; const int slot = est[e] + cbl[e] + PR[gi]; __hip_atomic_store(SLOT_TOK + slot, (int)(gi >> 3), RLX_AGENT); TOK_SLOT[gi] = slot; }
            }
        }
        REP_END(10)
        __syncthreads();
    }
    SEAM(10);

    if (IN(11)) { REP_BEGIN(11)
        int Gp = F.G, c11 = F.vcu, cid = -1;
        if (NGB < F.G && NCONV11 > 0) {
            const int units = (int)F.MISC[17] * 2, gmax = F.G - CONV11_MINWG, R = (units + gmax - 1) / gmax; Gp = (units + R - 1) / R;
            const int x = (int)blockIdx.x & 7, j = (int)blockIdx.x >> 3, qb = Gp >> 3, qr = Gp & 7, qx = qb + (x < qr ? 1 : 0), mn = x < qr ? x : qr;
            if (j < qx) c11 = x * qb + mn + j; else cid = x * (32 - qb) - mn + (j - qx);
        }
        Gp = __builtin_amdgcn_readfirstlane(Gp); c11 = __builtin_amdgcn_readfirstlane(c11); cid = __builtin_amdgcn_readfirstlane(cid);
        if (cid < 0) {
            LAS unsigned short* RL = (LAS unsigned short*)(lds + RL_OFF); const LAS int* tb = (const LAS int*)(lds + TAB_OFF); const int nu = (int)F.MISC[17] * 2;
            int rv[RL_MAXU / 2];
#pragma unroll
            for (int k = 0; k < RL_MAXU / 2; ++k) { const int en = tid + 512 * k, L = (en >> 8) * Gp + c11; rv[k] = (L < nu) ? SLOT_TOK[tb[(L >> 1) * 4 + 1] + (en & 255)] : 0; }
#pragma unroll
            for (int k = 0; k < RL_MAXU / 2; ++k) RL[tid + 512 * k] = (unsigned short)rv[k];
            __syncthreads(); }
        if (cid < 0) { pg8::RoutedSched<2, true> S{(const LAS int*)(lds + TAB_OFF), (int)F.MISC[17], Gp, c11, 1024u, (const char*)WGU, (size_t)512 * 1024, (const LAS unsigned short*)(lds + RL_OFF)};
          pg8::EpiGU E{(unsigned char*)HMID}; pg8::gemm_phase<ALIGN_DEFAULT, true, pg8::EpiGU, pg8::RoutedSched<2, true>, 4>(lds, (const char*)(ws + WS_H2F8), 1024, S, E, SC_WGU, SC_X); }
        else conv_run(NITEMS - NCONV11 + cid * NWAVES + wave, NITEMS, (F.G - Gp) * NWAVES, (LAS float*)(lds + wave * 16384));
    REP_END(11) }
    SEAM(11);

    if (IN(12)) { REP_BEGIN(12)
        if (STAGGER12 && (blockIdx.x & 8)) { for (int q = 0; q < STAGGER12; ++q) __builtin_amdgcn_s_sleep(127); }
        { pg8::RoutedSched<4, false> S{(const LAS int*)(lds + TAB_OFF), (int)F.MISC[17], F.G, F.vcu, 256u, (const char*)WD, (size_t)1024 * 256, nullptr};
          pg8::EpiRD E{(unsigned char*)YSLOT, SLOT_W}; pg8::gemm_phase<ALIGN_P12, true, pg8::EpiRD, pg8::RoutedSched<4, false>, 2>(lds, (const char*)HMID, 256, S, E, SC_WD, SC_HMID); }

    REP_END(12) }
    SEAM(12);

    if (IN(13)) { REP_BEGIN(13)
        float* dst13 = (rep + 1 < REPS(13)) ? (float*)(ws + WS_QF) : out;
        for (int m0 = F.gw * 16; m0 < T; m0 += F.NGW * 16) {
            const int b = m0 >> 12;
            f32x4 g2[4], fg[4];
#pragma unroll
            for (int j = 0; j < 4; ++j) { const int c = 256 * j + 4 * lane; g2[j] = *(const f32x4*)(MOD + b * 6144 + 5120 + c) * (1.0f / (float)(1 << SH_Y)); fg[j] = *(const f32x4*)(final_g + c); }
            for (int m = m0; m < m0 + 16; ++m) {
                unsigned yr[9][4];
#pragma unroll
                for (int j = 0; j < 4; ++j) yr[0][j] = __builtin_nontemporal_load((const unsigned*)(YSH + (size_t)m * 1024 + 256 * j + 4 * lane));
#pragma unroll
                for (int k = 0; k < 8; ++k) { const int slot = TOK_SLOT[m * 8 + k]; const unsigned char* sp = (const unsigned char*)YSLOT + (size_t)slot * 1024 + 4 * lane;
#pragma unroll
                    for (int j = 0; j < 4; ++j) yr[k + 1][j] = __builtin_nontemporal_load((const unsigned*)(sp + 256 * j)); }
                f32x4 v[4];
#pragma unroll
                for (int j = 0; j < 4; ++j) { const v2u xw = *(const v2u*)((const bf16*)(ws + WS_X1B) + (size_t)m * D + 256 * j + 4 * lane); v[j] = (f32x4){bflo(xw.x), bfhi(xw.x), bflo(xw.y), bfhi(xw.y)}; }
                f32x4 a[4];
#pragma unroll
                for (int j = 0; j < 4; ++j) a[j] = (f32x4){0.f, 0.f, 0.f, 0.f};
#pragma unroll
                for (int k = (DBG_MOE >= 1 ? 0 : 9); k < (DBG_MOE >= 2 ? 9 : 1); ++k) {
                    const float wk = k == 0 ? 1.0f : PW[m * 8 + (k > 0 ? k - 1 : 0)];
#pragma unroll
                    for (int j = 0; j < 4; ++j) { const f32x2_t lo = __builtin_amdgcn_cvt_pk_f32_fp8((int)yr[k][j], false), hi = __builtin_amdgcn_cvt_pk_f32_fp8((int)yr[k][j], true); a[j] += (f32x4){lo[0], lo[1], hi[0], hi[1]} * wk; } }
                float s = 0.f;
#pragma unroll
                for (int j = 0; j < 4; ++j) { v[j] = v[j] + g2[j] * a[j]; s += (v[j].x * v[j].x + v[j].y * v[j].y) + (v[j].z * v[j].z + v[j].w * v[j].w); }
                const float rstd = 1.0f / sqrtf(wave_sum(s) * (1.f / D) + RMS_EPS);
                GAS f32x4* dr = (GAS f32x4*)(dst13 + (size_t)m * D + 4 * lane);
#pragma unroll
                for (int j = 0; j < 4; ++j) __builtin_nontemporal_store(v[j] * rstd * fg[j], dr + 64 * j);
            }
        }
    REP_END(13) }
#if defined(DBG_DUMP)
    {
        xcd_barrier(bar);
        const bf16* SRC = DBG_DUMP_SRC; const int ld = DBG_DUMP_LD, off = DBG_DUMP_OFF;
        for (int m = F.gw; m < T; m += F.NGW) {
#pragma unroll
            for (int j = 0; j < 4; ++j) { const int c = 4 * lane + 256 * j; const int cc = c % DBG_DUMP_W; const v2u y = *(const v2u*)(SRC + (size_t)m * ld + off + cc); *(f32x4*)(out + (size_t)m * 1024 + c) = (f32x4){bflo(y.x), bfhi(y.x), bflo(y.y), bfhi(y.y)}; }
        }
    }
#endif
#undef IN
#undef SEAM
}

#undef X_IN
#undef cvec
#undef ada_w
#undef ada_b
#undef norm1_g
#undef w_in
#undef lb_logits
#undef hg_norm_g
#undef w_branch_a
#undef w_branch_b
#undef w_out
#undef norm2_g
#undef w_router
#undef router_bias
#undef w_exp_gate
#undef w_exp_up
#undef w_exp_down
#undef w_sh_gate
#undef w_sh_up
#undef w_sh_down
#undef final_g
#undef out
#undef WIN_T
#undef WA_T
#undef WB_T
#undef WO_T
#undef RS_T
#undef WSD_T
#undef WD
#undef WGU
#undef PE
#undef PR
#undef PW
#undef SLOT_TOK
#undef SLOT_W
#undef TOK_SLOT
#undef LSE
#undef QF
#undef OA
#undef OG
#undef MERGED
#undef HMID
#undef YSH
#undef AQKV
#undef GAB
#undef XN
#undef YA
#undef YB
#undef H2
#undef LOGITS
#undef YSLOT
#undef MOD
#undef HISTG
#undef ATTQ
#ifndef DBG_MOE
#define DBG_MOE 2
#endif
#ifndef MK_CUTS
#define MK_CUTS 1
#endif
extern "C" void kernel_launch(void* const* d_in, const int* in_sizes, int n_in, void* d_out, int out_size, void* d_ws, size_t ws_size, hipStream_t stream) {
    static int grid = 0;
    if (grid == 0) {
        if (n_in != 21 || out_size != T * D || ws_size < WS_END) { fprintf(stderr, "kernel_launch: unexpected shapes (n_in %d out %d ws %zu)\n", n_in, out_size, ws_size); grid = -1; return; }
        int dev = 0, cus = 0, per_cu = 0;
        if (hipGetDevice(&dev) != hipSuccess || hipDeviceGetAttribute(&cus, hipDeviceAttributeMultiprocessorCount, dev) != hipSuccess) { grid = -1; return; }
        if (hipFuncSetAttribute((const void*)mk_fwd, hipFuncAttributeMaxDynamicSharedMemorySize, LDS_BYTES) != hipSuccess) { fprintf(stderr, "kernel_launch: hipFuncSetAttribute failed\n"); grid = -1; return; }
        if (hipOccupancyMaxActiveBlocksPerMultiprocessor(&per_cu, (const void*)mk_fwd, NWAVES * 64, LDS_BYTES) != hipSuccess || per_cu < 1) fprintf(stderr, "kernel_launch: occupancy query reports %d\n", per_cu);
        (void)hipGetLastError();
        if ((long)(cus - 16) * RL_MAXU < 2L * MAXTILES) { fprintf(stderr, "kernel_launch: %d CUs: the routed gate/up GEMM keeps at most %d units' row lists per workgroup\n", cus, RL_MAXU); grid = -1; return; }
        grid = cus;
    }
    if (grid < 0) return;
    if (hipMemsetAsync((char*)d_ws + WS_CTL, 0, CTL_ZERO_BYTES, stream) != hipSuccess) return;
    Args a{};
    for (int i = 0; i < 21; ++i) a.in[i] = (const float*)d_in[i];
    a.out = (float*)d_out; a.ws = (unsigned char*)d_ws;
#if MK_CUTS == 1
    a.ph_lo = 0; a.ph_hi = 14;
    hipLaunchKernelGGL(mk_fwd, dim3(grid), dim3(NWAVES * 64), LDS_BYTES, stream, a);
#else
    for (int p = 0; p < 14; ++p) { a.ph_lo = p; a.ph_hi = p + 1; hipLaunchKernelGGL(mk_fwd, dim3(grid), dim3(NWAVES * 64), LDS_BYTES, stream, a); }
#endif
}
```
